# Optimizing an MI355X kernel written in HIP

```python
import math
import jax
import jax.numpy as jnp
from jax import lax
import numpy as np

D_MODEL = 1024
BATCH = 2
SEQ = 8192
DEPTH = 2
DEC_BATCH = 32
DEC_SEQ = 8
PAST_LEN = 16384
PAGE_SIZE = 128

N_A_LAYERS = DEPTH // 2
N_B_LAYERS = DEPTH - N_A_LAYERS
A_HEADS = 8
A_DK = 128
A_DV = 128
A_QK_W = A_HEADS * A_DK
A_V_W = A_HEADS * A_DV
A_CONV_DIM = 2 * A_QK_W + A_V_W
A_IN_W = A_CONV_DIM + A_V_W + 2 * A_HEADS
CONV_W = 4
DELTA_CHUNK = 64
B_HEADS = 16
B_HD = 64
B_KV_HEADS = 4
B_GROUP = B_HEADS // B_KV_HEADS
MOBA_BLOCK = 256
MOBA_TOPK = 3
Q_BLOCK = 128
ROPE_THETA = 10000.0
D_FF = ((8 * D_MODEL + 3 * 256 - 1) // (3 * 256)) * 256
DEEPNORM_ALPHA = (2.0 * DEPTH) ** 0.25
DEEPNORM_BETA = (8.0 * DEPTH) ** -0.25
LN_EPS = 1e-5
RMS_EPS = 1e-6
L2_EPS = 1e-6
F32 = jnp.float32

kernel_name = 'yoco_gdn_moba_deepnorm_step'


def layer_norm(x, g, b):
    xf = x.astype(F32)
    mu = jnp.mean(xf, -1, keepdims=True)
    var = jnp.mean(jnp.square(xf - mu), -1, keepdims=True)
    return ((xf - mu) * lax.rsqrt(var + LN_EPS) * g.astype(F32) + b.astype(F32)).astype(x.dtype)


def swiglu(x, w_gate, w_up, w_down):
    return (jax.nn.silu(x @ w_gate) * (x @ w_up)) @ w_down


def rope(x, pos):
    half = x.shape[-1] // 2
    inv_freq = ROPE_THETA ** (-jnp.arange(half, dtype=F32) / half)
    ang = pos.astype(F32)[:, None] * inv_freq[None, :]
    cos = jnp.cos(ang)[None, :, None, :]
    sin = jnp.sin(ang)[None, :, None, :]
    x1 = x[..., :half].astype(F32)
    x2 = x[..., half:].astype(F32)
    return jnp.concatenate([x1 * cos - x2 * sin, x2 * cos + x1 * sin], -1).astype(x.dtype)


def l2norm(x):
    return x * lax.rsqrt(jnp.sum(jnp.square(x), -1, keepdims=True) + L2_EPS)


def short_conv(x, buf, w):
    t = x.shape[1]
    xp = jnp.concatenate([buf.astype(x.dtype), x], axis=1)
    y = xp[:, 0:t] * w[0]
    for i in range(1, CONV_W):
        y = y + xp[:, i:i + t] * w[i]
    return jax.nn.silu(y), xp[:, xp.shape[1] - (CONV_W - 1):]


def gated_delta_chunked(q, k, v, g, beta, s0):
    b, t, h, _ = q.shape
    c = DELTA_CHUNK
    n = t // c

    def blk(a):
        a = a.reshape((b, n, c) + a.shape[2:])
        return jnp.swapaxes(a, 2, 3)

    q, k, v, g, beta = blk(q), blk(k), blk(v), blk(g), blk(beta)
    G = jnp.cumsum(g, axis=-1)
    causal = jnp.tril(jnp.ones((c, c), bool))
    strict = jnp.tril(jnp.ones((c, c), bool), -1)
    diff = G[..., :, None] - G[..., None, :]
    decay = jnp.where(causal, jnp.exp(jnp.where(causal, diff, 0.0)), 0.0)
    a_mat = jnp.where(strict, beta[..., :, None] * jnp.einsum('bnhik,bnhjk->bnhij', k, k) * decay, 0.0)
    m = a_mat + jnp.eye(c, dtype=F32)
    rhs = jnp.concatenate([v * beta[..., None], k * (beta * jnp.exp(G))[..., None]], -1)
    sol = lax.linalg.triangular_solve(m, rhs, left_side=True, lower=True, unit_diagonal=True)
    u, w = sol[..., :A_DV], sol[..., A_DV:]
    qk = jnp.where(causal, jnp.einsum('bnhik,bnhjk->bnhij', q, k) * decay, 0.0)
    q_dec = q * jnp.exp(G)[..., None]
    k_dec = k * jnp.exp(G[..., -1:] - G)[..., None]
    g_last = jnp.exp(G[..., -1])

    def step(s, xs):
        u_c, w_c, qk_c, qd_c, kd_c, gl_c = xs
        v_new = u_c - jnp.einsum('bhck,bhkv->bhcv', w_c, s)
        o = jnp.einsum('bhck,bhkv->bhcv', qd_c, s) + jnp.einsum('bhij,bhjv->bhiv', qk_c, v_new)
        s = s * gl_c[..., None, None] + jnp.einsum('bhck,bhcv->bhkv', kd_c, v_new)
        return s, o

    xs = tuple(jnp.moveaxis(a, 1, 0) for a in (u, w, qk, q_dec, k_dec, g_last))
    s, o = lax.scan(step, s0, xs)
    o = jnp.transpose(o, (1, 0, 3, 2, 4)).reshape(b, t, h, A_DV)
    return o, s


def gated_delta_recurrent(q, k, v, g, beta, s0):
    def step(s, xs):
        q_t, k_t, v_t, g_t, b_t = xs
        s = s * jnp.exp(g_t)[..., None, None]
        err = v_t - jnp.einsum('bhk,bhkv->bhv', k_t, s)
        s = s + jnp.einsum('bhk,bhv->bhkv', k_t, b_t[..., None] * err)
        return s, jnp.einsum('bhk,bhkv->bhv', q_t, s)

    xs = tuple(jnp.moveaxis(a, 1, 0) for a in (q, k, v, g, beta))
    s, o = lax.scan(step, s0, xs)
    return jnp.moveaxis(o, 0, 1), s


def gated_delta_mixer(x, conv_buf, s0, chunked, w_in, conv_w, a_log, dt_bias, norm_w, w_out):
    b, t, _ = x.shape
    proj = x @ w_in
    qkv = proj[..., :A_CONV_DIM]
    z = proj[..., A_CONV_DIM:A_CONV_DIM + A_V_W]
    a = proj[..., A_CONV_DIM + A_V_W:A_CONV_DIM + A_V_W + A_HEADS]
    bb = proj[..., A_CONV_DIM + A_V_W + A_HEADS:]
    qkv, new_buf = short_conv(qkv, conv_buf, conv_w)
    qkv = qkv.astype(F32)
    q = l2norm(qkv[..., :A_QK_W].reshape(b, t, A_HEADS, A_DK)) * (A_DK ** -0.5)
    k = l2norm(qkv[..., A_QK_W:2 * A_QK_W].reshape(b, t, A_HEADS, A_DK))
    v = qkv[..., 2 * A_QK_W:].reshape(b, t, A_HEADS, A_DV)
    g = -jnp.exp(a_log.astype(F32)) * jax.nn.softplus(a.astype(F32) + dt_bias.astype(F32))
    beta = jax.nn.sigmoid(bb.astype(F32))
    if chunked:
        o, s = gated_delta_chunked(q, k, v, g, beta, s0.astype(F32))
    else:
        o, s = gated_delta_recurrent(q, k, v, g, beta, s0.astype(F32))
    o = o * lax.rsqrt(jnp.mean(jnp.square(o), -1, keepdims=True) + RMS_EPS) * norm_w.astype(F32)
    o = o * jax.nn.silu(z.astype(F32).reshape(b, t, A_HEADS, A_DV))
    out = o.reshape(b, t, A_V_W).astype(x.dtype) @ w_out
    return out, new_buf, s.astype(x.dtype)


def to_blocks(k, v):
    b, t = k.shape[:2]
    nb = -(-t // MOBA_BLOCK)
    pad = nb * MOBA_BLOCK - t
    k = jnp.pad(k, ((0, 0), (0, pad), (0, 0), (0, 0)))
    v = jnp.pad(v, ((0, 0), (0, pad), (0, 0), (0, 0)))
    kb = k.reshape(b, nb, MOBA_BLOCK, B_KV_HEADS, B_HD)
    vb = v.reshape(b, nb, MOBA_BLOCK, B_KV_HEADS, B_HD)
    means = jnp.mean(kb.astype(F32), axis=2)
    return kb, vb, means


def moba_attend(q, q_pos, kb, vb, means):
    b, nq, h, _ = q.shape
    nb = kb.shape[1]
    qf = q.astype(F32)
    own = q_pos // MOBA_BLOCK
    gate = jnp.einsum('bqkgd,bnkd->bqkgn', qf.reshape(b, nq, B_KV_HEADS, B_GROUP, B_HD), means)
    gate = gate.reshape(b, nq, h, nb)
    past = jnp.arange(nb)[None, :] < own[:, None]
    gate = jnp.where(past[None, :, None, :], gate, -jnp.inf)
    n_sel = min(MOBA_TOPK, nb)
    _, top = lax.top_k(gate, n_sel)
    sel_valid = jnp.arange(n_sel)[None, :] < own[:, None]
    idx = jnp.concatenate([top, jnp.broadcast_to(own[None, :, None, None], (b, nq, h, 1)).astype(top.dtype)], -1)
    valid = jnp.concatenate([jnp.broadcast_to(sel_valid[None, :, None, :], (1, nq, 1, n_sel)),
                             jnp.ones((1, nq, 1, 1), bool)], -1)
    b_ix = jnp.arange(b)[:, None, None, None]
    h_ix = (jnp.arange(h) // B_GROUP)[None, None, :, None]
    kg = kb[b_ix, idx, :, h_ix, :].astype(F32)
    vg = vb[b_ix, idx, :, h_ix, :].astype(F32)
    key_pos = idx[..., None] * MOBA_BLOCK + jnp.arange(MOBA_BLOCK)
    mask = valid[..., None] & (key_pos <= q_pos[None, :, None, None, None])
    logits = jnp.einsum('bqhd,bqhrkd->bqhrk', qf, kg) * (B_HD ** -0.5)
    logits = jnp.where(mask, logits, -jnp.inf)
    p = jax.nn.softmax(logits.reshape(b, nq, h, -1), axis=-1).reshape(logits.shape)
    return jnp.einsum('bqhrk,bqhrkd->bqhd', p, vg).astype(q.dtype)


def moba_prompt(q, k, v):
    b, t = q.shape[:2]
    kb, vb, means = to_blocks(k, v)
    nqb = t // Q_BLOCK
    qc = jnp.swapaxes(q.reshape(b, nqb, Q_BLOCK, B_HEADS, B_HD), 0, 1)
    starts = jnp.arange(nqb, dtype=jnp.int32) * Q_BLOCK

    def one_block(args):
        q_i, s = args
        return moba_attend(q_i, s + jnp.arange(Q_BLOCK, dtype=jnp.int32), kb, vb, means)

    o = lax.map(one_block, (qc, starts))
    return jnp.swapaxes(o, 0, 1).reshape(b, t, B_HEADS, B_HD)


def moba_sample(q, k_new, v_new, cache_k, cache_v, page_table):
    db, t = q.shape[:2]
    past = page_table.shape[1] * PAGE_SIZE
    k_past = cache_k[page_table].reshape(db, past, B_KV_HEADS, B_HD).astype(k_new.dtype)
    v_past = cache_v[page_table].reshape(db, past, B_KV_HEADS, B_HD).astype(v_new.dtype)
    kb, vb, means = to_blocks(jnp.concatenate([k_past, k_new], 1), jnp.concatenate([v_past, v_new], 1))
    pos = past + jnp.arange(t, dtype=jnp.int32)
    return moba_attend(q, pos, kb, vb, means)


def trunk(x, pos, conv_state, delta_state, chunked, attend, ln_g, ln_b, a_w_in, a_conv, a_log_decay,
          a_dt_bias, a_norm, a_w_out, kv_w_k, kv_w_v, b_w_q, b_w_o, ffn_w_gate, ffn_w_up, ffn_w_down):
    b, t, _ = x.shape
    new_conv, new_delta = [], []
    k_sh = None
    v_sh = None
    for layer in range(DEPTH):
        if layer < N_A_LAYERS:
            mix, cb, s = gated_delta_mixer(x, conv_state[layer], delta_state[layer], chunked,
                                           a_w_in[layer], a_conv[layer], a_log_decay[layer],
                                           a_dt_bias[layer], a_norm[layer], a_w_out[layer])
            new_conv.append(cb)
            new_delta.append(s)
        else:
            if layer == N_A_LAYERS:
                k_sh = rope((x @ kv_w_k).reshape(b, t, B_KV_HEADS, B_HD), pos)
                v_sh = (x @ kv_w_v).reshape(b, t, B_KV_HEADS, B_HD)
            j = layer - N_A_LAYERS
            q = rope((x @ b_w_q[j]).reshape(b, t, B_HEADS, B_HD), pos)
            mix = attend(q, k_sh, v_sh).reshape(b, t, B_HEADS * B_HD) @ b_w_o[j]
        h = layer_norm(DEEPNORM_ALPHA * x + mix, ln_g[layer, 0], ln_b[layer, 0])
        x = layer_norm(DEEPNORM_ALPHA * h + swiglu(h, ffn_w_gate[layer], ffn_w_up[layer], ffn_w_down[layer]),
                       ln_g[layer, 1], ln_b[layer, 1])
    return x, jnp.stack(new_conv), jnp.stack(new_delta), k_sh, v_sh


def setup_inputs(seed: int = 0) -> dict:
    key = jax.random.key(seed)
    ks = jax.random.split(key, 24)
    n_pages = PAST_LEN // PAGE_SIZE
    n_pool = (DEC_BATCH * n_pages * 5) // 4

    def nrm(k, shape, scale):
        return jax.random.normal(k, shape, F32) * scale

    x_prompt = nrm(ks[0], (BATCH, SEQ, D_MODEL), 1.0)
    x_sample = nrm(ks[1], (DEC_BATCH, DEC_SEQ, D_MODEL), 1.0)
    state_conv = nrm(ks[2], (N_A_LAYERS, DEC_BATCH, CONV_W - 1, A_CONV_DIM), 1.0)
    state_delta = nrm(ks[3], (N_A_LAYERS, DEC_BATCH, A_HEADS, A_DK, A_DV), 0.1)
    cache_k = nrm(ks[4], (n_pool, PAGE_SIZE, B_KV_HEADS, B_HD), 1.0)
    cache_v = nrm(ks[5], (n_pool, PAGE_SIZE, B_KV_HEADS, B_HD), 1.0)
    page_table = jax.random.permutation(ks[6], n_pool)[:DEC_BATCH * n_pages].reshape(DEC_BATCH, n_pages).astype(jnp.int32)
    ln_g = 1.0 + nrm(ks[7], (DEPTH, 2, D_MODEL), 0.02)
    ln_b = nrm(ks[8], (DEPTH, 2, D_MODEL), 0.02)
    a_w_in = nrm(ks[9], (N_A_LAYERS, D_MODEL, A_IN_W), D_MODEL ** -0.5)
    a_conv = nrm(ks[10], (N_A_LAYERS, CONV_W, A_CONV_DIM), CONV_W ** -0.5)
    a_log_decay = jnp.log(jax.random.uniform(ks[11], (N_A_LAYERS, A_HEADS), F32, 1.0, 16.0))
    dt = jnp.exp(jax.random.uniform(ks[12], (N_A_LAYERS, A_HEADS), F32, math.log(1e-3), math.log(1e-1)))
    a_dt_bias = dt + jnp.log(-jnp.expm1(-dt))
    a_norm = 1.0 + nrm(ks[13], (N_A_LAYERS, A_DV), 0.02)
    a_w_out = nrm(ks[14], (N_A_LAYERS, A_V_W, D_MODEL), (A_V_W ** -0.5) * DEEPNORM_BETA)
    kv_w_k = nrm(ks[15], (D_MODEL, B_KV_HEADS * B_HD), D_MODEL ** -0.5)
    kv_w_v = nrm(ks[16], (D_MODEL, B_KV_HEADS * B_HD), (D_MODEL ** -0.5) * DEEPNORM_BETA)
    b_w_q = nrm(ks[17], (N_B_LAYERS, D_MODEL, B_HEADS * B_HD), D_MODEL ** -0.5)
    b_w_o = nrm(ks[18], (N_B_LAYERS, B_HEADS * B_HD, D_MODEL), ((B_HEADS * B_HD) ** -0.5) * DEEPNORM_BETA)
    ffn_w_gate = nrm(ks[19], (DEPTH, D_MODEL, D_FF), D_MODEL ** -0.5)
    ffn_w_up = nrm(ks[20], (DEPTH, D_MODEL, D_FF), (D_MODEL ** -0.5) * DEEPNORM_BETA)
    ffn_w_down = nrm(ks[21], (DEPTH, D_FF, D_MODEL), (D_FF ** -0.5) * DEEPNORM_BETA)
    return {'x_prompt': x_prompt, 'x_sample': x_sample, 'state_conv': state_conv,
            'state_delta': state_delta, 'cache_k': cache_k, 'cache_v': cache_v,
            'page_table': page_table, 'ln_g': ln_g, 'ln_b': ln_b, 'a_w_in': a_w_in,
            'a_conv': a_conv, 'a_log_decay': a_log_decay, 'a_dt_bias': a_dt_bias,
            'a_norm': a_norm, 'a_w_out': a_w_out, 'kv_w_k': kv_w_k, 'kv_w_v': kv_w_v,
            'b_w_q': b_w_q, 'b_w_o': b_w_o, 'ffn_w_gate': ffn_w_gate, 'ffn_w_up': ffn_w_up,
            'ffn_w_down': ffn_w_down}


def reference(x_prompt, x_sample, state_conv, state_delta, cache_k, cache_v, page_table,
              ln_g, ln_b, a_w_in, a_conv, a_log_decay, a_dt_bias, a_norm, a_w_out,
              kv_w_k, kv_w_v, b_w_q, b_w_o, ffn_w_gate, ffn_w_up, ffn_w_down):
    weights = (ln_g, ln_b, a_w_in, a_conv, a_log_decay, a_dt_bias, a_norm, a_w_out,
               kv_w_k, kv_w_v, b_w_q, b_w_o, ffn_w_gate, ffn_w_up, ffn_w_down)
    bp, tp, _ = x_prompt.shape
    p_pos = jnp.arange(tp, dtype=jnp.int32)
    p_conv0 = jnp.zeros((N_A_LAYERS, bp, CONV_W - 1, A_CONV_DIM), x_prompt.dtype)
    p_delta0 = jnp.zeros((N_A_LAYERS, bp, A_HEADS, A_DK, A_DV), F32)
    y_prompt, p_conv, p_delta, p_k, p_v = trunk(x_prompt, p_pos, p_conv0, p_delta0, True, moba_prompt, *weights)
    past_len = page_table.shape[1] * PAGE_SIZE
    s_pos = past_len + jnp.arange(x_sample.shape[1], dtype=jnp.int32)

    def attend_sample(q, k_new, v_new):
        return moba_sample(q, k_new, v_new, cache_k, cache_v, page_table)

    y_sample, s_conv, s_delta, s_k, s_v = trunk(x_sample, s_pos, state_conv, state_delta, False, attend_sample, *weights)
    return (y_prompt, y_sample, p_conv, p_delta, p_k, p_v, s_conv, s_delta, s_k, s_v)
```

```cpp
#include <hip/hip_runtime.h>
#include <cstdio>
#include <cstdint>
namespace pg8 {
#define PG8_LAS __attribute__((address_space(3)))
typedef unsigned short bf16_t;
typedef short bf16x8 __attribute__((ext_vector_type(8)));
typedef float f32x4 __attribute__((ext_vector_type(4)));
typedef unsigned u32x4 __attribute__((ext_vector_type(4)));
constexpr int BM = 256, BK = 64, HALF = 128, HTB = HALF * BK * 2  , STAGE_BYTES = 8 * HTB, NXCD = 8, WGM = 8;

__host__ __device__ __forceinline__ int lds_byte(int r, int c) { const int st = (r >> 4) * 2 + (c >> 5), rr = r & 15, cc = c & 31, ob = rr * 64 + cc * 2; return st * 1024 + (ob ^ (((ob >> 9) & 1) << 5)); }
__host__ __device__ __forceinline__ void stage_rc(int b, int& R, int& C) { const int st = b / 1024, sb = b % 1024, swz = sb ^ (((sb >> 9) & 1) << 5); R = (st >> 1) * 16 + swz / 64; C = (st & 1) * 32 + (swz % 64) / 2; }
__host__ __device__ __forceinline__ int perm32(int rho) { const int n = rho >> 4, i = rho & 15; return 8 * (i >> 2) + 4 * n + (i & 3); }

struct Unit { int pm, pn; };
struct Gemm { const bf16_t* A; const bf16_t* Bt; int M, N, K; };

struct StaticOrder {
    int nM, nN, nwg, G, c;
    __host__ __device__ void init(int M, int N, int G_, int c_) { nM = M / BM; nN = N / BM; nwg = nM * nN; G = G_; c = c_; }
    __host__ __device__ bool next(int i, Unit& u) const {
        const long L = (long)i * G + c; if (L >= nwg) return false;
        int wgid = (int)L; { const int q = nwg / NXCD, r = nwg % NXCD, xcd = wgid % NXCD, off = wgid / NXCD; wgid = (xcd < r ? xcd * (q + 1) : r * (q + 1) + (xcd - r) * q) + off; }
        const int nig = WGM * nN, gid = wgid / nig, fm = gid * WGM, gsz = (nM - fm) < WGM ? (nM - fm) : WGM;
        u.pm = fm + ((wgid % nig) % gsz); u.pn = (wgid % nig) / gsz; return true;
    }
    __device__ __forceinline__ void a_ready(const Unit&) const {}
    __device__ __forceinline__ void done(const Unit&) const {}
};

__device__ __forceinline__ unsigned cvt_pk_bf16(float lo, float hi) { unsigned r; asm volatile("v_cvt_pk_bf16_f32 %0, %1, %2" : "=v"(r) : "v"(lo), "v"(hi)); return r; }
typedef float f32x2 __attribute__((ext_vector_type(2)));
__device__ __forceinline__ f32x2 gelu_pk(f32x2 v) {
    const f32x2 av = __builtin_elementwise_abs(v), d = av * 0.2316418882f + 1.0f;
    f32x2 t; t.x = __builtin_amdgcn_rcpf(d.x); t.y = __builtin_amdgcn_rcpf(d.y);
    f32x2 q = t * 0.5307027145f + (-0.7265760135f); q = q * t + 0.7107068705f; q = q * t + (-0.142248368f); q = q * t + 0.127414796f; q = q * t;
    const f32x2 s = (v * v) * (-0.72134752044f);
    f32x2 e; e.x = __builtin_amdgcn_exp2f(s.x); e.y = __builtin_amdgcn_exp2f(s.y);
    const f32x2 m = v * (q * e), r = v - m;
    f32x2 o; o.x = v.x < 0.f ? m.x : r.x; o.y = v.y < 0.f ? m.y : r.y; return o;
}

template <int ACT  > struct EpiBf16 {
    static constexpr bool PERM = true, AFTER_DRAIN = false; static_assert(ACT == 0 || ACT == 1, "EpiBf16: ACT is 0 (none) or 1 (gelu_pk)");
    bf16_t* O; int ldc; const float* bias; int split_cols; size_t split_stride; float scale0;
    __device__ __forceinline__ void operator()(const f32x4 (&acc)[2][2][4][2], const Unit& u, int wr, int wc, int fr, int fq) const {
        const int row0 = u.pm * BM + wr * 64 + fr; int colt = u.pn * BM; bf16_t* base = O;
        float sc = 1.f; if (split_cols) { const int t = colt / split_cols; base += (size_t)t * split_stride; colt -= t * split_cols; if (t == 0) sc = scale0; }
        const int col0 = colt + wc * 32 + 8 * fq, bcol0 = u.pn * BM + wc * 32 + 8 * fq;
        f32x4 bv[2][2];
#pragma unroll
        for (int bj = 0; bj < 2; ++bj)
#pragma unroll
            for (int n = 0; n < 2; ++n) bv[bj][n] = bias ? *(const f32x4*)(bias + bcol0 + bj * HALF + 4 * n) : (f32x4){0.f, 0.f, 0.f, 0.f};
#pragma unroll
        for (int ai = 0; ai < 2; ++ai)
#pragma unroll
            for (int m = 0; m < 4; ++m) { bf16_t* rowp = base + (size_t)(row0 + ai * HALF + m * 16) * ldc + col0;
#pragma unroll
                for (int bj = 0; bj < 2; ++bj) { f32x4 v0 = acc[ai][bj][m][0] + bv[bj][0], v1 = acc[ai][bj][m][1] + bv[bj][1];
                    if (ACT == 1) { f32x2 a = gelu_pk((f32x2){v0[0], v0[1]}), b = gelu_pk((f32x2){v0[2], v0[3]}), c = gelu_pk((f32x2){v1[0], v1[1]}), d = gelu_pk((f32x2){v1[2], v1[3]});
                        v0 = (f32x4){a.x, a.y, b.x, b.y}; v1 = (f32x4){c.x, c.y, d.x, d.y}; }
                    v0 = v0 * sc; v1 = v1 * sc; u32x4 w; w.x = cvt_pk_bf16(v0[0], v0[1]); w.y = cvt_pk_bf16(v0[2], v0[3]); w.z = cvt_pk_bf16(v1[0], v1[1]); w.w = cvt_pk_bf16(v1[2], v1[3]);
                    *(u32x4*)(rowp + bj * HALF) = w; } }
    }
};

struct PanelStats {
    unsigned* xbuf;
    unsigned* cnt;
    unsigned* tmo;
    int ntn; float eps;
    unsigned code;
    __device__ __forceinline__ bool run(const f32x4 (&v)[2][2][4][2], const Unit& u, int wr, int wc, int fr, int fq, PG8_LAS unsigned char* lds, int wid, int lane) const {
        typedef float f32x2v __attribute__((ext_vector_type(2)));
        PG8_LAS f32x2v* P = (PG8_LAS f32x2v*)lds;
        PG8_LAS f32x2v* S = (PG8_LAS f32x2v*)(lds + 8192);
        PG8_LAS unsigned* flag = (PG8_LAS unsigned*)(lds + 8192 + 2048);
#pragma unroll
        for (int ai = 0; ai < 2; ++ai)
#pragma unroll
            for (int m = 0; m < 4; ++m) {
                float s = 0.f;
#pragma unroll
                for (int bj = 0; bj < 2; ++bj)
#pragma unroll
                    for (int n = 0; n < 2; ++n) { const f32x4 x = v[ai][bj][m][n]; s += (x[0] + x[1]) + (x[2] + x[3]); }
                s += __shfl_xor(s, 16); s += __shfl_xor(s, 32);
                const float mw = s * (1.0f / 64.0f); float q = 0.f;
#pragma unroll
                for (int bj = 0; bj < 2; ++bj)
#pragma unroll
                    for (int n = 0; n < 2; ++n) { const f32x4 d = v[ai][bj][m][n] - mw; q += (d[0] * d[0] + d[1] * d[1]) + (d[2] * d[2] + d[3] * d[3]); }
                q += __shfl_xor(q, 16); q += __shfl_xor(q, 32);
                if (fq == 0) P[(ai * HALF + wr * 64 + m * 16 + fr) * 4 + wc] = (f32x2v){mw, q};
            }
        asm volatile("s_waitcnt lgkmcnt(0)" ::: "memory"); __builtin_amdgcn_s_barrier(); asm volatile("" ::: "memory");
#if defined(BROKEN_EXCHANGE_NO_WAIT)
#warning BROKEN CONTROL BUILD: the row-statistics exchange does not wait; results are wrong by design
        if (blockIdx.x >= 64) { const long long t0_ = clock64(); while (clock64() - t0_ < 60000) __builtin_amdgcn_s_sleep(8); }
#endif
        const int row = wid * 32 + (lane & 31);
        if (lane < 32) {
            const f32x2v a = P[row * 4 + 0], b = P[row * 4 + 1], c = P[row * 4 + 2], d = P[row * 4 + 3];
            const float mt = (a.x + b.x + c.x + d.x) * 0.25f;
            const float da = a.x - mt, db = b.x - mt, dc = c.x - mt, dd = d.x - mt;
            const float m2 = (a.y + b.y) + (c.y + d.y) + 64.0f * ((da * da + db * db) + (dc * dc + dd * dd));
            unsigned long long* slot = (unsigned long long*)xbuf + ((size_t)(u.pm * BM + row) * 4 + u.pn);
            __hip_atomic_store(slot, ((unsigned long long)__float_as_uint(m2) << 32) | __float_as_uint(mt), __ATOMIC_RELAXED, __HIP_MEMORY_SCOPE_AGENT);
        }
        asm volatile("s_waitcnt vmcnt(0)" ::: "memory");
        if (lane == 0) __hip_atomic_fetch_add(cnt + 64 * u.pm, 1u, __ATOMIC_RELAXED, __HIP_MEMORY_SCOPE_AGENT);
        if (wid == 0) {
            bool dead = false; const unsigned long long t0 = __builtin_amdgcn_s_memrealtime(); const unsigned want = 8u * (unsigned)ntn;
            for (;;) {
#if defined(BROKEN_EXCHANGE_NO_WAIT)
                break;
#endif
                if ((unsigned)__builtin_amdgcn_readfirstlane(__hip_atomic_load(cnt + 64 * u.pm, __ATOMIC_RELAXED, __HIP_MEMORY_SCOPE_AGENT)) >= want) break;
                if (__builtin_amdgcn_s_memrealtime() - t0 > 2000000ull) {
                    if (lane == 0) { unsigned expect = 0u; __hip_atomic_compare_exchange_strong(tmo + 1, &expect, code | (unsigned)(u.pm & 0xff), __ATOMIC_RELAXED, __ATOMIC_RELAXED, __HIP_MEMORY_SCOPE_AGENT);
                                     __hip_atomic_store(tmo, 1u, __ATOMIC_RELAXED, __HIP_MEMORY_SCOPE_AGENT); }
                    dead = true; break; }
                __builtin_amdgcn_s_sleep(2);
            }
            __builtin_amdgcn_fence(__ATOMIC_ACQUIRE, "agent");
            if (lane == 0) flag[0] = dead ? 1u : 0u;
        }
        asm volatile("s_waitcnt vmcnt(0) lgkmcnt(0)" ::: "memory"); __builtin_amdgcn_s_barrier(); asm volatile("" ::: "memory");
        const bool bad = flag[0] != 0u;
        if (lane < 32) {
            const unsigned long long* slot = (const unsigned long long*)xbuf + (size_t)(u.pm * BM + row) * 4; float mt[4], m2[4]; float ms = 0.f;
#pragma unroll
            for (int t = 0; t < 4; ++t) { if (t < ntn) { const unsigned long long w = __hip_atomic_load(slot + t, __ATOMIC_RELAXED, __HIP_MEMORY_SCOPE_AGENT); mt[t] = __uint_as_float((unsigned)w); m2[t] = __uint_as_float((unsigned)(w >> 32)); } else { mt[t] = 0.f; m2[t] = 0.f; } ms += mt[t]; }
            const float mean = ms / (float)ntn; float q = 0.f;
#pragma unroll
            for (int t = 0; t < 4; ++t) if (t < ntn) { const float dm = mt[t] - mean; q += m2[t] + 256.0f * dm * dm; }
            S[row] = (f32x2v){mean, 1.0f / sqrtf(q / (256.0f * (float)ntn) + eps)};
        }
        asm volatile("s_waitcnt lgkmcnt(0)" ::: "memory"); __builtin_amdgcn_s_barrier(); asm volatile("" ::: "memory");
        return bad;
    }
};
struct EpiLnRes {
    static constexpr bool PERM = false, AFTER_DRAIN = true;
    const float* base; float* out; int ldc; const float* bias; PanelStats st; unsigned poison;
    __device__ __forceinline__ void fused(f32x4 (&acc)[2][2][4][2], const Unit& u, int wr, int wc, int fr, int fq, PG8_LAS unsigned char* lds, int wid, int lane) const {
        typedef float f32x2v __attribute__((ext_vector_type(2)));
        const PG8_LAS f32x2v* S = (const PG8_LAS f32x2v*)(lds + 8192);
        const int col0 = u.pn * BM + wc * 32 + 4 * fq;
#pragma unroll
        for (int bj = 0; bj < 2; ++bj)
#pragma unroll
            for (int n = 0; n < 2; ++n) { const f32x4 bv = bias ? *(const f32x4*)(bias + col0 + bj * HALF + n * 16) : (f32x4){0.f, 0.f, 0.f, 0.f};
#pragma unroll
                for (int ai = 0; ai < 2; ++ai)
#pragma unroll
                    for (int m = 0; m < 4; ++m) acc[ai][bj][m][n] += bv; }
        f32x4 pre[4][2][2];
#pragma unroll
        for (int m = 0; m < 4; ++m) { const size_t off = (size_t)(u.pm * BM + wr * 64 + m * 16 + fr) * ldc + col0;
#pragma unroll
            for (int bj = 0; bj < 2; ++bj)
#pragma unroll
                for (int n = 0; n < 2; ++n) pre[m][bj][n] = *(const f32x4*)(base + off + bj * HALF + n * 16); }
        const bool bad = st.run(acc, u, wr, wc, fr, fq, lds, wid, lane) || poison != 0u;
        const float qnan = __builtin_nanf("");
#pragma unroll
        for (int ai = 0; ai < 2; ++ai)
#pragma unroll
            for (int m = 0; m < 4; ++m) { const int r = ai * HALF + wr * 64 + m * 16 + fr; const f32x2v sr = S[r]; const size_t off = (size_t)(u.pm * BM + r) * ldc + col0;
#pragma unroll
                for (int bj = 0; bj < 2; ++bj)
#pragma unroll
                    for (int n = 0; n < 2; ++n) { const f32x4 bs = ai == 0 ? pre[m][bj][n] : *(const f32x4*)(base + off + bj * HALF + n * 16); f32x4 o = bs + (acc[ai][bj][m][n] - sr.x) * sr.y;
                        if (bad) o = (f32x4){qnan, qnan, qnan, qnan}; *(f32x4*)(out + off + bj * HALF + n * 16) = o; }
                if (m & 1) asm volatile("" ::: "memory"); }
    }
};
struct EpiLnResLn {
    static constexpr bool PERM = false, AFTER_DRAIN = true;
    const float* base; float* out; bf16_t* xn; int ldc; const float* bias; PanelStats st1, st2; unsigned poison;
    __device__ __forceinline__ void fused(f32x4 (&acc)[2][2][4][2], const Unit& u, int wr, int wc, int fr, int fq, PG8_LAS unsigned char* lds, int wid, int lane) const {
        typedef float f32x2v __attribute__((ext_vector_type(2))); typedef unsigned u32x2v __attribute__((ext_vector_type(2)));
        const PG8_LAS f32x2v* S = (const PG8_LAS f32x2v*)(lds + 8192);
        const int col0 = u.pn * BM + wc * 32 + 4 * fq;
#pragma unroll
        for (int bj = 0; bj < 2; ++bj)
#pragma unroll
            for (int n = 0; n < 2; ++n) { const f32x4 bv = bias ? *(const f32x4*)(bias + col0 + bj * HALF + n * 16) : (f32x4){0.f, 0.f, 0.f, 0.f};
#pragma unroll
                for (int ai = 0; ai < 2; ++ai)
#pragma unroll
                    for (int m = 0; m < 4; ++m) acc[ai][bj][m][n] += bv; }
        bool bad = st1.run(acc, u, wr, wc, fr, fq, lds, wid, lane) || poison != 0u;
        const float qnan = __builtin_nanf("");
#pragma unroll
        for (int ai = 0; ai < 2; ++ai)
#pragma unroll
            for (int m = 0; m < 4; ++m) { const int r = ai * HALF + wr * 64 + m * 16 + fr; const f32x2v sr = S[r]; const size_t off = (size_t)(u.pm * BM + r) * ldc + col0;
#pragma unroll
                for (int bj = 0; bj < 2; ++bj)
#pragma unroll
                    for (int n = 0; n < 2; ++n) { const f32x4 bs = *(const f32x4*)(base + off + bj * HALF + n * 16); acc[ai][bj][m][n] = bs + (acc[ai][bj][m][n] - sr.x) * sr.y; }
                asm volatile("" : "+v"(acc[ai][0][m][0]), "+v"(acc[ai][0][m][1]), "+v"(acc[ai][1][m][0]), "+v"(acc[ai][1][m][1]));
                if (m & 1) asm volatile("" ::: "memory"); }
        const bool bad1 = bad;
        bad = st2.run(acc, u, wr, wc, fr, fq, lds, wid, lane) || bad;
#pragma unroll
        for (int ai = 0; ai < 2; ++ai)
#pragma unroll
            for (int m = 0; m < 4; ++m) { const int r = ai * HALF + wr * 64 + m * 16 + fr; const f32x2v sr = S[r]; const size_t off = (size_t)(u.pm * BM + r) * ldc + col0;
#pragma unroll
                for (int bj = 0; bj < 2; ++bj)
#pragma unroll
                    for (int n = 0; n < 2; ++n) { const f32x4 x1 = acc[ai][bj][m][n]; *(f32x4*)(out + off + bj * HALF + n * 16) = bad1 ? (f32x4){qnan, qnan, qnan, qnan} : x1;
                        const f32x4 o = (x1 - sr.x) * sr.y; u32x2v w; w.x = cvt_pk_bf16(o[0], o[1]); w.y = cvt_pk_bf16(o[2], o[3]);
                        if (bad) { w.x = 0x7fc07fc0u; w.y = 0x7fc07fc0u; } *(u32x2v*)(xn + off + bj * HALF + n * 16) = w; }
                asm volatile("" ::: "memory"); }
    }
};

template <class Epi, class Sched, bool ALIGN_EPI = false, bool SP2 = false>
__device__ __forceinline__ void gemm_phase(PG8_LAS unsigned char* lds, const Gemm g, const Sched& S, const Epi& E, int tid_arg) {
    const int tid = tid_arg, wid = __builtin_amdgcn_readfirstlane(tid >> 6), lane = tid & 63, wr = wid >> 2, wc = wid & 3, fr = lane & 15, fq = lane >> 4;
    const int K = g.K, nt = K / BK;
    unsigned voffA[2], voffB[2];
#pragma unroll
    for (int i = 0; i < 2; ++i) { int R, C; stage_rc(tid * 16 + i * 8192, R, C); const int Rb = Epi::PERM ? ((R & ~31) + perm32(R & 31)) : R;
        voffA[i] = (unsigned)(R * K + C) * 2u; voffB[i] = (unsigned)(Rb * K + C) * 2u; }
    const size_t kstep = (size_t)(BK * 2);
    const size_t hstep = (size_t)HALF * K * 2;
    const size_t tstep = 2 * hstep;
    const unsigned ldsw = (unsigned)wid * 1024u;
    const int aoff = lds_byte(wr * 64 + fr, fq * 8), boff = lds_byte(wc * 32 + fr, fq * 8);
#define PG8_SA(b, h) (((b) * 2 + (h)) * HTB)
#define PG8_SB(b, h) ((4 + (b) * 2 + (h)) * HTB)
#define PG8_STAGE(bufoff, gbase, voff) do { _Pragma("unroll") for (int _i = 0; _i < 2; ++_i) \
        __builtin_amdgcn_global_load_lds((const unsigned*)((const char*)(gbase) + (voff)[_i]), (PG8_LAS unsigned*)(lds + (bufoff) + ldsw + _i * 8192), 16, 0, 0); } while (0)
#define PG8_LDA(dst, b, h) do { _Pragma("unroll") for (int m = 0; m < 4; ++m) _Pragma("unroll") for (int k = 0; k < 2; ++k) dst[m][k] = *(const PG8_LAS bf16x8*)(lds + PG8_SA(b, h) + aoff + m * 2048 + k * 1024); } while (0)
#define PG8_LDB(dst, b, h) do { _Pragma("unroll") for (int n = 0; n < 2; ++n) _Pragma("unroll") for (int k = 0; k < 2; ++k) dst[n][k] = *(const PG8_LAS bf16x8*)(lds + PG8_SB(b, h) + boff + n * 2048 + k * 1024); } while (0)
#define PG8_MMA(ai, bj, At, Bt) do { __builtin_amdgcn_s_setprio(1); _Pragma("unroll") for (int m = 0; m < 4; ++m) _Pragma("unroll") for (int n = 0; n < 2; ++n) _Pragma("unroll") for (int k = 0; k < 2; ++k) \
        acc[ai][bj][m][n] = __builtin_amdgcn_mfma_f32_16x16x32_bf16(Bt[n][k], At[m][k], acc[ai][bj][m][n], 0, 0, 0); __builtin_amdgcn_s_setprio(0); } while (0)
#define PG8_WAIT_V(n) asm volatile("s_waitcnt vmcnt(" #n ")" ::: "memory")
#define PG8_WAIT_L(n) asm volatile("s_waitcnt lgkmcnt(" #n ")" ::: "memory")
#define PG8_BAR __builtin_amdgcn_s_barrier()
#define PG8_SCHED __builtin_amdgcn_sched_barrier(0)
    Unit cur, nxt; int ui = 0;
    if (!S.next(0, cur)) return;
    f32x4 acc[2][2][4][2];
#pragma unroll
    for (int a = 0; a < 2; ++a)
#pragma unroll
        for (int b = 0; b < 2; ++b)
#pragma unroll
            for (int m = 0; m < 4; ++m)
#pragma unroll
                for (int n = 0; n < 2; ++n) acc[a][b][m][n] = (f32x4){0.f, 0.f, 0.f, 0.f};
    bf16x8 At[4][2], B0[2][2], B1[2][2];
    const char* cA = (const char*)g.A + (size_t)cur.pm * tstep; const char* cB = (const char*)g.Bt + (size_t)cur.pn * tstep;
    S.a_ready(cur);
    if constexpr (SP2) {
        PG8_STAGE(PG8_SB(0, 0), cB, voffB); PG8_STAGE(PG8_SB(0, 1), cB + hstep, voffB); PG8_STAGE(PG8_SA(0, 0), cA, voffA); PG8_STAGE(PG8_SA(0, 1), cA + hstep, voffA);
        if (wr == 1) PG8_BAR;
        PG8_WAIT_V(2); PG8_BAR;
        PG8_STAGE(PG8_SB(1, 0), cB + kstep, voffB); PG8_STAGE(PG8_SA(1, 0), cA + kstep, voffA); PG8_STAGE(PG8_SB(1, 1), cB + hstep + kstep, voffB);
        PG8_WAIT_V(6); PG8_BAR;
    } else {
        PG8_STAGE(PG8_SB(0, 0), cB, voffB); PG8_STAGE(PG8_SA(0, 0), cA, voffA); PG8_STAGE(PG8_SB(0, 1), cB + hstep, voffB); PG8_STAGE(PG8_SA(0, 1), cA + hstep, voffA);
        if (wr == 1) PG8_BAR;
        PG8_WAIT_V(4); PG8_BAR;
        PG8_STAGE(PG8_SB(1, 0), cB + kstep, voffB); PG8_STAGE(PG8_SA(1, 0), cA + kstep, voffA); PG8_STAGE(PG8_SB(1, 1), cB + hstep + kstep, voffB);
        PG8_WAIT_V(6); PG8_BAR;
    }
    for (;;) {
        const bool has_next = S.next(ui + 1, nxt);
        const char* nA = has_next ? (const char*)g.A + (size_t)nxt.pm * tstep : cA; const char* nB = has_next ? (const char*)g.Bt + (size_t)nxt.pn * tstep : cB;
        for (int t = 0; t < nt; t += 2) {
            const bool last = (t == nt - 2);
            const char* a1 = cA + (size_t)(t + 1) * kstep;
            const char* a2 = last ? nA : cA + (size_t)(t + 2) * kstep; const char* b2 = last ? nB : cB + (size_t)(t + 2) * kstep;
            const char* a3 = a2 + kstep; const char* b3 = b2 + kstep;
            if (last && has_next) S.a_ready(nxt);
            if constexpr (SP2) {
            PG8_LDB(B0, 0, 0); PG8_LDB(B1, 0, 1); PG8_SCHED; PG8_LDA(At, 0, 0); PG8_STAGE(PG8_SA(1, 1), a1 + hstep, voffA);
            PG8_WAIT_V(8); PG8_WAIT_L(0); PG8_BAR; PG8_MMA(0, 0, At, B0); PG8_MMA(0, 1, At, B1); PG8_BAR; PG8_SCHED;
            PG8_LDA(At, 0, 1); PG8_STAGE(PG8_SB(0, 0), b2, voffB); PG8_STAGE(PG8_SB(0, 1), b2 + hstep, voffB); PG8_STAGE(PG8_SA(0, 0), a2, voffA);
            PG8_WAIT_V(8); PG8_WAIT_L(0); PG8_BAR; PG8_MMA(1, 0, At, B0); PG8_MMA(1, 1, At, B1); PG8_BAR; PG8_SCHED;
            PG8_LDB(B0, 1, 0); PG8_LDB(B1, 1, 1); PG8_SCHED; PG8_LDA(At, 1, 0); PG8_STAGE(PG8_SA(0, 1), a2 + hstep, voffA);
            PG8_WAIT_V(8); PG8_WAIT_L(0); PG8_BAR; PG8_MMA(0, 0, At, B0); PG8_MMA(0, 1, At, B1); PG8_BAR; PG8_SCHED;
            PG8_LDA(At, 1, 1); PG8_STAGE(PG8_SB(1, 0), b3, voffB); PG8_STAGE(PG8_SB(1, 1), b3 + hstep, voffB); PG8_STAGE(PG8_SA(1, 0), a3, voffA);
            PG8_WAIT_V(8); PG8_WAIT_L(0); PG8_BAR; PG8_MMA(1, 0, At, B0); PG8_MMA(1, 1, At, B1); PG8_BAR; PG8_SCHED;
            } else {
            PG8_LDB(B0, 0, 0); PG8_SCHED; PG8_LDA(At, 0, 0); PG8_STAGE(PG8_SA(1, 1), a1 + hstep, voffA);
            PG8_WAIT_L(8); PG8_BAR; PG8_WAIT_L(0); PG8_MMA(0, 0, At, B0); PG8_BAR; PG8_SCHED;
            PG8_LDB(B1, 0, 1); PG8_STAGE(PG8_SB(0, 0), b2, voffB);
            PG8_BAR; PG8_WAIT_L(0); PG8_MMA(0, 1, At, B1); PG8_BAR;
            PG8_LDA(At, 0, 1); PG8_STAGE(PG8_SA(0, 0), a2, voffA);
            PG8_BAR; PG8_WAIT_L(0); PG8_MMA(1, 0, At, B0); PG8_BAR; PG8_SCHED;
            PG8_STAGE(PG8_SB(0, 1), b2 + hstep, voffB);
            PG8_WAIT_V(6); PG8_BAR; PG8_MMA(1, 1, At, B1); PG8_BAR;
            PG8_LDB(B0, 1, 0); PG8_SCHED; PG8_LDA(At, 1, 0); PG8_STAGE(PG8_SA(0, 1), a2 + hstep, voffA);
            PG8_WAIT_L(8); PG8_BAR; PG8_WAIT_L(0); PG8_MMA(0, 0, At, B0); PG8_BAR; PG8_SCHED;
            PG8_LDB(B1, 1, 1); PG8_STAGE(PG8_SB(1, 0), b3, voffB);
            PG8_BAR; PG8_WAIT_L(0); PG8_MMA(0, 1, At, B1); PG8_BAR;
            PG8_LDA(At, 1, 1); PG8_STAGE(PG8_SA(1, 0), a3, voffA);
            PG8_BAR; PG8_WAIT_L(0); PG8_MMA(1, 0, At, B0); PG8_BAR; PG8_SCHED;
            PG8_STAGE(PG8_SB(1, 1), b3 + hstep, voffB);
            PG8_WAIT_V(6); PG8_BAR; PG8_MMA(1, 1, At, B1); PG8_BAR;
            }
        }
        if constexpr (ALIGN_EPI) { if (wr == 0) PG8_BAR; }
        if constexpr (!Epi::AFTER_DRAIN) { E(acc, cur, wr, wc, fr, fq); S.done(cur); }
        if (!has_next) break;
#pragma unroll
        for (int a = 0; a < 2; ++a)
#pragma unroll
            for (int b = 0; b < 2; ++b)
#pragma unroll
                for (int m = 0; m < 4; ++m)
#pragma unroll
                    for (int n = 0; n < 2; ++n) acc[a][b][m][n] = (f32x4){0.f, 0.f, 0.f, 0.f};
        cur = nxt; cA = nA; cB = nB; ++ui;
        if constexpr (ALIGN_EPI) { if (wr == 1) PG8_BAR; }
    }
    PG8_WAIT_V(0);
    if constexpr (!ALIGN_EPI) { if (wr == 0) PG8_BAR; }
    PG8_BAR;
    if constexpr (Epi::AFTER_DRAIN) { E.fused(acc, cur, wr, wc, fr, fq, lds, wid, lane); S.done(cur); }
#undef PG8_SA
#undef PG8_SB
#undef PG8_STAGE
#undef PG8_LDA
#undef PG8_LDB
#undef PG8_MMA
#undef PG8_WAIT_V
#undef PG8_WAIT_L
#undef PG8_BAR
#undef PG8_SCHED
}
}
#define GAS __attribute__((address_space(1)))
#define LAS __attribute__((address_space(3)))
typedef unsigned short bf16;
typedef unsigned v4u __attribute__((ext_vector_type(4)));
typedef float f32x4 __attribute__((ext_vector_type(4)));
typedef short bf16x8 __attribute__((ext_vector_type(8)));
typedef GAS unsigned gu32;
typedef GAS unsigned long long gu64;
#define RLX_AGENT __ATOMIC_RELAXED, __HIP_MEMORY_SCOPE_AGENT
#define LDS_WAIT() asm volatile("s_waitcnt lgkmcnt(0)" ::: "memory")
#define VM_WAIT() asm volatile("s_waitcnt vmcnt(0)" ::: "memory")
__device__ __forceinline__ unsigned long long rt() { return __builtin_amdgcn_s_memrealtime(); }
__device__ __forceinline__ unsigned f2bf(float f) { unsigned u = __builtin_bit_cast(unsigned, f); return (u + 0x7fffu + ((u >> 16) & 1u)) >> 16; }
typedef float f32x2_cv __attribute__((ext_vector_type(2))); typedef __bf16 bf16x2_cv __attribute__((ext_vector_type(2)));
__device__ __forceinline__ unsigned pk2(float lo, float hi) { f32x2_cv v = {lo, hi}; bf16x2_cv b = __builtin_convertvector(v, bf16x2_cv); return __builtin_bit_cast(unsigned, b); }

#define XB_TMO      128
#define XB_XCNT(j)  (256  + 64 * (j))
#define XB_XSUB(j)  (1280 + 64 * (j))
#define XB_XGEN(j)  (2304 + 64 * (j))
#define XB_TOP      3328
#define XB_TOPGEN   3392
#define XCD_BAR_WORDS 3456
#define XB_SPIN_CAP (1u << 18)

__device__ __forceinline__ unsigned xb_ld(unsigned* p)              { return __hip_atomic_load(p, __ATOMIC_RELAXED, __HIP_MEMORY_SCOPE_AGENT); }
__device__ __forceinline__ unsigned xb_add(unsigned* p, unsigned v) { return __hip_atomic_fetch_add(p, v, __ATOMIC_RELAXED, __HIP_MEMORY_SCOPE_AGENT); }
__device__ __forceinline__ unsigned xb_xcc_id() { return (unsigned)__builtin_amdgcn_s_getreg((3 << 11) | 20) & 0xFu; }
#define XB_SPIN(cond, bar) do { unsigned _sp = 0; while (cond) { __builtin_amdgcn_s_sleep(1); \
    if ((++_sp & 255u) == 0u) { if (xb_ld(&(bar)[XB_TMO])) break; if (_sp > XB_SPIN_CAP) { atomicAdd(&(bar)[XB_TMO], 1u); break; } } } } while (0)

struct XcdBarrier {
    unsigned* bar; unsigned x;
    volatile LAS unsigned* st;
};

__device__ __forceinline__ XcdBarrier xcd_barrier_post(unsigned* bar, volatile LAS unsigned* st, int tid_arg) {
    XcdBarrier b; b.bar = bar; b.x = xb_xcc_id(); b.st = st;
    if (tid_arg == 0) (void)xb_add(&bar[XB_XCNT(b.x)], 1u);
    return b;
}
__device__ __forceinline__ void xcd_barrier_complete(unsigned* bar, unsigned x, unsigned& nloc, unsigned& nx) {
    const unsigned G = gridDim.x * gridDim.y * gridDim.z;
    unsigned sum, cnt, mine, sp = 0u;
    for (;;) {
        sum = 0u; cnt = 0u; mine = 0u;
#pragma unroll
        for (unsigned j = 0; j < 16; ++j) { const unsigned c = xb_ld(&bar[XB_XCNT(j)]); sum += c; cnt += (c > 0u) ? 1u : 0u; mine = (j == x) ? c : mine; }
        if (sum == G) break;
        __builtin_amdgcn_s_sleep(1);
        if ((++sp & 255u) == 0u) { if (xb_ld(&bar[XB_TMO])) break; if (sp > XB_SPIN_CAP) { atomicAdd(&bar[XB_TMO], 1u); break; } }
    }
    nloc = mine > 0u ? mine : 1u; nx = cnt > 0u ? cnt : 1u;
}

__device__ __forceinline__ void xcd_barrier(const XcdBarrier& b, int tid_arg) {
    asm volatile("s_waitcnt vmcnt(0)" ::: "memory");
    __syncthreads();
    if (tid_arg == 0) {
        unsigned* bar = b.bar;
        __builtin_amdgcn_s_waitcnt(0);
        unsigned nloc = b.st[0], nx = b.st[1];
        if (nloc == 0u) { xcd_barrier_complete(bar, b.x, nloc, nx); b.st[0] = nloc; b.st[1] = nx; }
        const unsigned old = xb_add(&bar[XB_XSUB(b.x)], 1u);
        const unsigned gen = old / nloc;
        if (old + 1u == (gen + 1u) * nloc) {
            __builtin_amdgcn_fence(__ATOMIC_RELEASE, "agent");
            asm volatile("s_waitcnt vmcnt(0)" ::: "memory");
            const unsigned og = xb_add(&bar[XB_TOP], 1u);
            const unsigned tg = og / nx;
            if (og + 1u == (tg + 1u) * nx) xb_add(&bar[XB_TOPGEN], 1u);
            else XB_SPIN(xb_ld(&bar[XB_TOPGEN]) == tg, bar);
            __builtin_amdgcn_fence(__ATOMIC_ACQUIRE, "agent");
            xb_add(&bar[XB_XGEN(b.x)], 1u);
            asm volatile("s_waitcnt vmcnt(0)" ::: "memory");
        } else {
            XB_SPIN(xb_ld(&bar[XB_XGEN(b.x)]) == gen, bar);
            __builtin_amdgcn_fence(__ATOMIC_ACQUIRE, "agent");
            asm volatile("s_waitcnt vmcnt(0)" ::: "memory");
        }
    }
    __syncthreads();
}
constexpr int NWAVES = 8, NTHR = 512;
constexpr int MP = 16384, MS = 256, MT = MP + MS, DM = 1024, SEQ = 8192;
constexpr int AINW = 4112, CONVD = 3072, NPROJ = 4096;
constexpr int FF = 2816, NGU = 5632, NQKV = 1536;
constexpr int NITEM = 2048;
constexpr float ALPHA = 1.4142135623730951f;
constexpr size_t O_Y = 0, O_PCONV = (size_t)MT * DM, O_PDELTA = O_PCONV + 18432, O_PK = O_PDELTA + 262144, O_PV = O_PK + 4194304,
                 O_SCONV = O_PV + 4194304, O_SDELTA = O_SCONV + 294912, O_SK = O_SDELTA + 4194304, O_SV = O_SK + 65536, O_END = O_SV + 65536;
constexpr size_t MiB = 1u << 20;
constexpr size_t WS_CTL = 0, CTL_ZERO_BYTES = 1 * MiB;
constexpr size_t WS_WIN = 2 * MiB, WS_WOUT = 10 * MiB, WS_WGU0 = 12 * MiB, WS_WD0 = 23 * MiB, WS_WQKV = 29 * MiB, WS_WO = 32 * MiB, WS_WGU1 = 34 * MiB, WS_WD1 = 45 * MiB;
constexpr size_t WS_ROPE = 51 * MiB, WS_AB = 54 * MiB, WS_CMEANS = 56 * MiB, WS_PMEANS = 58 * MiB, WS_GLB = 59 * MiB;
constexpr size_t WS_XB = 64 * MiB, WS_PROJ = 100 * MiB, WS_DEL = 232 * MiB, WS_VN = 376 * MiB, WS_O = 408 * MiB, WS_OG = 474 * MiB, WS_MIX = 508 * MiB,
                 WS_H = 574 * MiB, WS_HB = 640 * MiB, WS_FF = 674 * MiB, WS_X1 = 764 * MiB, WS_X1B = 830 * MiB, WS_Q = 864 * MiB, WS_KB = 897 * MiB, WS_VB = 906 * MiB,
                 WS_VTP = 915 * MiB, WS_LIST = 924 * MiB, WS_OPART = 956 * MiB, WS_ML = 1052 * MiB, WS_SLIST = 1058 * MiB, WS_SPART = 1059 * MiB, WS_END = 1064 * MiB;
constexpr int DEL_ITEM = 73728, DEL_QP = 16384, DEL_KTP = 32768, DEL_QKP = 49152, DEL_U = 57344;
constexpr int CW_BAR = 4096, CW_PCNT = 16384  , CW_SCNT = 20480  ;
constexpr int LDS_BYTES = 147456, MISC_OFF = 147456 - 256;
typedef unsigned v2u __attribute__((ext_vector_type(2)));
typedef float f32x2 __attribute__((ext_vector_type(2)));
#define DI __device__ __forceinline__
DI int lane_id() { int l; asm volatile("v_mbcnt_lo_u32_b32 %0, -1, 0\n\tv_mbcnt_hi_u32_b32 %0, -1, %0" : "=v"(l)); return l; }
DI float bflo(unsigned u) { return __uint_as_float(u << 16); }
DI float bfhi(unsigned u) { return __uint_as_float(u & 0xffff0000u); }
DI float bf2f(unsigned short u) { return __uint_as_float((unsigned)u << 16); }
DI float silu_f(float x) { return x / (1.f + __expf(-x)); }
DI float sigmoid_f(float x) { return 1.f / (1.f + __expf(-x)); }
DI float wsum(float v) {
#pragma unroll
    for (int o = 1; o < 64; o <<= 1) v += __shfl_xor(v, o);
    return v;
}
DI f32x4 mfma16(bf16x8 a, bf16x8 b, f32x4 c) { return __builtin_amdgcn_mfma_f32_16x16x32_bf16(a, b, c, 0, 0, 0); }
DI bf16x8 pack8(const float* v) { v4u r; r.x = pk2(v[0], v[1]); r.y = pk2(v[2], v[3]); r.z = pk2(v[4], v[5]); r.w = pk2(v[6], v[7]); return __builtin_bit_cast(bf16x8, r); }
DI bf16x8 pack44(f32x4 a, f32x4 b) { v4u r; r.x = pk2(a[0], a[1]); r.y = pk2(a[2], a[3]); r.z = pk2(b[0], b[1]); r.w = pk2(b[2], b[3]); return __builtin_bit_cast(bf16x8, r); }

struct Ctx {
    LAS unsigned char* lds; int tid, lane, wave, G, vcu;
    const float *x_prompt, *x_sample, *state_conv, *state_delta, *cache_k, *cache_v; const int* page_table;
    const float *ln_g, *ln_b, *a_w_in, *a_conv, *a_log, *a_dtb, *a_norm, *a_w_out, *kv_w_k, *kv_w_v, *b_w_q, *b_w_o, *w_gate, *w_up, *w_down;
    float* out; unsigned char* ws; gu32* ctl;
};
#define WSP(T, off) ((T*)(C.ws + (off)))

DI void tr_item(const float* Wsrc, int ldsrc, int col, int k0, bf16* WT, int Kd, int rowdst0, LAS float* scr, int lane) {
#pragma unroll 8
    for (int i = 0; i < 32; ++i) { const int kk = 2 * i + (lane >> 5); scr[kk * 33 + (lane & 31)] = Wsrc[(size_t)(k0 + kk) * ldsrc + col]; }
    LDS_WAIT(); asm volatile("" ::: "memory");
    const int c = lane & 7;
#pragma unroll
    for (int j = 0; j < 4; ++j) { const int n = (lane >> 3) + 8 * j; const LAS float* s = scr + (8 * c) * 33 + n;
        v4u o; o.x = pk2(s[0 * 33], s[1 * 33]); o.y = pk2(s[2 * 33], s[3 * 33]); o.z = pk2(s[4 * 33], s[5 * 33]); o.w = pk2(s[6 * 33], s[7 * 33]);
        *(GAS v4u*)(WT + (size_t)(rowdst0 + n) * Kd + k0 + 8 * c) = o; }
    LDS_WAIT(); asm volatile("" ::: "memory");
}
DI int rope_dmap(int cc) { return 4 * (cc >> 3) + (cc & 3) + 32 * ((cc >> 2) & 1); }

DI void p0_weights(const Ctx& C) {
    LAS float* scr = (LAS float*)(C.lds + C.wave * 16384);
    const int gw = C.vcu * NWAVES + C.wave, NGW = C.G * NWAVES, lane = C.lane, nl = lane & 31;
    constexpr int I_IN = 16 * 128, I_SQ = 16 * 32, I_GU = 16 * 176, I_DN = 44 * 32, I_QKV = 16 * 48;
    constexpr int NIT = I_IN + I_SQ + I_GU + I_DN + I_QKV + I_SQ + I_GU + I_DN;
    for (int it = gw; it < NIT; it += NGW) {
        int r = it;
        if (r < I_IN) { const int kb = r / 128, nb = r % 128; tr_item(C.a_w_in, AINW, nb * 32 + nl, kb * 64, WSP(bf16, WS_WIN), DM, nb * 32, scr, lane); continue; } r -= I_IN;
        if (r < I_SQ) { const int kb = r / 32, nb = r % 32; tr_item(C.a_w_out, DM, nb * 32 + nl, kb * 64, WSP(bf16, WS_WOUT), DM, nb * 32, scr, lane); continue; } r -= I_SQ;
        if (r < I_GU) { const int kb = r / 176, nb = r % 176, n0 = nb * 32, tile = n0 >> 8, w = n0 & 255;
            tr_item(w < 128 ? C.w_gate : C.w_up, FF, tile * 128 + (w & 127) + nl, kb * 64, WSP(bf16, WS_WGU0), DM, n0, scr, lane); continue; } r -= I_GU;
        if (r < I_DN) { const int kb = r / 32, nb = r % 32; tr_item(C.w_down, DM, nb * 32 + nl, kb * 64, WSP(bf16, WS_WD0), FF, nb * 32, scr, lane); continue; } r -= I_DN;
        if (r < I_QKV) { const int kb = r / 48, nb = r % 48, n0 = nb * 32; const float* src; int ld, col;
            if (n0 < 1024) { src = C.b_w_q; ld = 1024; col = (n0 & ~63) + rope_dmap((n0 & 63) + nl); }
            else if (n0 < 1280) { src = C.kv_w_k; ld = 256; col = ((n0 - 1024) & ~63) + rope_dmap((n0 & 63) + nl); }
            else { src = C.kv_w_v; ld = 256; col = n0 - 1280 + nl; }
            tr_item(src, ld, col, kb * 64, WSP(bf16, WS_WQKV), DM, n0, scr, lane); continue; } r -= I_QKV;
        if (r < I_SQ) { const int kb = r / 32, nb = r % 32; tr_item(C.b_w_o, DM, nb * 32 + nl, kb * 64, WSP(bf16, WS_WO), DM, nb * 32, scr, lane); continue; } r -= I_SQ;
        if (r < I_GU) { const int kb = r / 176, nb = r % 176, n0 = nb * 32, tile = n0 >> 8, w = n0 & 255;
            tr_item((w < 128 ? C.w_gate : C.w_up) + (size_t)DM * FF, FF, tile * 128 + (w & 127) + nl, kb * 64, WSP(bf16, WS_WGU1), DM, n0, scr, lane); continue; } r -= I_GU;
        { const int kb = r / 32, nb = r % 32; tr_item(C.w_down + (size_t)FF * DM, DM, nb * 32 + nl, kb * 64, WSP(bf16, WS_WD1), FF, nb * 32, scr, lane); }
    }
}
DI void p0_rope(const Ctx& C) {
    f32x2* tab = WSP(f32x2, WS_ROPE);
    for (int idx = C.vcu * NTHR + C.tid; idx < 8200 * 32; idx += C.G * NTHR) {
        const int pi = idx >> 5, f = idx & 31; const double pos = (double)(pi < 8192 ? pi : 16384 + (pi - 8192));
        double inv = 1.0; const double r = 0.74989420933245582730;
        for (int i = 0; i < 31; ++i) inv = (i < f) ? inv * r : inv;
        const double ang = pos * inv;
        const double n = __builtin_rint(ang * 0.63661977236758134308);
        double x = __builtin_fma(-n, 1.5707963267948965580, ang); x = __builtin_fma(-n, 6.1232339957367660e-17, x);
        const double x2 = x * x;
        double s = -1.0 / 1307674368000.0; s = s * x2 + 1.0 / 6227020800.0; s = s * x2 - 1.0 / 39916800.0; s = s * x2 + 1.0 / 362880.0; s = s * x2 - 1.0 / 5040.0; s = s * x2 + 1.0 / 120.0; s = s * x2 - 1.0 / 6.0; s = s * x2 * x + x;
        double c = 1.0 / 20922789888000.0; c = c * x2 - 1.0 / 87178291200.0; c = c * x2 + 1.0 / 479001600.0; c = c * x2 - 1.0 / 3628800.0; c = c * x2 + 1.0 / 40320.0; c = c * x2 - 1.0 / 720.0; c = c * x2 + 1.0 / 24.0; c = c * x2 - 0.5; c = c * x2 + 1.0;
        const int q = ((int)n) & 3;
        const double cs = (q == 0) ? c : (q == 1) ? -s : (q == 2) ? -c : s, sn = (q == 0) ? s : (q == 1) ? c : (q == 2) ? -s : -c;
        tab[idx] = (f32x2){(float)cs, (float)sn};
    }
}
DI void p0_x(const Ctx& C) {
    LAS float* wab = (LAS float*)C.lds;
    for (int idx = C.tid; idx < 16384; idx += NTHR) { const int k = idx >> 4, c = idx & 15; wab[c * 1024 + k] = C.a_w_in[(size_t)k * AINW + NPROJ + c]; }
    __syncthreads();
    const int gw = C.vcu * NWAVES + C.wave, NGW = C.G * NWAVES, sub = C.lane & 15, rr = C.lane >> 4;
    bf16* XB = WSP(bf16, WS_XB); float* AB = WSP(float, WS_AB);
    for (int task = gw; task < MT / 4; task += NGW) {
        const int row = task * 4 + rr; const float* xr = row < MP ? C.x_prompt + (size_t)row * DM : C.x_sample + (size_t)(row - MP) * DM;
        float acc[16];
#pragma unroll
        for (int c = 0; c < 16; ++c) acc[c] = 0.f;
#pragma unroll 4
        for (int i = 0; i < 16; ++i) { const int k = 64 * i + 4 * sub; const f32x4 xv = *(const GAS f32x4*)(xr + k);
            v2u o; o.x = pk2(xv[0], xv[1]); o.y = pk2(xv[2], xv[3]); *(GAS v2u*)(XB + (size_t)row * DM + k) = o;
#pragma unroll
            for (int c = 0; c < 16; ++c) { const f32x4 w = *(const LAS f32x4*)(wab + c * 1024 + k); acc[c] += (xv[0] * w[0] + xv[1] * w[1]) + (xv[2] * w[2] + xv[3] * w[3]); } }
#pragma unroll
        for (int c = 0; c < 16; ++c) { float v = acc[c]; v += __shfl_xor(v, 1); v += __shfl_xor(v, 2); v += __shfl_xor(v, 4); v += __shfl_xor(v, 8); acc[c] = v; }
        if (sub == 0) {
#pragma unroll
            for (int c = 0; c < 4; ++c) *(GAS f32x4*)(AB + (size_t)row * 16 + 4 * c) = (f32x4){acc[4 * c], acc[4 * c + 1], acc[4 * c + 2], acc[4 * c + 3]}; }
    }
}
DI void p0_cmeans(const Ctx& C) {
    const int gw = C.vcu * NWAVES + C.wave, NGW = C.G * NWAVES; float* cm = WSP(float, WS_CMEANS);
    for (int it = gw; it < 32 * 64; it += NGW) { const int seq = it >> 6, blk = it & 63; f32x4 a0 = {0, 0, 0, 0}, a1 = a0, a2 = a0, a3 = a0;
#pragma unroll
        for (int pg = 0; pg < 2; ++pg) { const int page = C.page_table[seq * 128 + 2 * blk + pg]; const GAS f32x4* base = (const GAS f32x4*)(C.cache_k + (size_t)page * 32768) + C.lane;
#pragma unroll 4
            for (int t = 0; t < 128; t += 4) { a0 += base[(t + 0) * 64]; a1 += base[(t + 1) * 64]; a2 += base[(t + 2) * 64]; a3 += base[(t + 3) * 64]; } }
        const f32x4 m = ((a0 + a1) + (a2 + a3)) * (1.f / 256.f);
        *(GAS f32x4*)(cm + (size_t)it * 256 + 4 * C.lane) = m; }
}
struct EpiF32 {
    static constexpr bool PERM = false, AFTER_DRAIN = false; float* O; int ldc;
    DI void operator()(const f32x4 (&acc)[2][2][4][2], const pg8::Unit& u, int wr, int wc, int fr, int fq) const {
        const int row0 = u.pm * 256 + wr * 64 + fr, col0 = u.pn * 256 + wc * 32 + 4 * fq;
#pragma unroll
        for (int ai = 0; ai < 2; ++ai)
#pragma unroll
            for (int m = 0; m < 4; ++m) { float* rp = O + (size_t)(row0 + ai * 128 + m * 16) * ldc + col0;
#pragma unroll
                for (int bj = 0; bj < 2; ++bj)
#pragma unroll
                    for (int n = 0; n < 2; ++n) *(GAS f32x4*)(rp + bj * 128 + n * 16) = acc[ai][bj][m][n]; }
    }
};
struct EpiSwiglu {
    static constexpr bool PERM = true, AFTER_DRAIN = false; bf16* O;
    DI void operator()(const f32x4 (&acc)[2][2][4][2], const pg8::Unit& u, int wr, int wc, int fr, int fq) const {
        const int row0 = u.pm * 256 + wr * 64 + fr, col0 = u.pn * 128 + wc * 32 + 8 * fq;
#pragma unroll
        for (int ai = 0; ai < 2; ++ai)
#pragma unroll
            for (int m = 0; m < 4; ++m) { bf16* rp = O + (size_t)(row0 + ai * 128 + m * 16) * FF + col0; float v[8];
#pragma unroll
                for (int n = 0; n < 2; ++n)
#pragma unroll
                    for (int e = 0; e < 4; ++e) { const float g = acc[ai][0][m][n][e], uu = acc[ai][1][m][n][e]; v[4 * n + e] = silu_f(g) * uu; }
                *(GAS bf16x8*)rp = pack8(v); }
    }
};
struct EpiQkvRope {
    static constexpr bool PERM = true, AFTER_DRAIN = false; bf16 *Q, *KB, *VB; float* out; const f32x2* tab;
    DI void operator()(const f32x4 (&acc)[2][2][4][2], const pg8::Unit& u, int wr, int wc, int fr, int fq) const {
        const int row0 = u.pm * 256 + wr * 64 + fr;
#pragma unroll
        for (int ai = 0; ai < 2; ++ai)
#pragma unroll
            for (int m = 0; m < 4; ++m) { const int row = row0 + ai * 128 + m * 16;
                if (u.pn < 5) {
                    const int pi = row < MP ? (row & 8191) : 8192 + (row & 7), q8 = 4 * (wc & 1) + fq;
                    const f32x4 t0 = *(const GAS f32x4*)(tab + pi * 32 + 4 * q8), t1 = *(const GAS f32x4*)(tab + pi * 32 + 4 * q8 + 2);
                    const float cs[4] = {t0[0], t0[2], t1[0], t1[2]}, sn[4] = {t0[1], t0[3], t1[1], t1[3]};
#pragma unroll
                    for (int bj = 0; bj < 2; ++bj) { const f32x4 x1 = acc[ai][bj][m][0], x2 = acc[ai][bj][m][1]; float o1[4], o2[4];
#pragma unroll
                        for (int e = 0; e < 4; ++e) { o1[e] = x1[e] * cs[e] - x2[e] * sn[e]; o2[e] = x2[e] * cs[e] + x1[e] * sn[e]; }
                        const int hl = 2 * bj + (wc >> 1);
                        v2u w1, w2; w1.x = pk2(o1[0], o1[1]); w1.y = pk2(o1[2], o1[3]); w2.x = pk2(o2[0], o2[1]); w2.y = pk2(o2[2], o2[3]);
                        if (u.pn < 4) { bf16* p = Q + (size_t)row * DM + (4 * u.pn + hl) * 64 + 4 * q8; *(GAS v2u*)p = w1; *(GAS v2u*)(p + 32) = w2; }
                        else { bf16* p = KB + (size_t)row * 256 + hl * 64 + 4 * q8; *(GAS v2u*)p = w1; *(GAS v2u*)(p + 32) = w2;
                            float* f = (row < MP ? out + O_PK + (size_t)row * 256 : out + O_SK + (size_t)(row - MP) * 256) + hl * 64 + 4 * q8;
                            *(GAS f32x4*)f = (f32x4){o1[0], o1[1], o1[2], o1[3]}; *(GAS f32x4*)(f + 32) = (f32x4){o2[0], o2[1], o2[2], o2[3]}; } }
                } else {
#pragma unroll
                    for (int bj = 0; bj < 2; ++bj) { const int col = bj * 128 + wc * 32 + 8 * fq; const f32x4 a = acc[ai][bj][m][0], b = acc[ai][bj][m][1];
                        *(GAS bf16x8*)(VB + (size_t)row * 256 + col) = pack44(a, b);
                        float* f = (row < MP ? out + O_PV + (size_t)row * 256 : out + O_SV + (size_t)(row - MP) * 256) + col;
                        *(GAS f32x4*)f = a; *(GAS f32x4*)(f + 4) = b; }
                }
            }
    }
};
DI void conv_state_out(const Ctx& C) {
    const bf16* PROJ = WSP(bf16, WS_PROJ);
    for (int idx = C.vcu * NTHR + C.tid; idx < (2 + 32) * 3 * CONVD; idx += C.G * NTHR) {
        const int col = idx % CONVD, r = (idx / CONVD) % 3, s = idx / (3 * CONVD);
        const int row = s < 2 ? s * SEQ + SEQ - 3 + r : MP + (s - 2) * 8 + 5 + r;
        const float v = bf2f(PROJ[(size_t)row * NPROJ + col]);
        if (s < 2) C.out[O_PCONV + (size_t)idx] = v; else C.out[O_SCONV + (size_t)(idx - 2 * 3 * CONVD)] = v; }
}
constexpr int PAIR_BYTES = 16384 + 17408 + 2048;
DI float shx(float v, int m, int lane) { return __int_as_float(__builtin_amdgcn_ds_bpermute((lane ^ m) << 2, __float_as_int(v))); }
DI float shfrom(float v, int src) { return __int_as_float(__builtin_amdgcn_ds_bpermute(src << 2, __float_as_int(v))); }
DI float softplus_f(float x) { return fmaxf(x, 0.f) + log1pf(__expf(-fabsf(x))); }

template <int NROW> DI void tri_solve(f32x2 (&x)[64], const LAS float* AM) {
#pragma unroll
    for (int i = 1; i < NROW; ++i) {
        f32x2 acc = x[i];
#pragma unroll
        for (int m4 = 0; m4 < (i + 3) / 4; ++m4) { const f32x4 a = *(const LAS f32x4*)(AM + i * 64 + 4 * m4);
#pragma unroll
            for (int e = 0; e < 4; ++e) if (4 * m4 + e < i) acc -= x[4 * m4 + e] * a[e];
            if ((m4 & 3) == 3) asm volatile("" ::: "memory"); }
        x[i] = acc;
        asm volatile("" ::: "memory");
    }
}

DI void prep_item(const Ctx& C, LAS unsigned char* pl, int item, int half) {
    int lane_ = C.lane; asm volatile("" : "+v"(lane_));
    const int lane = lane_, h = item & 7, c = (item >> 3) & 127, b = item >> 10, R0 = b * SEQ + c * 64;
    LAS float* AM = (LAS float*)pl; LAS unsigned char* KIMG = pl + 16384;
    LAS float* Gs = (LAS float*)(pl + 16384 + 17408 + half * 1024); LAS float* Bs = Gs + 64; LAS float* Es = Gs + 128; LAS float* Cs = Gs + 192;
    const bf16* PROJ = WSP(bf16, WS_PROJ); const float* AB = WSP(float, WS_AB);
    unsigned char* blk = C.ws + WS_DEL + (size_t)item * DEL_ITEM;
    float Glast;
    { const float a = AB[(size_t)(R0 + lane) * 16 + h], bb = AB[(size_t)(R0 + lane) * 16 + 8 + h];
      const float g = -__expf(C.a_log[h]) * softplus_f(a + C.a_dtb[h]), beta = sigmoid_f(bb);
      float G = g;
#pragma unroll
      for (int o = 1; o < 64; o <<= 1) { const float t = shfrom(G, (lane - o) & 63); if (lane >= o) G += t; }
      Glast = shfrom(G, 63 + (lane & 0));
      Gs[lane] = G; Bs[lane] = beta; Es[lane] = __expf(Glast - G); Cs[lane] = beta * __expf(G);
      if (half == 1 && lane == 0) WSP(float, WS_GLB)[item] = __expf(Glast);
      LDS_WAIT(); }
    const int il = lane & 15, g4 = lane >> 4;
    if (half == 1) {
#pragma unroll
        for (int part = 1; part >= 0; --part) {
            const int colbase = part * 1024 + h * 128;
#pragma unroll 1
            for (int mt = 0; mt < 4; ++mt) {
                const int i = 16 * mt + il; float y[4][8]; float ss = 0.f;
#pragma unroll
                for (int ks = 0; ks < 4; ++ks) {
                    const int ch0 = 32 * ks + 8 * g4; float accv[8];
#pragma unroll
                    for (int e = 0; e < 8; ++e) accv[e] = 0.f;
#pragma unroll
                    for (int w = 0; w < 4; ++w) {
                        const int tr = c * 64 + i - 3 + w;
                        v4u xv = {0u, 0u, 0u, 0u};
                        if (tr >= 0) xv = *(const GAS v4u*)(PROJ + (size_t)(b * SEQ + tr) * NPROJ + colbase + ch0);
                        const f32x4 w0 = *(const GAS f32x4*)(C.a_conv + w * CONVD + colbase + ch0), w1 = *(const GAS f32x4*)(C.a_conv + w * CONVD + colbase + ch0 + 4);
                        accv[0] += w0[0] * bflo(xv.x); accv[1] += w0[1] * bfhi(xv.x); accv[2] += w0[2] * bflo(xv.y); accv[3] += w0[3] * bfhi(xv.y);
                        accv[4] += w1[0] * bflo(xv.z); accv[5] += w1[1] * bfhi(xv.z); accv[6] += w1[2] * bflo(xv.w); accv[7] += w1[3] * bfhi(xv.w);
                    }
#pragma unroll
                    for (int e = 0; e < 8; ++e) { const float v = silu_f(accv[e]); y[ks][e] = v; ss += v * v; }
                    asm volatile("" ::: "memory");
                }
                ss += shx(ss, 16, lane); ss += shx(ss, 32, lane);
                const float inv = rsqrtf(ss + 1e-6f) * (part == 0 ? 0.08838834764831845f : 1.f);
                const float Gi = Gs[i], eG = __expf(Gi);
                bf16x8 qf[4];
#pragma unroll
                for (int ks = 0; ks < 4; ++ks) {
                    float yn[8];
#pragma unroll
                    for (int e = 0; e < 8; ++e) yn[e] = y[ks][e] * inv;
                    const bf16x8 fr = pack8(yn);
                    if (part == 0) { qf[ks] = fr;
                        bf16* qp = (bf16*)(blk + DEL_QP) + (size_t)((mt * 4 + ks) * 64) * 8;
#pragma unroll
                        for (int eh = 0; eh < 2; ++eh) { v2u o; o.x = pk2(yn[4 * eh] * eG, yn[4 * eh + 1] * eG); o.y = pk2(yn[4 * eh + 2] * eG, yn[4 * eh + 3] * eG);
                            *(GAS v2u*)(qp + (16 * (2 * (g4 & 1) + eh) + il) * 8 + 4 * (g4 >> 1)) = o; }
                    } else { *(LAS bf16x8*)(KIMG + i * 272 + (32 * ks + 8 * g4) * 2) = fr; }
                }
                if (part == 0) {
                    const int ni = mt;
#pragma unroll
                    for (int mj = 0; mj < 4; ++mj) {
                        const bool need_qk = (ni >= mj) || (ni == 0 && mj == 1) || (ni == 2 && mj == 3);
                        if (need_qk) {
                            f32x4 acc = {0.f, 0.f, 0.f, 0.f};
                            if (ni >= mj) {
#pragma unroll
                                for (int ks = 0; ks < 4; ++ks) acc = mfma16(*(const LAS bf16x8*)(KIMG + (16 * mj + il) * 272 + (32 * ks + 8 * g4) * 2), qf[ks], acc);
                            }
                            float v[4];
#pragma unroll
                            for (int r = 0; r < 4; ++r) { const int j = 16 * mj + 4 * g4 + r; v[r] = (i >= j) ? acc[r] * __expf(Gi - Gs[j]) : 0.f; }
                            v2u o; o.x = pk2(v[0], v[1]); o.y = pk2(v[2], v[3]);
                            *(GAS v2u*)((bf16*)(blk + DEL_QKP) + (size_t)(((ni * 2 + (mj >> 1)) * 64 + lane) * 8 + 4 * (mj & 1))) = o;
                        }
                    }
                }
                asm volatile("" ::: "memory");
            }
            if (part == 1) {
                LDS_WAIT();
#pragma unroll 1
                for (int mi = 0; mi < 4; ++mi) {
                    bf16x8 ka[4];
#pragma unroll
                    for (int ks = 0; ks < 4; ++ks) ka[ks] = *(const LAS bf16x8*)(KIMG + (16 * mi + il) * 272 + (32 * ks + 8 * g4) * 2);
                    float Gr[4], Br[4];
#pragma unroll
                    for (int r = 0; r < 4; ++r) { Gr[r] = Gs[16 * mi + 4 * g4 + r]; Br[r] = Bs[16 * mi + 4 * g4 + r]; }
#pragma unroll 1
                    for (int nj = 0; nj <= mi; ++nj) {
                        f32x4 acc = {0.f, 0.f, 0.f, 0.f};
#pragma unroll
                        for (int ks = 0; ks < 4; ++ks) acc = mfma16(ka[ks], *(const LAS bf16x8*)(KIMG + (16 * nj + il) * 272 + (32 * ks + 8 * g4) * 2), acc);
                        const float Gc = Gs[16 * nj + il];
#pragma unroll
                        for (int r = 0; r < 4; ++r) { const int i2 = 16 * mi + 4 * g4 + r, j = 16 * nj + il;
                            AM[i2 * 64 + j] = (i2 > j) ? Br[r] * acc[r] * __expf(Gr[r] - Gc) : 0.f; }
                    }
                }
            }
        }
    } else {
        const int rg = lane >> 4, ch = lane & 15, col = 2048 + h * 128 + 8 * ch;
        float cw[4][8];
#pragma unroll
        for (int w = 0; w < 4; ++w) { const f32x4 w0 = *(const GAS f32x4*)(C.a_conv + w * CONVD + col), w1 = *(const GAS f32x4*)(C.a_conv + w * CONVD + col + 4);
#pragma unroll
            for (int e = 0; e < 4; ++e) { cw[w][e] = w0[e]; cw[w][4 + e] = w1[e]; } }
        float x0[8], x1[8], x2[8];
        auto ldrow = [&](int tr, float* dst) { v4u xv = {0u, 0u, 0u, 0u}; if (tr >= 0) xv = *(const GAS v4u*)(PROJ + (size_t)(b * SEQ + tr) * NPROJ + col);
            dst[0] = bflo(xv.x); dst[1] = bfhi(xv.x); dst[2] = bflo(xv.y); dst[3] = bfhi(xv.y); dst[4] = bflo(xv.z); dst[5] = bfhi(xv.z); dst[6] = bflo(xv.w); dst[7] = bfhi(xv.w); };
        const int t0 = c * 64 + 16 * rg;
        ldrow(t0 - 3, x0); ldrow(t0 - 2, x1); ldrow(t0 - 1, x2);
        bf16* VN = WSP(bf16, WS_VN);
#pragma unroll
        for (int rr = 0; rr < 16; ++rr) { float x3[8]; ldrow(t0 + rr, x3); float yv[8];
#pragma unroll
            for (int e = 0; e < 8; ++e) { yv[e] = silu_f(cw[0][e] * x0[e] + cw[1][e] * x1[e] + cw[2][e] * x2[e] + cw[3][e] * x3[e]); x0[e] = x1[e]; x1[e] = x2[e]; x2[e] = x3[e]; }
            *(GAS bf16x8*)(VN + (size_t)(b * SEQ + t0 + rr) * DM + h * 128 + 8 * ch) = pack8(yv);
            if ((rr & 3) == 3) asm volatile("" ::: "memory"); }
        VM_WAIT();
    }
}
DI void prep_item2(const Ctx& C, LAS unsigned char* pl, int item, int half) {
    int lane_ = C.lane; asm volatile("" : "+v"(lane_));
    const int lane = lane_, h = item & 7, c = (item >> 3) & 127, b = item >> 10, R0 = b * SEQ + c * 64;
    const LAS float* AM = (const LAS float*)pl; const LAS unsigned char* KIMG = pl + 16384;
    const LAS float* Gs = (const LAS float*)(pl + 16384 + 17408 + half * 1024); const LAS float* Bs = Gs + 64; const LAS float* Es = Gs + 128; const LAS float* Cs = Gs + 192;
    unsigned char* blk = C.ws + WS_DEL + (size_t)item * DEL_ITEM;
    const int il = lane & 15, g4 = lane >> 4;
    f32x2 x[64];
    if (half == 1) {
#pragma unroll
        for (int f = 0; f < 16; ++f) { const int dt = f >> 1, ks = f & 1, d = 16 * dt + il; float v[8];
#pragma unroll
            for (int e = 0; e < 8; ++e) { const int j = 32 * ks + 16 * (e >> 2) + 4 * g4 + (e & 3); v[e] = bf2f(*(const LAS unsigned short*)(KIMG + j * 272 + d * 2)) * Es[j]; }
            *(GAS bf16x8*)((bf16*)(blk + DEL_KTP) + (size_t)(f * 64 + lane) * 8) = pack8(v); }
#pragma unroll
        for (int j = 0; j < 64; ++j) { const unsigned u = *(const LAS unsigned*)(KIMG + j * 272 + lane * 4); const float cj = Cs[j]; x[j] = (f32x2){bflo(u) * cj, bfhi(u) * cj}; if ((j & 15) == 15) asm volatile("" ::: "memory"); }
    } else {
        const unsigned* VN = (const unsigned*)(WSP(bf16, WS_VN) + (size_t)R0 * DM + h * 128) + lane;
#pragma unroll
        for (int j = 0; j < 64; ++j) { const unsigned u = __hip_atomic_load(VN + (size_t)j * (DM / 2), __ATOMIC_RELAXED, __HIP_MEMORY_SCOPE_AGENT); const float bj = Bs[j]; x[j] = (f32x2){bflo(u) * bj, bfhi(u) * bj}; if ((j & 15) == 15) asm volatile("" ::: "memory"); }
    }
    tri_solve<64>(x, AM);
    if (half == 1) {
        const int d = 2 * lane, ks = d >> 5, ap = d & 31, p = 8 * ((ap >> 2) & 3) + 4 * (ap >> 4) + (ap & 3);
        bf16* wp = (bf16*)blk;
#pragma unroll
        for (int i = 0; i < 64; ++i) *(GAS unsigned*)(wp + (size_t)((((i >> 4) * 4 + ks) * 64 + 16 * (p >> 3) + (i & 15)) * 8 + (p & 7))) = pk2(x[i][0], x[i][1]);
    } else {
        bf16* up = (bf16*)(blk + DEL_U);
#pragma unroll
        for (int cc = 0; cc < 2; ++cc) { const int dv = 2 * lane + cc, dvs = dv >> 4;
#pragma unroll
            for (int mt = 0; mt < 4; ++mt)
#pragma unroll
                for (int q4 = 0; q4 < 4; ++q4) { const int i0 = 16 * mt + 4 * q4; v2u o; o.x = pk2(x[i0][cc], x[i0 + 1][cc]); o.y = pk2(x[i0 + 2][cc], x[i0 + 3][cc]);
                    *(GAS v2u*)(up + (size_t)((dvs * 64 + 16 * q4 + (dv & 15)) * 16 + 4 * mt)) = o; } }
    }
}
DI void prep_phase(const Ctx& C) {
    const int pair = C.wave >> 1, half = C.wave & 1; LAS unsigned char* pl = C.lds + pair * PAIR_BYTES;
    for (int base = C.vcu * 4; base < NITEM; base += C.G * 4) { const int item = base + pair;
        prep_item(C, pl, item, half);
        LDS_WAIT(); __syncthreads();
        prep_item2(C, pl, item, half);
        LDS_WAIT(); __syncthreads(); }
}

constexpr int SCAN_SLOT = 59392;
DI void scan_phase(const Ctx& C) {
    const int bx = blockIdx.x, lane = C.lane, il = lane & 15, g4 = lane >> 4;
    const int xcd = bx & 7, k = bx >> 3, bh = xcd * 2 + (k >> 3), dvs = k & 7, b = bh >> 3, h = bh & 7;
    const unsigned char* blk0 = C.ws + WS_DEL + (size_t)((b * 128) * 8 + h) * DEL_ITEM;
    const int ltid = (C.wave - 1) * 64 + lane;
    auto stage = [&](int c, int slot) {
        const unsigned char* src = blk0 + (size_t)c * 8 * DEL_ITEM; LAS unsigned char* dst = C.lds + slot * SCAN_SLOT; v4u v[9];
#pragma unroll
        for (int q = 0; q < 9; ++q) { const int ch = ltid + q * 448; if (ch < 3712) v[q] = *(const GAS v4u*)(src + (ch < 3584 ? ch * 16 : DEL_U + dvs * 2048 + (ch - 3584) * 16)); }
#pragma unroll
        for (int q = 0; q < 9; ++q) { const int ch = ltid + q * 448; if (ch < 3712) *(LAS v4u*)(dst + ch * 16) = v[q]; }
    };
    if (C.wave >= 1) stage(0, 0);
    LDS_WAIT(); __syncthreads();
    f32x4 sd[8];
#pragma unroll
    for (int t = 0; t < 8; ++t) sd[t] = (f32x4){0.f, 0.f, 0.f, 0.f};
    float* O = WSP(float, WS_O); const float* GLB = WSP(float, WS_GLB);
#pragma unroll 1
    for (int c = 0; c < 128; ++c) {
        if (C.wave >= 1) { if (c + 1 < 128) stage(c + 1, (c + 1) & 1); }
        else {
            const LAS unsigned char* L = C.lds + (c & 1) * SCAN_SLOT;
            const float gl = GLB[(b * 128 + c) * 8 + h];
            bf16x8 Sb[4];
#pragma unroll
            for (int ks = 0; ks < 4; ++ks) Sb[ks] = pack44(sd[2 * ks], sd[2 * ks + 1]);
            const v4u u0 = *(const LAS v4u*)(L + 57344 + lane * 32), u1 = *(const LAS v4u*)(L + 57344 + lane * 32 + 16);
            const unsigned uu[8] = {u0.x, u0.y, u0.z, u0.w, u1.x, u1.y, u1.z, u1.w};
            f32x4 vn[4];
#pragma unroll
            for (int mt = 0; mt < 4; ++mt) { f32x4 acc = {0.f, 0.f, 0.f, 0.f};
#pragma unroll
                for (int ks = 0; ks < 4; ++ks) acc = mfma16(*(const LAS bf16x8*)(L + ((mt * 4 + ks) * 64 + lane) * 16), Sb[ks], acc);
                vn[mt] = (f32x4){bflo(uu[2 * mt]) - acc[0], bfhi(uu[2 * mt]) - acc[1], bflo(uu[2 * mt + 1]) - acc[2], bfhi(uu[2 * mt + 1]) - acc[3]}; }
            bf16x8 vb[2];
            vb[0] = pack44(vn[0], vn[1]); vb[1] = pack44(vn[2], vn[3]);
            float* orow = O + (size_t)(b * SEQ + c * 64 + 4 * g4) * DM + h * 128 + 16 * dvs + il;
#pragma unroll
            for (int mt = 0; mt < 4; ++mt) { f32x4 acc = {0.f, 0.f, 0.f, 0.f};
#pragma unroll
                for (int ks = 0; ks < 4; ++ks) acc = mfma16(*(const LAS bf16x8*)(L + DEL_QP + ((mt * 4 + ks) * 64 + lane) * 16), Sb[ks], acc);
#pragma unroll
                for (int ks = 0; ks < 2; ++ks) if (ks <= (mt >> 1)) acc = mfma16(*(const LAS bf16x8*)(L + DEL_QKP + ((mt * 2 + ks) * 64 + lane) * 16), vb[ks], acc);
#pragma unroll
                for (int r = 0; r < 4; ++r) orow[(size_t)(16 * mt + r) * DM] = acc[r]; }
#pragma unroll
            for (int dt = 0; dt < 8; ++dt) { f32x4 acc = sd[dt] * gl;
#pragma unroll
                for (int ks = 0; ks < 2; ++ks) acc = mfma16(*(const LAS bf16x8*)(L + DEL_KTP + ((dt * 2 + ks) * 64 + lane) * 16), vb[ks], acc);
                sd[dt] = acc; }
        }
        LDS_WAIT(); __syncthreads();
    }
    if (C.wave == 0) { float* pd = C.out + O_PDELTA + (size_t)((b * 8 + h) * 128) * 128 + 16 * dvs + il;
#pragma unroll
        for (int dt = 0; dt < 8; ++dt)
#pragma unroll
            for (int r = 0; r < 4; ++r) pd[(size_t)(16 * dt + 4 * g4 + r) * 128] = sd[dt][r]; }
}
DI void sample_delta(const Ctx& C) {
    const int vs = (int)blockIdx.x - 128, pair = C.wave >> 1, half = C.wave & 1, lane = C.lane, tt = half * 64 + lane;
    LAS float* qs = (LAS float*)(C.lds + pair * 9216); LAS float* ksm = qs + 1024; LAS float* red = ksm + 1024;
    const bf16* PROJ = WSP(bf16, WS_PROJ); const float* AB = WSP(float, WS_AB); float* O = WSP(float, WS_O);
    for (int base = vs * 4; base < 256; base += 128 * 4) {
        const int idx = base + pair, seq = idx >> 3, h = idx & 7, R0 = MP + seq * 8;
        float yq[8], yk[8], yv[8];
#pragma unroll
        for (int part = 0; part < 3; ++part) { const int col = part * 1024 + h * 128 + tt; float xp[11], cw[4];
#pragma unroll
            for (int r = 0; r < 3; ++r) xp[r] = C.state_conv[(size_t)(seq * 3 + r) * CONVD + col];
#pragma unroll
            for (int t = 0; t < 8; ++t) xp[3 + t] = bf2f(PROJ[(size_t)(R0 + t) * NPROJ + col]);
#pragma unroll
            for (int w = 0; w < 4; ++w) cw[w] = C.a_conv[w * CONVD + col];
#pragma unroll
            for (int t = 0; t < 8; ++t) { const float y = silu_f(cw[0] * xp[t] + cw[1] * xp[t + 1] + cw[2] * xp[t + 2] + cw[3] * xp[t + 3]);
                if (part == 0) yq[t] = y; else if (part == 1) yk[t] = y; else yv[t] = y; } }
#pragma unroll
        for (int t = 0; t < 8; ++t) { const float sq = wsum(yq[t] * yq[t]), sk = wsum(yk[t] * yk[t]); if (lane == 0) { red[t * 2 + half] = sq; red[16 + t * 2 + half] = sk; } }
        LDS_WAIT(); __syncthreads();
#pragma unroll
        for (int t = 0; t < 8; ++t) { const float nq = rsqrtf(red[t * 2] + red[t * 2 + 1] + 1e-6f) * 0.08838834764831845f, nk = rsqrtf(red[16 + t * 2] + red[16 + t * 2 + 1] + 1e-6f);
            qs[t * 128 + tt] = yq[t] * nq; ksm[t * 128 + tt] = yk[t] * nk; }
        LDS_WAIT(); __syncthreads();
        float s[128];
        const float* sp = C.state_delta + (size_t)((seq * 8 + h) * 128) * 128 + tt;
#pragma unroll
        for (int d = 0; d < 128; ++d) { s[d] = sp[(size_t)d * 128]; if ((d & 15) == 15) asm volatile("" ::: "memory"); }
#pragma unroll
        for (int t = 0; t < 8; ++t) {
            const float a = AB[(size_t)(R0 + t) * 16 + h], bb = AB[(size_t)(R0 + t) * 16 + 8 + h];
            const float eg = __expf(-__expf(C.a_log[h]) * softplus_f(a + C.a_dtb[h])), beta = sigmoid_f(bb);
            float dot = 0.f;
#pragma unroll
            for (int d4 = 0; d4 < 32; ++d4) { const f32x4 kk = *(const LAS f32x4*)(ksm + t * 128 + 4 * d4);
#pragma unroll
                for (int e = 0; e < 4; ++e) { s[4 * d4 + e] *= eg; dot += kk[e] * s[4 * d4 + e]; }
                if ((d4 & 7) == 7) asm volatile("" ::: "memory"); }
            const float err = (yv[t] - dot) * beta; float o = 0.f;
#pragma unroll
            for (int d4 = 0; d4 < 32; ++d4) { const f32x4 kk = *(const LAS f32x4*)(ksm + t * 128 + 4 * d4), qq = *(const LAS f32x4*)(qs + t * 128 + 4 * d4);
#pragma unroll
                for (int e = 0; e < 4; ++e) { s[4 * d4 + e] += kk[e] * err; o += qq[e] * s[4 * d4 + e]; }
                if ((d4 & 3) == 3) asm volatile("" ::: "memory"); }
            O[(size_t)(R0 + t) * DM + h * 128 + tt] = o;
            asm volatile("" ::: "memory");
        }
        float* so = C.out + O_SDELTA + (size_t)((seq * 8 + h) * 128) * 128 + tt;
#pragma unroll
        for (int d = 0; d < 128; ++d) { so[(size_t)d * 128] = s[d]; if ((d & 15) == 15) asm volatile("" ::: "memory"); }
        __syncthreads();
    }
}
DI void onorm_phase(const Ctx& C) {
    const int gw = C.vcu * NWAVES + C.wave, NGW = C.G * NWAVES, sub = C.lane & 15;
    const float* O = WSP(float, WS_O); const bf16* PROJ = WSP(bf16, WS_PROJ); bf16* OG = WSP(bf16, WS_OG);
    const f32x4 n0 = *(const GAS f32x4*)(C.a_norm + 8 * sub), n1 = *(const GAS f32x4*)(C.a_norm + 8 * sub + 4);
    for (int it = gw; it < MT * 8 / 4; it += NGW) { const int grp = it * 4 + (C.lane >> 4), row = grp >> 3, h = grp & 7, col = h * 128 + 8 * sub;
        const f32x4 o0 = *(const GAS f32x4*)(O + (size_t)row * DM + col), o1 = *(const GAS f32x4*)(O + (size_t)row * DM + col + 4);
        const v4u z = *(const GAS v4u*)(PROJ + (size_t)row * NPROJ + 3072 + col);
        float ss = (o0[0] * o0[0] + o0[1] * o0[1]) + (o0[2] * o0[2] + o0[3] * o0[3]) + (o1[0] * o1[0] + o1[1] * o1[1]) + (o1[2] * o1[2] + o1[3] * o1[3]);
        ss += __shfl_xor(ss, 1); ss += __shfl_xor(ss, 2); ss += __shfl_xor(ss, 4); ss += __shfl_xor(ss, 8);
        const float r = rsqrtf(ss * (1.f / 128.f) + 1e-6f);
        float v[8] = {o0[0] * r * n0[0] * silu_f(bflo(z.x)), o0[1] * r * n0[1] * silu_f(bfhi(z.x)), o0[2] * r * n0[2] * silu_f(bflo(z.y)), o0[3] * r * n0[3] * silu_f(bfhi(z.y)),
                      o1[0] * r * n1[0] * silu_f(bflo(z.z)), o1[1] * r * n1[1] * silu_f(bfhi(z.z)), o1[2] * r * n1[2] * silu_f(bflo(z.w)), o1[3] * r * n1[3] * silu_f(bfhi(z.w))};
        *(GAS bf16x8*)(OG + (size_t)row * DM + col) = pack8(v); }
}
DI void ln_phase(const Ctx& C, const float* resA, const float* resB, const float* mix, const float* g, const float* bb, float* outf, bf16* outb) {
    const int gw = C.vcu * NWAVES + C.wave, NGW = C.G * NWAVES, lane = C.lane;
    f32x4 gv[4], bv[4];
#pragma unroll
    for (int j = 0; j < 4; ++j) { gv[j] = *(const GAS f32x4*)(g + 4 * lane + 256 * j); bv[j] = *(const GAS f32x4*)(bb + 4 * lane + 256 * j); }
    for (int row = gw; row < MT; row += NGW) {
        const float* rr = row < MP ? resA + (size_t)row * DM : resB + (size_t)(row - MP) * DM; const float* mr = mix + (size_t)row * DM;
        f32x4 v[4]; float s = 0.f;
#pragma unroll
        for (int j = 0; j < 4; ++j) { const f32x4 a = *(const GAS f32x4*)(rr + 4 * lane + 256 * j), m = *(const GAS f32x4*)(mr + 4 * lane + 256 * j); v[j] = a * ALPHA + m; s += (v[j][0] + v[j][1]) + (v[j][2] + v[j][3]); }
        const float mean = wsum(s) * (1.f / DM); float s2 = 0.f;
#pragma unroll
        for (int j = 0; j < 4; ++j) { v[j] = v[j] - mean; s2 += (v[j][0] * v[j][0] + v[j][1] * v[j][1]) + (v[j][2] * v[j][2] + v[j][3] * v[j][3]); }
        const float rstd = rsqrtf(wsum(s2) * (1.f / DM) + 1e-5f);
#pragma unroll
        for (int j = 0; j < 4; ++j) { const f32x4 y = v[j] * rstd * gv[j] + bv[j];
            if (outf) *(GAS f32x4*)(outf + (size_t)row * DM + 4 * lane + 256 * j) = y;
            if (outb) { v2u o; o.x = pk2(y[0], y[1]); o.y = pk2(y[2], y[3]); *(GAS v2u*)(outb + (size_t)row * DM + 4 * lane + 256 * j) = o; } }
    }
}
constexpr float SM_SCALE = 0.125f, SM_C2 = 0.125f * 1.4426950408889634f;
DI float exp2_f(float x) { return __builtin_amdgcn_exp2f(x); }

template <bool CAUSAL, class KF, class VF>
DI void moba_tile(const KF& kfrag, const VF& vfrag, const bf16x8 (&qf)[2][2], int kt_max, int q0, int lane, float (&m_out)[2], float (&l_out)[2], f32x4 (&ot)[4][2]) {
    const int il = lane & 15, g4 = lane >> 4;
    f32x4 st[16][2];
    const float NEG = -__builtin_inff();
#pragma unroll
    for (int mt = 0; mt < 16; ++mt) {
        if (mt < kt_max) {
            const bf16x8 k0 = kfrag(mt, 0), k1 = kfrag(mt, 1);
#pragma unroll
            for (int nt = 0; nt < 2; ++nt) { f32x4 acc = {0.f, 0.f, 0.f, 0.f}; acc = mfma16(k0, qf[nt][0], acc); acc = mfma16(k1, qf[nt][1], acc);
                if (CAUSAL) {
#pragma unroll
                    for (int r = 0; r < 4; ++r) if (16 * mt + 4 * g4 + r > q0 + 16 * nt + il) acc[r] = NEG; }
                st[mt][nt] = acc; }
        } else { st[mt][0] = (f32x4){NEG, NEG, NEG, NEG}; st[mt][1] = st[mt][0]; }
        if (mt & 1) asm volatile("" ::: "memory");
    }
#pragma unroll
    for (int nt = 0; nt < 2; ++nt) { float m = NEG;
#pragma unroll
        for (int mt = 0; mt < 16; ++mt) m = fmaxf(m, fmaxf(fmaxf(st[mt][nt][0], st[mt][nt][1]), fmaxf(st[mt][nt][2], st[mt][nt][3])));
        m = fmaxf(m, __shfl_xor(m, 16)); m = fmaxf(m, __shfl_xor(m, 32));
        float l = 0.f; const float mc = m * SM_C2;
#pragma unroll
        for (int mt = 0; mt < 16; ++mt)
#pragma unroll
            for (int r = 0; r < 4; ++r) { const float p = exp2_f(st[mt][nt][r] * SM_C2 - mc); st[mt][nt][r] = p; l += p; }
        l += __shfl_xor(l, 16); l += __shfl_xor(l, 32);
        m_out[nt] = m * SM_SCALE; l_out[nt] = l; }
#pragma unroll
    for (int mt = 0; mt < 4; ++mt) { ot[mt][0] = (f32x4){0.f, 0.f, 0.f, 0.f}; ot[mt][1] = ot[mt][0]; }
#pragma unroll
    for (int ks = 0; ks < 8; ++ks) {
        if (2 * ks < kt_max) {
            const bf16x8 p0 = pack44(st[2 * ks][0], st[2 * ks + 1][0]), p1 = pack44(st[2 * ks][1], st[2 * ks + 1][1]);
#pragma unroll
            for (int mt = 0; mt < 4; ++mt) { const bf16x8 vf = vfrag(mt, ks); ot[mt][0] = mfma16(vf, p0, ot[mt][0]); ot[mt][1] = mfma16(vf, p1, ot[mt][1]); }
        }
        asm volatile("" ::: "memory");
    }
}
struct LdsK { const LAS unsigned char* p; int lane; DI bf16x8 operator()(int mt, int ks) const { return *(const LAS bf16x8*)(p + ((mt * 2 + ks) * 64 + lane) * 16); } };
struct LdsV { const LAS unsigned char* p; int lane; DI bf16x8 operator()(int mt, int ks) const { return *(const LAS bf16x8*)(p + ((mt * 8 + ks) * 64 + lane) * 16); } };
DI void stage_kv(int tid, const bf16* Kblk  , const bf16* Vt  , LAS unsigned char* Kl, LAS unsigned char* Vl) {
#pragma unroll
    for (int q = 0; q < 4; ++q) { const int ch = tid + q * NTHR, key = ch >> 3, ci = ch & 7;
        const v4u v = *(const GAS v4u*)(Kblk + (size_t)key * 256 + 8 * ci);
        *(LAS v4u*)(Kl + ((((key >> 4) * 2 + (ci >> 2)) * 64) + (ci & 3) * 16 + (key & 15)) * 16) = v; }
#pragma unroll
    for (int q = 0; q < 4; ++q) { const int ch = tid + q * NTHR, d = ch >> 5, c32 = ch & 31;
        const v4u v = *(const GAS v4u*)(Vt + (size_t)d * 256 + 8 * c32);
        *(LAS v4u*)(Vl + ((((d >> 4) * 8 + (c32 >> 2)) * 64) + (c32 & 3) * 16 + (d & 15)) * 16) = v; }
}

DI void attn_p11(const Ctx& C) {
    float* PM = WSP(float, WS_PMEANS); const float* pk = C.out + O_PK;
    LAS float* red = (LAS float*)C.lds;
    for (int it = C.vcu; it < 64; it += C.G) {
        const float* base = pk + (size_t)(it * 256 + C.wave * 32) * 256 + 4 * C.lane; f32x4 a = {0.f, 0.f, 0.f, 0.f};
#pragma unroll 8
        for (int r = 0; r < 32; ++r) a += *(const GAS f32x4*)(base + (size_t)r * 256);
        *(LAS f32x4*)(red + C.wave * 256 + 4 * C.lane) = a;
        LDS_WAIT(); __syncthreads();
        if (C.tid < 256) { float s = 0.f;
#pragma unroll
            for (int w = 0; w < 8; ++w) s += red[w * 256 + C.tid];
            PM[it * 256 + C.tid] = s * (1.f / 256.f); }
        __syncthreads();
    }
    LAS unsigned short* img = (LAS unsigned short*)(C.lds + 16384);
    const bf16* VB = WSP(bf16, WS_VB); bf16* VTP = WSP(bf16, WS_VTP);
    for (int it = C.vcu; it < 256; it += C.G) { const int n = it & 31, g = (it >> 5) & 3, b = it >> 7;
#pragma unroll
        for (int q = 0; q < 4; ++q) { const int ch = C.tid + q * NTHR, key = ch >> 3, ci = ch & 7;
            const v4u v = *(const GAS v4u*)(VB + (size_t)(b * SEQ + n * 256 + key) * 256 + g * 64 + 8 * ci);
            LAS unsigned* dst = (LAS unsigned*)(img + key * 68 + 8 * ci); dst[0] = v.x; dst[1] = v.y; dst[2] = v.z; dst[3] = v.w; }
        LDS_WAIT(); __syncthreads();
#pragma unroll
        for (int q = 0; q < 4; ++q) { const int task = C.tid + q * NTHR, d = task >> 5, ks = (task >> 2) & 7, g4 = task & 3; unsigned short e8[8];
#pragma unroll
            for (int e = 0; e < 8; ++e) e8[e] = img[(32 * ks + 16 * (e >> 2) + 4 * g4 + (e & 3)) * 68 + d];
            v4u o; o.x = e8[0] | ((unsigned)e8[1] << 16); o.y = e8[2] | ((unsigned)e8[3] << 16); o.z = e8[4] | ((unsigned)e8[5] << 16); o.w = e8[6] | ((unsigned)e8[7] << 16);
            *(GAS v4u*)(VTP + ((size_t)((b * 4 + g) * 32 + n) * 64 + d) * 256 + 32 * ks + 8 * g4) = o; }
        __syncthreads();
    }
}
#define TOP3_INS(v_, i_) do { const float tv_ = (v_); const int ti_ = (i_); const bool g0_ = tv_ > v0, g1_ = tv_ > v1, g2_ = tv_ > v2; \
    const float nv2_ = g1_ ? v1 : (g2_ ? tv_ : v2); const int ni2_ = g1_ ? i1 : (g2_ ? ti_ : i2); \
    const float nv1_ = g0_ ? v0 : (g1_ ? tv_ : v1); const int ni1_ = g0_ ? i0 : (g1_ ? ti_ : i1); \
    v0 = g0_ ? tv_ : v0; i0 = g0_ ? ti_ : i0; v1 = nv1_; i1 = ni1_; v2 = nv2_; i2 = ni2_; } while (0)
DI void attn_p12(const Ctx& C) {
    const float* PM = WSP(float, WS_PMEANS); const bf16* Q = WSP(bf16, WS_Q); unsigned* LIST = WSP(unsigned, WS_LIST);
    LAS float* mn = (LAS float*)C.lds;
    const int lane = C.lane;
    for (int it = C.vcu; it < 512; it += C.G) {
        const int tr = it & 63, g = (it >> 6) & 3, b = it >> 8, own = tr >> 1;
        for (int i = C.tid; i < 32 * 64; i += NTHR) mn[i] = PM[(size_t)(b * 32 + (i >> 6)) * 256 + g * 64 + (i & 63)];
        LDS_WAIT(); __syncthreads();
        const int h4 = C.wave & 3, t = tr * 128 + (C.wave >> 2) * 64 + lane;
        if (own > 0) {
            float q[64];
            const bf16* qp = Q + (size_t)(b * SEQ + t) * DM + (4 * g + h4) * 64;
#pragma unroll
            for (int c8 = 0; c8 < 8; ++c8) { const v4u v = *(const GAS v4u*)(qp + 8 * c8);
                q[8 * c8] = bflo(v.x); q[8 * c8 + 1] = bfhi(v.x); q[8 * c8 + 2] = bflo(v.y); q[8 * c8 + 3] = bfhi(v.y); q[8 * c8 + 4] = bflo(v.z); q[8 * c8 + 5] = bfhi(v.z); q[8 * c8 + 6] = bflo(v.w); q[8 * c8 + 7] = bfhi(v.w); }
            float v0 = -__builtin_inff(), v1 = v0, v2 = v0; int i0 = -1, i1 = -1, i2 = -1;
#pragma unroll 1
            for (int n = 0; n < own; ++n) { float s = 0.f;
#pragma unroll
                for (int d4 = 0; d4 < 16; ++d4) { const f32x4 m = *(const LAS f32x4*)(mn + n * 64 + 4 * d4); s += (q[4 * d4] * m[0] + q[4 * d4 + 1] * m[1]) + (q[4 * d4 + 2] * m[2] + q[4 * d4 + 3] * m[3]); }
                TOP3_INS(s, n); }
#pragma unroll 1
            for (int n = 0; n < own; ++n) { const int sel = (i0 == n) ? 0 : (i1 == n) ? 1 : (i2 == n) ? 2 : -1;
                const unsigned long long mask = __ballot(sel >= 0);
                if (mask) { const int lid = ((b * 4 + g) * 32 + n) * 4 + h4; unsigned basep = 0;
                    const int leader = __builtin_ctzll(mask);
                    if (lane == leader) basep = __hip_atomic_fetch_add(C.ctl + CW_PCNT + lid, (unsigned)__builtin_popcountll(mask), __ATOMIC_RELAXED, __HIP_MEMORY_SCOPE_AGENT);
                    basep = __shfl(basep, leader);
                    if (sel >= 0) LIST[(size_t)lid * 8192 + basep + __builtin_popcountll(mask & ((1ull << lane) - 1ull))] = (unsigned)t | ((unsigned)sel << 13); } }
        }
        __syncthreads();
    }
    const float* CM = WSP(float, WS_CMEANS); unsigned* SL = WSP(unsigned, WS_SLIST);
    for (int it = C.vcu; it < 128; it += C.G) { const int g = it & 3, seq = it >> 2, q32 = C.tid >> 4, sub = C.tid & 15, tq = q32 >> 2, h4 = q32 & 3;
        float q[64]; const bf16* qp = Q + (size_t)(MP + seq * 8 + tq) * DM + (4 * g + h4) * 64;
#pragma unroll
        for (int c8 = 0; c8 < 8; ++c8) { const v4u v = *(const GAS v4u*)(qp + 8 * c8);
            q[8 * c8] = bflo(v.x); q[8 * c8 + 1] = bfhi(v.x); q[8 * c8 + 2] = bflo(v.y); q[8 * c8 + 3] = bfhi(v.y); q[8 * c8 + 4] = bflo(v.z); q[8 * c8 + 5] = bfhi(v.z); q[8 * c8 + 6] = bflo(v.w); q[8 * c8 + 7] = bfhi(v.w); }
        float v0 = -__builtin_inff(), v1 = v0, v2 = v0; int i0 = -1, i1 = -1, i2 = -1;
#pragma unroll 1
        for (int j = 0; j < 4; ++j) { const int n = 4 * sub + j; const float* mp = CM + (size_t)(seq * 64 + n) * 256 + g * 64; float s = 0.f;
#pragma unroll
            for (int d4 = 0; d4 < 16; ++d4) { const f32x4 m = *(const GAS f32x4*)(mp + 4 * d4); s += (q[4 * d4] * m[0] + q[4 * d4 + 1] * m[1]) + (q[4 * d4 + 2] * m[2] + q[4 * d4 + 3] * m[3]); }
            TOP3_INS(s, n); }
#pragma unroll
        for (int o = 1; o < 16; o <<= 1) { const float a0 = __shfl_xor(v0, o), a1 = __shfl_xor(v1, o), a2 = __shfl_xor(v2, o); const int j0 = __shfl_xor(i0, o), j1 = __shfl_xor(i1, o), j2 = __shfl_xor(i2, o);
            TOP3_INS(a0, j0); TOP3_INS(a1, j1); TOP3_INS(a2, j2); }
        if (sub == 0) {
#pragma unroll
            for (int s = 0; s < 3; ++s) { const int lid = (seq * 4 + g) * 64 + (s == 0 ? i0 : s == 1 ? i1 : i2); const unsigned pos = __hip_atomic_fetch_add(C.ctl + CW_SCNT + lid, 1u, __ATOMIC_RELAXED, __HIP_MEMORY_SCOPE_AGENT);
                SL[(size_t)lid * 32 + pos] = (unsigned)q32 | ((unsigned)s << 5); } }
    }
}
struct GlobK { const float* r0; const float* r1; int g, lane;
    DI bf16x8 operator()(int mt, int ks) const { const int key = 16 * mt + (lane & 15); const float* p = (key < 128 ? r0 + (size_t)key * 256 : r1 + (size_t)(key - 128) * 256) + 32 * ks + 8 * (lane >> 4);
        return pack44(*(const GAS f32x4*)p, *(const GAS f32x4*)(p + 4)); } };
struct GlobV { const float* r0; const float* r1; int lane;
    DI bf16x8 operator()(int mt, int ks) const { float v[8];
#pragma unroll
        for (int e = 0; e < 8; ++e) { const int key = 32 * ks + 16 * (e >> 2) + 4 * (lane >> 4) + (e & 3); v[e] = (key < 128 ? r0 + (size_t)key * 256 : r1 + (size_t)(key - 128) * 256)[16 * mt + (lane & 15)]; }
        return pack8(v); } };
DI void attn_p13(const Ctx& C) {
    int lane = C.lane, il = lane & 15, g4 = lane >> 4;
    LAS unsigned char* Kl = C.lds; LAS unsigned char* Vl = C.lds + 32768; LAS int* start = (LAS int*)(C.lds + 65536);
    LAS int* wtot = (LAS int*)(C.lds + 65536 + 4352);
    { const unsigned c0 = __hip_atomic_load(C.ctl + CW_PCNT + 2 * C.tid, __ATOMIC_RELAXED, __HIP_MEMORY_SCOPE_AGENT), c1 = __hip_atomic_load(C.ctl + CW_PCNT + 2 * C.tid + 1, __ATOMIC_RELAXED, __HIP_MEMORY_SCOPE_AGENT);
      const int t0 = (int)(c0 + 255) >> 8, t1 = (int)(c1 + 255) >> 8; int s = t0 + t1, inc = s;
#pragma unroll
      for (int o = 1; o < 64; o <<= 1) { const int v = __shfl_up(inc, o); if (lane >= o) inc += v; }
      if (lane == 63) wtot[C.wave] = inc;
      LDS_WAIT(); __syncthreads();
      int wb = 0;
#pragma unroll
      for (int w = 0; w < 8; ++w) if (w < C.wave) wb += wtot[w];
      const int ex = wb + inc - s; start[2 * C.tid] = ex; start[2 * C.tid + 1] = ex + t0; if (C.tid == NTHR - 1) start[1024] = ex + s;
      LDS_WAIT(); __syncthreads(); }
    const int T = start[1024], per = (T + C.G - 1) / C.G, i_lo = C.vcu * per, i_hi = (i_lo + per < T) ? i_lo + per : T;
    const bf16* Q = WSP(bf16, WS_Q); const bf16* KB = WSP(bf16, WS_KB); const bf16* VTP = WSP(bf16, WS_VTP); const unsigned* LIST = WSP(unsigned, WS_LIST);
    bf16* OP = WSP(bf16, WS_OPART); float* ML = WSP(float, WS_ML);
    int cur_blk = -1;
#pragma unroll 1
    for (int item = i_lo; item < i_hi; ++item) {
        int tid_l = C.tid; asm volatile("" : "+v"(tid_l)); lane = tid_l & 63; il = lane & 15; g4 = lane >> 4;
        int lo = 0, hi = 1024;
        while (hi - lo > 1) { const int mid = (lo + hi) >> 1; if (start[mid] <= item) lo = mid; else hi = mid; }
        const int lid = lo, tile = item - start[lid], h4 = lid & 3, n = (lid >> 2) & 31, g = (lid >> 7) & 3, b = lid >> 9, blkid = lid >> 2;
        const int cnt = (int)__hip_atomic_load(C.ctl + CW_PCNT + lid, __ATOMIC_RELAXED, __HIP_MEMORY_SCOPE_AGENT);
        if (blkid != cur_blk) { __syncthreads(); stage_kv(tid_l, KB + (size_t)(b * SEQ + n * 256) * 256 + g * 64, VTP + (size_t)blkid * 64 * 256, Kl, Vl); cur_blk = blkid; LDS_WAIT(); __syncthreads(); }
        const int h = 4 * g + h4; int tq[2], sl[2]; bool ok[2]; bf16x8 qf[2][2];
#pragma unroll
        for (int nt = 0; nt < 2; ++nt) { const int pi = tile * 256 + C.wave * 32 + nt * 16 + il; ok[nt] = pi < cnt; const unsigned e = ok[nt] ? LIST[(size_t)lid * 8192 + pi] : 0u; tq[nt] = e & 8191; sl[nt] = e >> 13;
            const bf16* qp = Q + (size_t)(b * SEQ + tq[nt]) * DM + h * 64 + 8 * g4;
            qf[nt][0] = *(const GAS bf16x8*)qp; qf[nt][1] = *(const GAS bf16x8*)(qp + 32); }
        if (tile * 256 + C.wave * 32 < cnt) {
            float m[2], l[2]; f32x4 ot[4][2];
            moba_tile<false>(LdsK{Kl, lane}, LdsV{Vl, lane}, qf, 16, 0, lane, m, l, ot);
#pragma unroll
            for (int nt = 0; nt < 2; ++nt) if (ok[nt]) { const size_t rec = ((size_t)(b * SEQ + tq[nt]) * 16 + h) * 3 + sl[nt];
#pragma unroll
                for (int mt = 0; mt < 4; ++mt) { v2u o; o.x = pk2(ot[mt][nt][0], ot[mt][nt][1]); o.y = pk2(ot[mt][nt][2], ot[mt][nt][3]); *(GAS v2u*)(OP + rec * 64 + 16 * mt + 4 * g4) = o; }
                if (g4 == 0) *(GAS f32x2*)(ML + rec * 2) = (f32x2){m[nt], l[nt]}; }
        }
    }
    __syncthreads();
    const unsigned* SL = WSP(unsigned, WS_SLIST); float* SP = WSP(float, WS_SPART);
    const int gw = C.vcu * NWAVES + C.wave, NGW = C.G * NWAVES;
#pragma unroll 1
    for (int it = gw; it < 32 * 4 * 64; it += NGW) {
        { int tid_l = C.tid; asm volatile("" : "+v"(tid_l)); lane = tid_l & 63; il = lane & 15; g4 = lane >> 4; }
        const int cnt = (int)__hip_atomic_load(C.ctl + CW_SCNT + it, __ATOMIC_RELAXED, __HIP_MEMORY_SCOPE_AGENT);
        if (cnt == 0) continue;
        const int n = it & 63, g = (it >> 6) & 3, seq = it >> 8;
        const int pg0 = C.page_table[seq * 128 + 2 * n], pg1 = C.page_table[seq * 128 + 2 * n + 1];
        int q32[2], sl[2]; bool ok[2]; bf16x8 qf[2][2];
#pragma unroll
        for (int nt = 0; nt < 2; ++nt) { const int pi = nt * 16 + il; ok[nt] = pi < cnt; const unsigned e = ok[nt] ? SL[(size_t)it * 32 + pi] : 0u; q32[nt] = e & 31; sl[nt] = e >> 5;
            const bf16* qp = Q + (size_t)(MP + seq * 8 + (q32[nt] >> 2)) * DM + (4 * g + (q32[nt] & 3)) * 64 + 8 * g4;
            qf[nt][0] = *(const GAS bf16x8*)qp; qf[nt][1] = *(const GAS bf16x8*)(qp + 32); }
        float m[2], l[2]; f32x4 ot[4][2];
        moba_tile<false>(GlobK{C.cache_k + (size_t)pg0 * 32768 + g * 64, C.cache_k + (size_t)pg1 * 32768 + g * 64, g, lane},
                         GlobV{C.cache_v + (size_t)pg0 * 32768 + g * 64, C.cache_v + (size_t)pg1 * 32768 + g * 64, lane}, qf, 16, 0, lane, m, l, ot);
#pragma unroll
        for (int nt = 0; nt < 2; ++nt) if (ok[nt]) { const size_t rec = ((size_t)(seq * 8 + (q32[nt] >> 2)) * 16 + 4 * g + (q32[nt] & 3)) * 3 + sl[nt];
#pragma unroll
            for (int mt = 0; mt < 4; ++mt) *(GAS f32x4*)(SP + rec * 68 + 16 * mt + 4 * g4) = ot[mt][nt];
            if (g4 == 0) { SP[rec * 68 + 64] = m[nt]; SP[rec * 68 + 65] = l[nt]; } }
    }
}
DI void attn_p14(const Ctx& C) {
    int lane = C.lane, il = lane & 15, g4 = lane >> 4;
    LAS unsigned char* Kl = C.lds; LAS unsigned char* Vl = C.lds + 32768;
    const bf16* Q = WSP(bf16, WS_Q); const bf16* KB = WSP(bf16, WS_KB); const bf16* VB = WSP(bf16, WS_VB); const bf16* VTP = WSP(bf16, WS_VTP);
    const bf16* OP = WSP(bf16, WS_OPART); const float* ML = WSP(float, WS_ML); bf16* ATT = WSP(bf16, WS_OG);
#pragma unroll 1
    for (int it = C.vcu; it < 256; it += C.G) { const int n = it & 31, g = (it >> 5) & 3, b = it >> 7;
        __syncthreads(); stage_kv(C.tid, KB + (size_t)(b * SEQ + n * 256) * 256 + g * 64, VTP + (size_t)it * 64 * 256, Kl, Vl); LDS_WAIT(); __syncthreads();
        const int nsl = n < 3 ? n : 3;
#pragma unroll 1
        for (int h4 = 0; h4 < 4; ++h4) { { int tid_l = C.tid; asm volatile("" : "+v"(tid_l)); lane = tid_l & 63; il = lane & 15; g4 = lane >> 4; }
            const int h = 4 * g + h4, q0 = C.wave * 32; bf16x8 qf[2][2];
#pragma unroll
            for (int nt = 0; nt < 2; ++nt) { const bf16* qp = Q + (size_t)(b * SEQ + n * 256 + q0 + nt * 16 + il) * DM + h * 64 + 8 * g4; qf[nt][0] = *(const GAS bf16x8*)qp; qf[nt][1] = *(const GAS bf16x8*)(qp + 32); }
            float m[2], l[2]; f32x4 ot[4][2];
            moba_tile<true>(LdsK{Kl, lane}, LdsV{Vl, lane}, qf, 2 * C.wave + 2, q0, lane, m, l, ot);
#pragma unroll
            for (int nt = 0; nt < 2; ++nt) { const int row = b * SEQ + n * 256 + q0 + nt * 16 + il; const size_t rec = ((size_t)row * 16 + h) * 3;
                float ms[3], ls[3], M = m[nt];
#pragma unroll
                for (int s = 0; s < 3; ++s) { ms[s] = -__builtin_inff(); ls[s] = 0.f; if (s < nsl) { const f32x2 v = *(const GAS f32x2*)(ML + (rec + s) * 2); ms[s] = v[0]; ls[s] = v[1]; M = fmaxf(M, v[0]); } }
                const float LOG2E = 1.4426950408889634f; const float w0 = exp2_f((m[nt] - M) * LOG2E); float L = l[nt] * w0, ws[3];
#pragma unroll
                for (int s = 0; s < 3; ++s) { ws[s] = (s < nsl) ? exp2_f((ms[s] - M) * LOG2E) : 0.f; L += ls[s] * ws[s]; }
                const float inv = 1.f / L;
#pragma unroll
                for (int mt = 0; mt < 4; ++mt) { f32x4 o = ot[mt][nt] * w0;
#pragma unroll
                    for (int s = 0; s < 3; ++s) if (s < nsl) { const v2u pv = *(const GAS v2u*)(OP + (rec + s) * 64 + 16 * mt + 4 * g4); o += (f32x4){bflo(pv.x), bfhi(pv.x), bflo(pv.y), bfhi(pv.y)} * ws[s]; }
                    o = o * inv; v2u w; w.x = pk2(o[0], o[1]); w.y = pk2(o[2], o[3]); *(GAS v2u*)(ATT + (size_t)row * DM + h * 64 + 16 * mt + 4 * g4) = w; } }
        }
    }
    const float* SP = WSP(float, WS_SPART);
    for (int idx = (C.vcu * NTHR + C.tid) >> 4; idx < 32 * 8 * 16; idx += (C.G * NTHR) >> 4) { const int sub = C.tid & 15, h = idx & 15, t = (idx >> 4) & 7, seq = idx >> 7, row = MP + seq * 8 + t, g = h >> 2;
        const v2u qv = *(const GAS v2u*)(Q + (size_t)row * DM + h * 64 + 4 * sub); const float q0 = bflo(qv.x), q1 = bfhi(qv.x), q2 = bflo(qv.y), q3 = bfhi(qv.y);
        const size_t rec = ((size_t)(seq * 8 + t) * 16 + h) * 3;
        float M = -__builtin_inff(), sc[8];
#pragma unroll
        for (int t2 = 0; t2 < 8; ++t2) { const v2u kv = *(const GAS v2u*)(KB + (size_t)(MP + seq * 8 + t2) * 256 + g * 64 + 4 * sub);
            float s = (q0 * bflo(kv.x) + q1 * bfhi(kv.x)) + (q2 * bflo(kv.y) + q3 * bfhi(kv.y));
            s += __shfl_xor(s, 1); s += __shfl_xor(s, 2); s += __shfl_xor(s, 4); s += __shfl_xor(s, 8);
            s = (t2 <= t) ? s * SM_SCALE : -__builtin_inff(); sc[t2] = s; M = fmaxf(M, s); }
        float ms[3], ls[3];
#pragma unroll
        for (int s = 0; s < 3; ++s) { ms[s] = SP[(rec + s) * 68 + 64]; ls[s] = SP[(rec + s) * 68 + 65]; M = fmaxf(M, ms[s]); }
        f32x4 o = {0.f, 0.f, 0.f, 0.f}; float L = 0.f;
#pragma unroll
        for (int s = 0; s < 3; ++s) { const float w = __expf(ms[s] - M); L += ls[s] * w; o += *(const GAS f32x4*)(SP + (rec + s) * 68 + 4 * sub) * w; }
#pragma unroll
        for (int t2 = 0; t2 < 8; ++t2) { const float p = __expf(sc[t2] - M); L += p; const v2u vv = *(const GAS v2u*)(VB + (size_t)(MP + seq * 8 + t2) * 256 + g * 64 + 4 * sub);
            o += (f32x4){bflo(vv.x), bfhi(vv.x), bflo(vv.y), bfhi(vv.y)} * p; }
        const float inv = 1.f / L; v2u w; w.x = pk2(o[0] * inv, o[1] * inv); w.y = pk2(o[2] * inv, o[3] * inv);
        *(GAS v2u*)(ATT + (size_t)row * DM + h * 64 + 4 * sub) = w;
    }
}
constexpr int NPHASE = 20;
struct Args { const void* in[22]; float* out; unsigned char* ws; int ph_lo, ph_hi, li, pad; };
__global__ void __launch_bounds__(NTHR, 2) yoco_fwd(Args args) {
    extern __shared__ __attribute__((aligned(16))) unsigned char lds_raw[];
    Ctx C;
    C.lds = (LAS unsigned char*)lds_raw;
    C.wave = __builtin_amdgcn_readfirstlane((int)threadIdx.x >> 6); C.lane = lane_id(); C.tid = C.wave * 64 + C.lane;
#define REFRESH() do { C.lane = lane_id(); C.tid = C.wave * 64 + C.lane; } while (0)
    C.G = gridDim.x; { const int bx = blockIdx.x; C.vcu = (C.G % 8 == 0) ? (bx % 8) * (C.G / 8) + bx / 8 : bx; }
    C.x_prompt = (const float*)args.in[0]; C.x_sample = (const float*)args.in[1]; C.state_conv = (const float*)args.in[2]; C.state_delta = (const float*)args.in[3];
    C.cache_k = (const float*)args.in[4]; C.cache_v = (const float*)args.in[5]; C.page_table = (const int*)args.in[6]; C.ln_g = (const float*)args.in[7]; C.ln_b = (const float*)args.in[8];
    C.a_w_in = (const float*)args.in[9]; C.a_conv = (const float*)args.in[10]; C.a_log = (const float*)args.in[11]; C.a_dtb = (const float*)args.in[12]; C.a_norm = (const float*)args.in[13];
    C.a_w_out = (const float*)args.in[14]; C.kv_w_k = (const float*)args.in[15]; C.kv_w_v = (const float*)args.in[16]; C.b_w_q = (const float*)args.in[17]; C.b_w_o = (const float*)args.in[18];
    C.w_gate = (const float*)args.in[19]; C.w_up = (const float*)args.in[20]; C.w_down = (const float*)args.in[21];
    C.out = args.out; C.ws = args.ws; C.ctl = (gu32*)(args.ws + WS_CTL);
    volatile LAS unsigned* MISC = (volatile LAS unsigned*)(C.lds + MISC_OFF);
    if (C.tid < 64) MISC[C.tid] = 0u;
    __syncthreads();
    const int lo = args.ph_lo, hi = args.ph_hi;
    XcdBarrier bar; bar.bar = (unsigned*)(C.ctl + 32768) + args.li * 4096; bar.x = 0; bar.st = nullptr;
    if (hi - lo > 1) bar = xcd_barrier_post((unsigned*)(C.ctl + 32768) + args.li * 4096, MISC + 8, C.tid);
#define IN(k) (lo <= (k) && (k) < hi)
#define SEAM(k) do { if (IN(k) && IN((k) + 1)) { REFRESH(); xcd_barrier(bar, C.tid); } } while (0)
    if (IN(0)) { REFRESH(); p0_weights(C); p0_rope(C); p0_cmeans(C); __syncthreads(); p0_x(C); __syncthreads(); }
    SEAM(0);
    if (IN(1)) { REFRESH(); pg8::Gemm g{WSP(bf16, WS_XB), WSP(bf16, WS_WIN), MT, NPROJ, DM}; pg8::StaticOrder S; S.init(MT, NPROJ, C.G, (int)blockIdx.x);
        pg8::EpiBf16<0> E{WSP(bf16, WS_PROJ), NPROJ, nullptr, 0, 0, 1.f};
        pg8::gemm_phase<pg8::EpiBf16<0>, pg8::StaticOrder, true, true>(C.lds, g, S, E, C.tid); }
    SEAM(1);
    if (IN(2)) { REFRESH(); conv_state_out(C); prep_phase(C); }
    SEAM(2);
    if (IN(3)) { REFRESH(); if (blockIdx.x < 128) scan_phase(C); else sample_delta(C); }
    SEAM(3);
    if (IN(4)) { REFRESH(); onorm_phase(C); }
    SEAM(4);
    if (IN(5)) { REFRESH(); pg8::Gemm g{WSP(bf16, WS_OG), WSP(bf16, WS_WOUT), MT, DM, DM}; pg8::StaticOrder S; S.init(MT, DM, C.G, (int)blockIdx.x);
        EpiF32 E{WSP(float, WS_MIX), DM}; pg8::gemm_phase<EpiF32, pg8::StaticOrder, true, true>(C.lds, g, S, E, C.tid); }
    SEAM(5);
    if (IN(6)) { REFRESH(); ln_phase(C, C.x_prompt, C.x_sample, WSP(float, WS_MIX), C.ln_g, C.ln_b, WSP(float, WS_H), WSP(bf16, WS_HB)); }
    SEAM(6);
    if (IN(7)) { REFRESH(); pg8::Gemm g{WSP(bf16, WS_HB), WSP(bf16, WS_WGU0), MT, NGU, DM}; pg8::StaticOrder S; S.init(MT, NGU, C.G, (int)blockIdx.x);
        EpiSwiglu E{WSP(bf16, WS_FF)}; pg8::gemm_phase<EpiSwiglu, pg8::StaticOrder, true, true>(C.lds, g, S, E, C.tid); }
    SEAM(7);
    if (IN(8)) { REFRESH(); pg8::Gemm g{WSP(bf16, WS_FF), WSP(bf16, WS_WD0), MT, DM, FF}; pg8::StaticOrder S; S.init(MT, DM, C.G, (int)blockIdx.x);
        EpiF32 E{WSP(float, WS_MIX), DM}; pg8::gemm_phase<EpiF32, pg8::StaticOrder, true, true>(C.lds, g, S, E, C.tid); }
    SEAM(8);
    if (IN(9)) { REFRESH(); ln_phase(C, WSP(float, WS_H), WSP(float, WS_H) + (size_t)MP * DM, WSP(float, WS_MIX), C.ln_g + DM, C.ln_b + DM, WSP(float, WS_X1), WSP(bf16, WS_X1B)); }
    SEAM(9);
    if (IN(10)) { REFRESH(); pg8::Gemm g{WSP(bf16, WS_X1B), WSP(bf16, WS_WQKV), MT, NQKV, DM}; pg8::StaticOrder S; S.init(MT, NQKV, C.G, (int)blockIdx.x);
        EpiQkvRope E{WSP(bf16, WS_Q), WSP(bf16, WS_KB), WSP(bf16, WS_VB), C.out, WSP(f32x2, WS_ROPE)}; pg8::gemm_phase<EpiQkvRope, pg8::StaticOrder, true, true>(C.lds, g, S, E, C.tid); }
    SEAM(10);
    if (IN(11)) { REFRESH(); attn_p11(C); }
    SEAM(11);
    if (IN(12)) { REFRESH(); attn_p12(C); }
    SEAM(12);
    if (IN(13)) { REFRESH(); attn_p13(C); }
    SEAM(13);
    if (IN(14)) { REFRESH(); attn_p14(C); }
    SEAM(14);
    if (IN(15)) { REFRESH(); pg8::Gemm g{WSP(bf16, WS_OG), WSP(bf16, WS_WO), MT, DM, DM}; pg8::StaticOrder S; S.init(MT, DM, C.G, (int)blockIdx.x);
        EpiF32 E{WSP(float, WS_MIX), DM}; pg8::gemm_phase<EpiF32, pg8::StaticOrder, true, true>(C.lds, g, S, E, C.tid); }
    SEAM(15);
    if (IN(16)) { REFRESH(); ln_phase(C, WSP(float, WS_X1), WSP(float, WS_X1) + (size_t)MP * DM, WSP(float, WS_MIX), C.ln_g + 2 * DM, C.ln_b + 2 * DM, WSP(float, WS_H), WSP(bf16, WS_HB)); }
    SEAM(16);
    if (IN(17)) { REFRESH(); pg8::Gemm g{WSP(bf16, WS_HB), WSP(bf16, WS_WGU1), MT, NGU, DM}; pg8::StaticOrder S; S.init(MT, NGU, C.G, (int)blockIdx.x);
        EpiSwiglu E{WSP(bf16, WS_FF)}; pg8::gemm_phase<EpiSwiglu, pg8::StaticOrder, true, true>(C.lds, g, S, E, C.tid); }
    SEAM(17);
    if (IN(18)) { REFRESH(); pg8::Gemm g{WSP(bf16, WS_FF), WSP(bf16, WS_WD1), MT, DM, FF}; pg8::StaticOrder S; S.init(MT, DM, C.G, (int)blockIdx.x);
        EpiF32 E{WSP(float, WS_MIX), DM}; pg8::gemm_phase<EpiF32, pg8::StaticOrder, true, true>(C.lds, g, S, E, C.tid); }
    SEAM(18);
    if (IN(19)) { REFRESH(); ln_phase(C, WSP(float, WS_H), WSP(float, WS_H) + (size_t)MP * DM, WSP(float, WS_MIX), C.ln_g + 3 * DM, C.ln_b + 3 * DM, C.out + O_Y, nullptr); }

#undef IN
#undef SEAM
}

#ifndef MK_SPLIT
#define MK_SPLIT 1
#endif
extern "C" void kernel_launch(void* const* d_in, const int* in_sizes, int n_in, void* d_out, int out_size, void* d_ws, size_t ws_size, hipStream_t stream) {
    static int grid = 0;
    if (grid == 0) {
        if (n_in != 22 || ws_size < WS_END) { fprintf(stderr, "kernel_launch: unexpected sizes n_in %d out %d ws %zu\n", n_in, out_size, ws_size); grid = -1; return; }
        int dev = 0, cus = 0;
        if (hipGetDevice(&dev) != hipSuccess || hipDeviceGetAttribute(&cus, hipDeviceAttributeMultiprocessorCount, dev) != hipSuccess) { grid = -1; return; }
        if (hipFuncSetAttribute((const void*)yoco_fwd, hipFuncAttributeMaxDynamicSharedMemorySize, LDS_BYTES) != hipSuccess) { fprintf(stderr, "kernel_launch: hipFuncSetAttribute failed\n"); grid = -1; return; }
        int per_cu = 0;
        if (hipOccupancyMaxActiveBlocksPerMultiprocessor(&per_cu, (const void*)yoco_fwd, NTHR, LDS_BYTES) != hipSuccess || per_cu < 1) { fprintf(stderr, "kernel_launch: occupancy query says %d\n", per_cu); }
        (void)hipGetLastError();
        grid = cus;
    }
    if (grid < 0) return;
    (void)hipMemsetAsync((char*)d_ws + WS_CTL, 0, CTL_ZERO_BYTES, stream);
    Args a{};
    for (int i = 0; i < 22; ++i) a.in[i] = d_in[i];
    a.out = (float*)d_out; a.ws = (unsigned char*)d_ws;
#if MK_SPLIT
    for (int p = 0; p < NPHASE; ++p) { a.ph_lo = p; a.ph_hi = p + 1; a.li = p; hipLaunchKernelGGL(yoco_fwd, dim3(grid), dim3(NTHR), LDS_BYTES, stream, a); }
#else
    a.ph_lo = 0; a.ph_hi = NPHASE; a.li = 0; hipLaunchKernelGGL(yoco_fwd, dim3(grid), dim3(NTHR), LDS_BYTES, stream, a);
#endif
}
```

```cpp
#include <hip/hip_runtime.h>
#include <cstdio>
#include <cstdint>
namespace pg8 {
#define PG8_LAS __attribute__((address_space(3)))
typedef unsigned short bf16_t;
typedef short bf16x8 __attribute__((ext_vector_type(8)));
typedef float f32x4 __attribute__((ext_vector_type(4)));
typedef unsigned u32x4 __attribute__((ext_vector_type(4)));
constexpr int BM = 256, BK = 64, HALF = 128, HTB = HALF * BK * 2  , STAGE_BYTES = 8 * HTB, NXCD = 8, WGM = 8;

__host__ __device__ __forceinline__ int lds_byte(int r, int c) { const int st = (r >> 4) * 2 + (c >> 5), rr = r & 15, cc = c & 31, ob = rr * 64 + cc * 2; return st * 1024 + (ob ^ (((ob >> 9) & 1) << 5)); }
__host__ __device__ __forceinline__ void stage_rc(int b, int& R, int& C) { const int st = b / 1024, sb = b % 1024, swz = sb ^ (((sb >> 9) & 1) << 5); R = (st >> 1) * 16 + swz / 64; C = (st & 1) * 32 + (swz % 64) / 2; }
__host__ __device__ __forceinline__ int perm32(int rho) { const int n = rho >> 4, i = rho & 15; return 8 * (i >> 2) + 4 * n + (i & 3); }

struct Unit { int pm, pn; };
struct Gemm { const bf16_t* A; const bf16_t* Bt; int M, N, K; };

struct StaticOrder {
    int nM, nN, nwg, G, c;
    __host__ __device__ void init(int M, int N, int G_, int c_) { nM = M / BM; nN = N / BM; nwg = nM * nN; G = G_; c = c_; }
    __host__ __device__ bool next(int i, Unit& u) const {
        const long L = (long)i * G + c; if (L >= nwg) return false;
        int wgid = (int)L; { const int q = nwg / NXCD, r = nwg % NXCD, xcd = wgid % NXCD, off = wgid / NXCD; wgid = (xcd < r ? xcd * (q + 1) : r * (q + 1) + (xcd - r) * q) + off; }
        const int nig = WGM * nN, gid = wgid / nig, fm = gid * WGM, gsz = (nM - fm) < WGM ? (nM - fm) : WGM;
        u.pm = fm + ((wgid % nig) % gsz); u.pn = (wgid % nig) / gsz; return true;
    }
    __device__ __forceinline__ void a_ready(const Unit&) const {}
    __device__ __forceinline__ void done(const Unit&) const {}
};

__device__ __forceinline__ unsigned cvt_pk_bf16(float lo, float hi) { unsigned r; asm volatile("v_cvt_pk_bf16_f32 %0, %1, %2" : "=v"(r) : "v"(lo), "v"(hi)); return r; }
typedef float f32x2 __attribute__((ext_vector_type(2)));
__device__ __forceinline__ f32x2 gelu_pk(f32x2 v) {
    const f32x2 av = __builtin_elementwise_abs(v), d = av * 0.2316418882f + 1.0f;
    f32x2 t; t.x = __builtin_amdgcn_rcpf(d.x); t.y = __builtin_amdgcn_rcpf(d.y);
    f32x2 q = t * 0.5307027145f + (-0.7265760135f); q = q * t + 0.7107068705f; q = q * t + (-0.142248368f); q = q * t + 0.127414796f; q = q * t;
    const f32x2 s = (v * v) * (-0.72134752044f);
    f32x2 e; e.x = __builtin_amdgcn_exp2f(s.x); e.y = __builtin_amdgcn_exp2f(s.y);
    const f32x2 m = v * (q * e), r = v - m;
    f32x2 o; o.x = v.x < 0.f ? m.x : r.x; o.y = v.y < 0.f ? m.y : r.y; return o;
}

template <int ACT  > struct EpiBf16 {
    static constexpr bool PERM = true, AFTER_DRAIN = false; static_assert(ACT == 0 || ACT == 1, "EpiBf16: ACT is 0 (none) or 1 (gelu_pk)");
    bf16_t* O; int ldc; const float* bias; int split_cols; size_t split_stride; float scale0;
    __device__ __forceinline__ void operator()(const f32x4 (&acc)[2][2][4][2], const Unit& u, int wr, int wc, int fr, int fq) const {
        const int row0 = u.pm * BM + wr * 64 + fr; int colt = u.pn * BM; bf16_t* base = O;
        float sc = 1.f; if (split_cols) { const int t = colt / split_cols; base += (size_t)t * split_stride; colt -= t * split_cols; if (t == 0) sc = scale0; }
        const int col0 = colt + wc * 32 + 8 * fq, bcol0 = u.pn * BM + wc * 32 + 8 * fq;
        f32x4 bv[2][2];
#pragma unroll
        for (int bj = 0; bj < 2; ++bj)
#pragma unroll
            for (int n = 0; n < 2; ++n) bv[bj][n] = bias ? *(const f32x4*)(bias + bcol0 + bj * HALF + 4 * n) : (f32x4){0.f, 0.f, 0.f, 0.f};
#pragma unroll
        for (int ai = 0; ai < 2; ++ai)
#pragma unroll
            for (int m = 0; m < 4; ++m) { bf16_t* rowp = base + (size_t)(row0 + ai * HALF + m * 16) * ldc + col0;
#pragma unroll
                for (int bj = 0; bj < 2; ++bj) { f32x4 v0 = acc[ai][bj][m][0] + bv[bj][0], v1 = acc[ai][bj][m][1] + bv[bj][1];
                    if (ACT == 1) { f32x2 a = gelu_pk((f32x2){v0[0], v0[1]}), b = gelu_pk((f32x2){v0[2], v0[3]}), c = gelu_pk((f32x2){v1[0], v1[1]}), d = gelu_pk((f32x2){v1[2], v1[3]});
                        v0 = (f32x4){a.x, a.y, b.x, b.y}; v1 = (f32x4){c.x, c.y, d.x, d.y}; }
                    v0 = v0 * sc; v1 = v1 * sc; u32x4 w; w.x = cvt_pk_bf16(v0[0], v0[1]); w.y = cvt_pk_bf16(v0[2], v0[3]); w.z = cvt_pk_bf16(v1[0], v1[1]); w.w = cvt_pk_bf16(v1[2], v1[3]);
                    *(u32x4*)(rowp + bj * HALF) = w; } }
    }
};

struct PanelStats {
    unsigned* xbuf;
    unsigned* cnt;
    unsigned* tmo;
    int ntn; float eps;
    unsigned code;
    __device__ __forceinline__ bool run(const f32x4 (&v)[2][2][4][2], const Unit& u, int wr, int wc, int fr, int fq, PG8_LAS unsigned char* lds, int wid, int lane) const {
        typedef float f32x2v __attribute__((ext_vector_type(2)));
        PG8_LAS f32x2v* P = (PG8_LAS f32x2v*)lds;
        PG8_LAS f32x2v* S = (PG8_LAS f32x2v*)(lds + 8192);
        PG8_LAS unsigned* flag = (PG8_LAS unsigned*)(lds + 8192 + 2048);
#pragma unroll
        for (int ai = 0; ai < 2; ++ai)
#pragma unroll
            for (int m = 0; m < 4; ++m) {
                float s = 0.f;
#pragma unroll
                for (int bj = 0; bj < 2; ++bj)
#pragma unroll
                    for (int n = 0; n < 2; ++n) { const f32x4 x = v[ai][bj][m][n]; s += (x[0] + x[1]) + (x[2] + x[3]); }
                s += __shfl_xor(s, 16); s += __shfl_xor(s, 32);
                const float mw = s * (1.0f / 64.0f); float q = 0.f;
#pragma unroll
                for (int bj = 0; bj < 2; ++bj)
#pragma unroll
                    for (int n = 0; n < 2; ++n) { const f32x4 d = v[ai][bj][m][n] - mw; q += (d[0] * d[0] + d[1] * d[1]) + (d[2] * d[2] + d[3] * d[3]); }
                q += __shfl_xor(q, 16); q += __shfl_xor(q, 32);
                if (fq == 0) P[(ai * HALF + wr * 64 + m * 16 + fr) * 4 + wc] = (f32x2v){mw, q};
            }
        asm volatile("s_waitcnt lgkmcnt(0)" ::: "memory"); __builtin_amdgcn_s_barrier(); asm volatile("" ::: "memory");
#if defined(BROKEN_EXCHANGE_NO_WAIT)
#warning BROKEN CONTROL BUILD: the row-statistics exchange does not wait; results are wrong by design
        if (blockIdx.x >= 64) { const long long t0_ = clock64(); while (clock64() - t0_ < 60000) __builtin_amdgcn_s_sleep(8); }
#endif
        const int row = wid * 32 + (lane & 31);
        if (lane < 32) {
            const f32x2v a = P[row * 4 + 0], b = P[row * 4 + 1], c = P[row * 4 + 2], d = P[row * 4 + 3];
            const float mt = (a.x + b.x + c.x + d.x) * 0.25f;
            const float da = a.x - mt, db = b.x - mt, dc = c.x - mt, dd = d.x - mt;
            const float m2 = (a.y + b.y) + (c.y + d.y) + 64.0f * ((da * da + db * db) + (dc * dc + dd * dd));
            unsigned long long* slot = (unsigned long long*)xbuf + ((size_t)(u.pm * BM + row) * 4 + u.pn);
            __hip_atomic_store(slot, ((unsigned long long)__float_as_uint(m2) << 32) | __float_as_uint(mt), __ATOMIC_RELAXED, __HIP_MEMORY_SCOPE_AGENT);
        }
        asm volatile("s_waitcnt vmcnt(0)" ::: "memory");
        if (lane == 0) __hip_atomic_fetch_add(cnt + 64 * u.pm, 1u, __ATOMIC_RELAXED, __HIP_MEMORY_SCOPE_AGENT);
        if (wid == 0) {
            bool dead = false; const unsigned long long t0 = __builtin_amdgcn_s_memrealtime(); const unsigned want = 8u * (unsigned)ntn;
            for (;;) {
#if defined(BROKEN_EXCHANGE_NO_WAIT)
                break;
#endif
                if ((unsigned)__builtin_amdgcn_readfirstlane(__hip_atomic_load(cnt + 64 * u.pm, __ATOMIC_RELAXED, __HIP_MEMORY_SCOPE_AGENT)) >= want) break;
                if (__builtin_amdgcn_s_memrealtime() - t0 > 2000000ull) {
                    if (lane == 0) { unsigned expect = 0u; __hip_atomic_compare_exchange_strong(tmo + 1, &expect, code | (unsigned)(u.pm & 0xff), __ATOMIC_RELAXED, __ATOMIC_RELAXED, __HIP_MEMORY_SCOPE_AGENT);
                                     __hip_atomic_store(tmo, 1u, __ATOMIC_RELAXED, __HIP_MEMORY_SCOPE_AGENT); }
                    dead = true; break; }
                __builtin_amdgcn_s_sleep(2);
            }
            __builtin_amdgcn_fence(__ATOMIC_ACQUIRE, "agent");
            if (lane == 0) flag[0] = dead ? 1u : 0u;
        }
        asm volatile("s_waitcnt vmcnt(0) lgkmcnt(0)" ::: "memory"); __builtin_amdgcn_s_barrier(); asm volatile("" ::: "memory");
        const bool bad = flag[0] != 0u;
        if (lane < 32) {
            const unsigned long long* slot = (const unsigned long long*)xbuf + (size_t)(u.pm * BM + row) * 4; float mt[4], m2[4]; float ms = 0.f;
#pragma unroll
            for (int t = 0; t < 4; ++t) { if (t < ntn) { const unsigned long long w = __hip_atomic_load(slot + t, __ATOMIC_RELAXED, __HIP_MEMORY_SCOPE_AGENT); mt[t] = __uint_as_float((unsigned)w); m2[t] = __uint_as_float((unsigned)(w >> 32)); } else { mt[t] = 0.f; m2[t] = 0.f; } ms += mt[t]; }
            const float mean = ms / (float)ntn; float q = 0.f;
#pragma unroll
            for (int t = 0; t < 4; ++t) if (t < ntn) { const float dm = mt[t] - mean; q += m2[t] + 256.0f * dm * dm; }
            S[row] = (f32x2v){mean, 1.0f / sqrtf(q / (256.0f * (float)ntn) + eps)};
        }
        asm volatile("s_waitcnt lgkmcnt(0)" ::: "memory"); __builtin_amdgcn_s_barrier(); asm volatile("" ::: "memory");
        return bad;
    }
};
struct EpiLnRes {
    static constexpr bool PERM = false, AFTER_DRAIN = true;
    const float* base; float* out; int ldc; const float* bias; PanelStats st; unsigned poison;
    __device__ __forceinline__ void fused(f32x4 (&acc)[2][2][4][2], const Unit& u, int wr, int wc, int fr, int fq, PG8_LAS unsigned char* lds, int wid, int lane) const {
        typedef float f32x2v __attribute__((ext_vector_type(2)));
        const PG8_LAS f32x2v* S = (const PG8_LAS f32x2v*)(lds + 8192);
        const int col0 = u.pn * BM + wc * 32 + 4 * fq;
#pragma unroll
        for (int bj = 0; bj < 2; ++bj)
#pragma unroll
            for (int n = 0; n < 2; ++n) { const f32x4 bv = bias ? *(const f32x4*)(bias + col0 + bj * HALF + n * 16) : (f32x4){0.f, 0.f, 0.f, 0.f};
#pragma unroll
                for (int ai = 0; ai < 2; ++ai)
#pragma unroll
                    for (int m = 0; m < 4; ++m) acc[ai][bj][m][n] += bv; }
        f32x4 pre[4][2][2];
#pragma unroll
        for (int m = 0; m < 4; ++m) { const size_t off = (size_t)(u.pm * BM + wr * 64 + m * 16 + fr) * ldc + col0;
#pragma unroll
            for (int bj = 0; bj < 2; ++bj)
#pragma unroll
                for (int n = 0; n < 2; ++n) pre[m][bj][n] = *(const f32x4*)(base + off + bj * HALF + n * 16); }
        const bool bad = st.run(acc, u, wr, wc, fr, fq, lds, wid, lane) || poison != 0u;
        const float qnan = __builtin_nanf("");
#pragma unroll
        for (int ai = 0; ai < 2; ++ai)
#pragma unroll
            for (int m = 0; m < 4; ++m) { const int r = ai * HALF + wr * 64 + m * 16 + fr; const f32x2v sr = S[r]; const size_t off = (size_t)(u.pm * BM + r) * ldc + col0;
#pragma unroll
                for (int bj = 0; bj < 2; ++bj)
#pragma unroll
                    for (int n = 0; n < 2; ++n) { const f32x4 bs = ai == 0 ? pre[m][bj][n] : *(const f32x4*)(base + off + bj * HALF + n * 16); f32x4 o = bs + (acc[ai][bj][m][n] - sr.x) * sr.y;
                        if (bad) o = (f32x4){qnan, qnan, qnan, qnan}; *(f32x4*)(out + off + bj * HALF + n * 16) = o; }
                if (m & 1) asm volatile("" ::: "memory"); }
    }
};
struct EpiLnResLn {
    static constexpr bool PERM = false, AFTER_DRAIN = true;
    const float* base; float* out; bf16_t* xn; int ldc; const float* bias; PanelStats st1, st2; unsigned poison;
    __device__ __forceinline__ void fused(f32x4 (&acc)[2][2][4][2], const Unit& u, int wr, int wc, int fr, int fq, PG8_LAS unsigned char* lds, int wid, int lane) const {
        typedef float f32x2v __attribute__((ext_vector_type(2))); typedef unsigned u32x2v __attribute__((ext_vector_type(2)));
        const PG8_LAS f32x2v* S = (const PG8_LAS f32x2v*)(lds + 8192);
        const int col0 = u.pn * BM + wc * 32 + 4 * fq;
#pragma unroll
        for (int bj = 0; bj < 2; ++bj)
#pragma unroll
            for (int n = 0; n < 2; ++n) { const f32x4 bv = bias ? *(const f32x4*)(bias + col0 + bj * HALF + n * 16) : (f32x4){0.f, 0.f, 0.f, 0.f};
#pragma unroll
                for (int ai = 0; ai < 2; ++ai)
#pragma unroll
                    for (int m = 0; m < 4; ++m) acc[ai][bj][m][n] += bv; }
        bool bad = st1.run(acc, u, wr, wc, fr, fq, lds, wid, lane) || poison != 0u;
        const float qnan = __builtin_nanf("");
#pragma unroll
        for (int ai = 0; ai < 2; ++ai)
#pragma unroll
            for (int m = 0; m < 4; ++m) { const int r = ai * HALF + wr * 64 + m * 16 + fr; const f32x2v sr = S[r]; const size_t off = (size_t)(u.pm * BM + r) * ldc + col0;
#pragma unroll
                for (int bj = 0; bj < 2; ++bj)
#pragma unroll
                    for (int n = 0; n < 2; ++n) { const f32x4 bs = *(const f32x4*)(base + off + bj * HALF + n * 16); acc[ai][bj][m][n] = bs + (acc[ai][bj][m][n] - sr.x) * sr.y; }
                asm volatile("" : "+v"(acc[ai][0][m][0]), "+v"(acc[ai][0][m][1]), "+v"(acc[ai][1][m][0]), "+v"(acc[ai][1][m][1]));
                if (m & 1) asm volatile("" ::: "memory"); }
        const bool bad1 = bad;
        bad = st2.run(acc, u, wr, wc, fr, fq, lds, wid, lane) || bad;
#pragma unroll
        for (int ai = 0; ai < 2; ++ai)
#pragma unroll
            for (int m = 0; m < 4; ++m) { const int r = ai * HALF + wr * 64 + m * 16 + fr; const f32x2v sr = S[r]; const size_t off = (size_t)(u.pm * BM + r) * ldc + col0;
#pragma unroll
                for (int bj = 0; bj < 2; ++bj)
#pragma unroll
                    for (int n = 0; n < 2; ++n) { const f32x4 x1 = acc[ai][bj][m][n]; *(f32x4*)(out + off + bj * HALF + n * 16) = bad1 ? (f32x4){qnan, qnan, qnan, qnan} : x1;
                        const f32x4 o = (x1 - sr.x) * sr.y; u32x2v w; w.x = cvt_pk_bf16(o[0], o[1]); w.y = cvt_pk_bf16(o[2], o[3]);
                        if (bad) { w.x = 0x7fc07fc0u; w.y = 0x7fc07fc0u; } *(u32x2v*)(xn + off + bj * HALF + n * 16) = w; }
                asm volatile("" ::: "memory"); }
    }
};

template <class Epi, class Sched, bool ALIGN_EPI = false, bool SP2 = false>
__device__ __forceinline__ void gemm_phase(PG8_LAS unsigned char* lds, const Gemm g, const Sched& S, const Epi& E, int tid_arg) {
    const int tid = tid_arg, wid = __builtin_amdgcn_readfirstlane(tid >> 6), lane = tid & 63, wr = wid >> 2, wc = wid & 3, fr = lane & 15, fq = lane >> 4;
    const int K = g.K, nt = K / BK;
    unsigned voffA[2], voffB[2];
#pragma unroll
    for (int i = 0; i < 2; ++i) { int R, C; stage_rc(tid * 16 + i * 8192, R, C); const int Rb = Epi::PERM ? ((R & ~31) + perm32(R & 31)) : R;
        voffA[i] = (unsigned)(R * K + C) * 2u; voffB[i] = (unsigned)(Rb * K + C) * 2u; }
    const size_t kstep = (size_t)(BK * 2);
    const size_t hstep = (size_t)HALF * K * 2;
    const size_t tstep = 2 * hstep;
    const unsigned ldsw = (unsigned)wid * 1024u;
    const int aoff = lds_byte(wr * 64 + fr, fq * 8), boff = lds_byte(wc * 32 + fr, fq * 8);
#define PG8_SA(b, h) (((b) * 2 + (h)) * HTB)
#define PG8_SB(b, h) ((4 + (b) * 2 + (h)) * HTB)
#define PG8_STAGE(bufoff, gbase, voff) do { _Pragma("unroll") for (int _i = 0; _i < 2; ++_i) \
        __builtin_amdgcn_global_load_lds((const unsigned*)((const char*)(gbase) + (voff)[_i]), (PG8_LAS unsigned*)(lds + (bufoff) + ldsw + _i * 8192), 16, 0, 0); } while (0)
#define PG8_LDA(dst, b, h) do { _Pragma("unroll") for (int m = 0; m < 4; ++m) _Pragma("unroll") for (int k = 0; k < 2; ++k) dst[m][k] = *(const PG8_LAS bf16x8*)(lds + PG8_SA(b, h) + aoff + m * 2048 + k * 1024); } while (0)
#define PG8_LDB(dst, b, h) do { _Pragma("unroll") for (int n = 0; n < 2; ++n) _Pragma("unroll") for (int k = 0; k < 2; ++k) dst[n][k] = *(const PG8_LAS bf16x8*)(lds + PG8_SB(b, h) + boff + n * 2048 + k * 1024); } while (0)
#define PG8_MMA(ai, bj, At, Bt) do { __builtin_amdgcn_s_setprio(1); _Pragma("unroll") for (int m = 0; m < 4; ++m) _Pragma("unroll") for (int n = 0; n < 2; ++n) _Pragma("unroll") for (int k = 0; k < 2; ++k) \
        acc[ai][bj][m][n] = __builtin_amdgcn_mfma_f32_16x16x32_bf16(Bt[n][k], At[m][k], acc[ai][bj][m][n], 0, 0, 0); __builtin_amdgcn_s_setprio(0); } while (0)
#define PG8_WAIT_V(n) asm volatile("s_waitcnt vmcnt(" #n ")" ::: "memory")
#define PG8_WAIT_L(n) asm volatile("s_waitcnt lgkmcnt(" #n ")" ::: "memory")
#define PG8_BAR __builtin_amdgcn_s_barrier()
#define PG8_SCHED __builtin_amdgcn_sched_barrier(0)
    Unit cur, nxt; int ui = 0;
    if (!S.next(0, cur)) return;
    f32x4 acc[2][2][4][2];
#pragma unroll
    for (int a = 0; a < 2; ++a)
#pragma unroll
        for (int b = 0; b < 2; ++b)
#pragma unroll
            for (int m = 0; m < 4; ++m)
#pragma unroll
                for (int n = 0; n < 2; ++n) acc[a][b][m][n] = (f32x4){0.f, 0.f, 0.f, 0.f};
    bf16x8 At[4][2], B0[2][2], B1[2][2];
    const char* cA = (const char*)g.A + (size_t)cur.pm * tstep; const char* cB = (const char*)g.Bt + (size_t)cur.pn * tstep;
    S.a_ready(cur);
    if constexpr (SP2) {
        PG8_STAGE(PG8_SB(0, 0), cB, voffB); PG8_STAGE(PG8_SB(0, 1), cB + hstep, voffB); PG8_STAGE(PG8_SA(0, 0), cA, voffA); PG8_STAGE(PG8_SA(0, 1), cA + hstep, voffA);
        if (wr == 1) PG8_BAR;
        PG8_WAIT_V(2); PG8_BAR;
        PG8_STAGE(PG8_SB(1, 0), cB + kstep, voffB); PG8_STAGE(PG8_SA(1, 0), cA + kstep, voffA); PG8_STAGE(PG8_SB(1, 1), cB + hstep + kstep, voffB);
        PG8_WAIT_V(6); PG8_BAR;
    } else {
        PG8_STAGE(PG8_SB(0, 0), cB, voffB); PG8_STAGE(PG8_SA(0, 0), cA, voffA); PG8_STAGE(PG8_SB(0, 1), cB + hstep, voffB); PG8_STAGE(PG8_SA(0, 1), cA + hstep, voffA);
        if (wr == 1) PG8_BAR;
        PG8_WAIT_V(4); PG8_BAR;
        PG8_STAGE(PG8_SB(1, 0), cB + kstep, voffB); PG8_STAGE(PG8_SA(1, 0), cA + kstep, voffA); PG8_STAGE(PG8_SB(1, 1), cB + hstep + kstep, voffB);
        PG8_WAIT_V(6); PG8_BAR;
    }
    for (;;) {
        const bool has_next = S.next(ui + 1, nxt);
        const char* nA = has_next ? (const char*)g.A + (size_t)nxt.pm * tstep : cA; const char* nB = has_next ? (const char*)g.Bt + (size_t)nxt.pn * tstep : cB;
        for (int t = 0; t < nt; t += 2) {
            const bool last = (t == nt - 2);
            const char* a1 = cA + (size_t)(t + 1) * kstep;
            const char* a2 = last ? nA : cA + (size_t)(t + 2) * kstep; const char* b2 = last ? nB : cB + (size_t)(t + 2) * kstep;
            const char* a3 = a2 + kstep; const char* b3 = b2 + kstep;
            if (last && has_next) S.a_ready(nxt);
            if constexpr (SP2) {
            PG8_LDB(B0, 0, 0); PG8_LDB(B1, 0, 1); PG8_SCHED; PG8_LDA(At, 0, 0); PG8_STAGE(PG8_SA(1, 1), a1 + hstep, voffA);
            PG8_WAIT_V(8); PG8_WAIT_L(0); PG8_BAR; PG8_MMA(0, 0, At, B0); PG8_MMA(0, 1, At, B1); PG8_BAR; PG8_SCHED;
            PG8_LDA(At, 0, 1); PG8_STAGE(PG8_SB(0, 0), b2, voffB); PG8_STAGE(PG8_SB(0, 1), b2 + hstep, voffB); PG8_STAGE(PG8_SA(0, 0), a2, voffA);
            PG8_WAIT_V(8); PG8_WAIT_L(0); PG8_BAR; PG8_MMA(1, 0, At, B0); PG8_MMA(1, 1, At, B1); PG8_BAR; PG8_SCHED;
            PG8_LDB(B0, 1, 0); PG8_LDB(B1, 1, 1); PG8_SCHED; PG8_LDA(At, 1, 0); PG8_STAGE(PG8_SA(0, 1), a2 + hstep, voffA);
            PG8_WAIT_V(8); PG8_WAIT_L(0); PG8_BAR; PG8_MMA(0, 0, At, B0); PG8_MMA(0, 1, At, B1); PG8_BAR; PG8_SCHED;
            PG8_LDA(At, 1, 1); PG8_STAGE(PG8_SB(1, 0), b3, voffB); PG8_STAGE(PG8_SB(1, 1), b3 + hstep, voffB); PG8_STAGE(PG8_SA(1, 0), a3, voffA);
            PG8_WAIT_V(8); PG8_WAIT_L(0); PG8_BAR; PG8_MMA(1, 0, At, B0); PG8_MMA(1, 1, At, B1); PG8_BAR; PG8_SCHED;
            } else {
            PG8_LDB(B0, 0, 0); PG8_SCHED; PG8_LDA(At, 0, 0); PG8_STAGE(PG8_SA(1, 1), a1 + hstep, voffA);
            PG8_WAIT_L(8); PG8_BAR; PG8_WAIT_L(0); PG8_MMA(0, 0, At, B0); PG8_BAR; PG8_SCHED;
            PG8_LDB(B1, 0, 1); PG8_STAGE(PG8_SB(0, 0), b2, voffB);
            PG8_BAR; PG8_WAIT_L(0); PG8_MMA(0, 1, At, B1); PG8_BAR;
            PG8_LDA(At, 0, 1); PG8_STAGE(PG8_SA(0, 0), a2, voffA);
            PG8_BAR; PG8_WAIT_L(0); PG8_MMA(1, 0, At, B0); PG8_BAR; PG8_SCHED;
            PG8_STAGE(PG8_SB(0, 1), b2 + hstep, voffB);
            PG8_WAIT_V(6); PG8_BAR; PG8_MMA(1, 1, At, B1); PG8_BAR;
            PG8_LDB(B0, 1, 0); PG8_SCHED; PG8_LDA(At, 1, 0); PG8_STAGE(PG8_SA(0, 1), a2 + hstep, voffA);
            PG8_WAIT_L(8); PG8_BAR; PG8_WAIT_L(0); PG8_MMA(0, 0, At, B0); PG8_BAR; PG8_SCHED;
            PG8_LDB(B1, 1, 1); PG8_STAGE(PG8_SB(1, 0), b3, voffB);
            PG8_BAR; PG8_WAIT_L(0); PG8_MMA(0, 1, At, B1); PG8_BAR;
            PG8_LDA(At, 1, 1); PG8_STAGE(PG8_SA(1, 0), a3, voffA);
            PG8_BAR; PG8_WAIT_L(0); PG8_MMA(1, 0, At, B0); PG8_BAR; PG8_SCHED;
            PG8_STAGE(PG8_SB(1, 1), b3 + hstep, voffB);
            PG8_WAIT_V(6); PG8_BAR; PG8_MMA(1, 1, At, B1); PG8_BAR;
            }
        }
        if constexpr (ALIGN_EPI) { if (wr == 0) PG8_BAR; }
        if constexpr (!Epi::AFTER_DRAIN) { E(acc, cur, wr, wc, fr, fq); S.done(cur); }
        if (!has_next) break;
#pragma unroll
        for (int a = 0; a < 2; ++a)
#pragma unroll
            for (int b = 0; b < 2; ++b)
#pragma unroll
                for (int m = 0; m < 4; ++m)
#pragma unroll
                    for (int n = 0; n < 2; ++n) acc[a][b][m][n] = (f32x4){0.f, 0.f, 0.f, 0.f};
        cur = nxt; cA = nA; cB = nB; ++ui;
        if constexpr (ALIGN_EPI) { if (wr == 1) PG8_BAR; }
    }
    PG8_WAIT_V(0);
    if constexpr (!ALIGN_EPI) { if (wr == 0) PG8_BAR; }
    PG8_BAR;
    if constexpr (Epi::AFTER_DRAIN) { E.fused(acc, cur, wr, wc, fr, fq, lds, wid, lane); S.done(cur); }
#undef PG8_SA
#undef PG8_SB
#undef PG8_STAGE
#undef PG8_LDA
#undef PG8_LDB
#undef PG8_MMA
#undef PG8_WAIT_V
#undef PG8_WAIT_L
#undef PG8_BAR
#undef PG8_SCHED
}
}
#define GAS __attribute__((address_space(1)))
#define LAS __attribute__((address_space(3)))
typedef unsigned short bf16;
typedef unsigned v4u __attribute__((ext_vector_type(4)));
typedef float f32x4 __attribute__((ext_vector_type(4)));
typedef short bf16x8 __attribute__((ext_vector_type(8)));
typedef GAS unsigned gu32;
typedef GAS unsigned long long gu64;
#define RLX_AGENT __ATOMIC_RELAXED, __HIP_MEMORY_SCOPE_AGENT
#define LDS_WAIT() asm volatile("s_waitcnt lgkmcnt(0)" ::: "memory")
#define VM_WAIT() asm volatile("s_waitcnt vmcnt(0)" ::: "memory")
__device__ __forceinline__ unsigned long long rt() { return __builtin_amdgcn_s_memrealtime(); }
__device__ __forceinline__ unsigned f2bf(float f) { unsigned u = __builtin_bit_cast(unsigned, f); return (u + 0x7fffu + ((u >> 16) & 1u)) >> 16; }
typedef float f32x2_cv __attribute__((ext_vector_type(2))); typedef __bf16 bf16x2_cv __attribute__((ext_vector_type(2)));
__device__ __forceinline__ unsigned pk2(float lo, float hi) { f32x2_cv v = {lo, hi}; bf16x2_cv b = __builtin_convertvector(v, bf16x2_cv); return __builtin_bit_cast(unsigned, b); }

#define XB_TMO      128
#define XB_XCNT(j)  (256  + 64 * (j))
#define XB_XSUB(j)  (1280 + 64 * (j))
#define XB_XGEN(j)  (2304 + 64 * (j))
#define XB_TOP      3328
#define XB_TOPGEN   3392
#define XCD_BAR_WORDS 3456
#define XB_SPIN_CAP (1u << 18)

__device__ __forceinline__ unsigned xb_ld(unsigned* p)              { return __hip_atomic_load(p, __ATOMIC_RELAXED, __HIP_MEMORY_SCOPE_AGENT); }
__device__ __forceinline__ unsigned xb_add(unsigned* p, unsigned v) { return __hip_atomic_fetch_add(p, v, __ATOMIC_RELAXED, __HIP_MEMORY_SCOPE_AGENT); }
__device__ __forceinline__ unsigned xb_xcc_id() { return (unsigned)__builtin_amdgcn_s_getreg((3 << 11) | 20) & 0xFu; }
#define XB_SPIN(cond, bar) do { unsigned _sp = 0; while (cond) { __builtin_amdgcn_s_sleep(1); \
    if ((++_sp & 255u) == 0u) { if (xb_ld(&(bar)[XB_TMO])) break; if (_sp > XB_SPIN_CAP) { atomicAdd(&(bar)[XB_TMO], 1u); break; } } } } while (0)

struct XcdBarrier {
    unsigned* bar; unsigned x;
    volatile LAS unsigned* st;
};

__device__ __forceinline__ XcdBarrier xcd_barrier_post(unsigned* bar, volatile LAS unsigned* st, int tid_arg) {
    XcdBarrier b; b.bar = bar; b.x = xb_xcc_id(); b.st = st;
    if (tid_arg == 0) (void)xb_add(&bar[XB_XCNT(b.x)], 1u);
    return b;
}
__device__ __forceinline__ void xcd_barrier_complete(unsigned* bar, unsigned x, unsigned& nloc, unsigned& nx) {
    const unsigned G = gridDim.x * gridDim.y * gridDim.z;
    unsigned sum, cnt, mine, sp = 0u;
    for (;;) {
        sum = 0u; cnt = 0u; mine = 0u;
#pragma unroll
        for (unsigned j = 0; j < 16; ++j) { const unsigned c = xb_ld(&bar[XB_XCNT(j)]); sum += c; cnt += (c > 0u) ? 1u : 0u; mine = (j == x) ? c : mine; }
        if (sum == G) break;
        __builtin_amdgcn_s_sleep(1);
        if ((++sp & 255u) == 0u) { if (xb_ld(&bar[XB_TMO])) break; if (sp > XB_SPIN_CAP) { atomicAdd(&bar[XB_TMO], 1u); break; } }
    }
    nloc = mine > 0u ? mine : 1u; nx = cnt > 0u ? cnt : 1u;
}

__device__ __forceinline__ void xcd_barrier(const XcdBarrier& b, int tid_arg) {
    asm volatile("s_waitcnt vmcnt(0)" ::: "memory");
    __syncthreads();
    if (tid_arg == 0) {
        unsigned* bar = b.bar;
        __builtin_amdgcn_s_waitcnt(0);
        unsigned nloc = b.st[0], nx = b.st[1];
        if (nloc == 0u) { xcd_barrier_complete(bar, b.x, nloc, nx); b.st[0] = nloc; b.st[1] = nx; }
        const unsigned old = xb_add(&bar[XB_XSUB(b.x)], 1u);
        const unsigned gen = old / nloc;
        if (old + 1u == (gen + 1u) * nloc) {
            __builtin_amdgcn_fence(__ATOMIC_RELEASE, "agent");
            asm volatile("s_waitcnt vmcnt(0)" ::: "memory");
            const unsigned og = xb_add(&bar[XB_TOP], 1u);
            const unsigned tg = og / nx;
            if (og + 1u == (tg + 1u) * nx) xb_add(&bar[XB_TOPGEN], 1u);
            else XB_SPIN(xb_ld(&bar[XB_TOPGEN]) == tg, bar);
            __builtin_amdgcn_fence(__ATOMIC_ACQUIRE, "agent");
            xb_add(&bar[XB_XGEN(b.x)], 1u);
            asm volatile("s_waitcnt vmcnt(0)" ::: "memory");
        } else {
            XB_SPIN(xb_ld(&bar[XB_XGEN(b.x)]) == gen, bar);
            __builtin_amdgcn_fence(__ATOMIC_ACQUIRE, "agent");
            asm volatile("s_waitcnt vmcnt(0)" ::: "memory");
        }
    }
    __syncthreads();
}
constexpr int NWAVES = 8, NTHR = 512;
constexpr int MP = 16384, MS = 256, MT = MP + MS, DM = 1024, SEQ = 8192;
constexpr int AINW = 4112, CONVD = 3072, NPROJ = 4096;
constexpr int FF = 2816, NGU = 5632, NQKV = 1536;
constexpr int NITEM = 2048;
constexpr float ALPHA = 1.4142135623730951f;
constexpr size_t O_Y = 0, O_PCONV = (size_t)MT * DM, O_PDELTA = O_PCONV + 18432, O_PK = O_PDELTA + 262144, O_PV = O_PK + 4194304,
                 O_SCONV = O_PV + 4194304, O_SDELTA = O_SCONV + 294912, O_SK = O_SDELTA + 4194304, O_SV = O_SK + 65536, O_END = O_SV + 65536;
constexpr size_t MiB = 1u << 20;
constexpr size_t WS_CTL = 0, CTL_ZERO_BYTES = 1 * MiB;
constexpr size_t WS_WIN = 2 * MiB, WS_WOUT = 10 * MiB, WS_WGU0 = 12 * MiB, WS_WD0 = 23 * MiB, WS_WQKV = 29 * MiB, WS_WO = 32 * MiB, WS_WGU1 = 34 * MiB, WS_WD1 = 45 * MiB;
constexpr size_t WS_ROPE = 51 * MiB, WS_AB = 54 * MiB, WS_CMEANS = 56 * MiB, WS_PMEANS = 58 * MiB, WS_GLB = 59 * MiB;
constexpr size_t WS_XB = 64 * MiB, WS_PROJ = 100 * MiB, WS_DEL = 232 * MiB, WS_VN = 376 * MiB, WS_O = 408 * MiB, WS_OG = 474 * MiB, WS_MIX = 508 * MiB,
                 WS_H = 574 * MiB, WS_HB = 640 * MiB, WS_FF = 674 * MiB, WS_X1 = 764 * MiB, WS_X1B = 830 * MiB, WS_Q = 864 * MiB, WS_KB = 897 * MiB, WS_VB = 906 * MiB,
                 WS_VTP = 915 * MiB, WS_LIST = 924 * MiB, WS_OPART = 956 * MiB, WS_ML = 1052 * MiB, WS_SLIST = 1058 * MiB, WS_SPART = 1059 * MiB, WS_END = 1064 * MiB;
constexpr int DEL_ITEM = 73728, DEL_QP = 16384, DEL_KTP = 32768, DEL_QKP = 49152, DEL_U = 57344;
constexpr int CW_BAR = 4096, CW_PCNT = 16384  , CW_SCNT = 20480  ;
constexpr int LDS_BYTES = 147456, MISC_OFF = 147456 - 256;
typedef unsigned v2u __attribute__((ext_vector_type(2)));
typedef float f32x2 __attribute__((ext_vector_type(2)));
#define DI __device__ __forceinline__
#define LDS_BARRIER() do { asm volatile("s_waitcnt lgkmcnt(0)" ::: "memory"); __builtin_amdgcn_s_barrier(); asm volatile("" ::: "memory"); } while (0)
DI int lane_id() { int l; asm volatile("v_mbcnt_lo_u32_b32 %0, -1, 0\n\tv_mbcnt_hi_u32_b32 %0, -1, %0" : "=v"(l)); return l; }
DI float bflo(unsigned u) { return __uint_as_float(u << 16); }
DI float bfhi(unsigned u) { return __uint_as_float(u & 0xffff0000u); }
DI float bf2f(unsigned short u) { return __uint_as_float((unsigned)u << 16); }
DI float silu_f(float x) { return x * __builtin_amdgcn_rcpf(1.f + __expf(-x)); }
DI float sigmoid_f(float x) { return __builtin_amdgcn_rcpf(1.f + __expf(-x)); }
DI float rowsum16(float v) {
    v += __builtin_bit_cast(float, __builtin_amdgcn_update_dpp(0, __builtin_bit_cast(int, v), 0x128, 0xf, 0xf, false));
    v += __builtin_bit_cast(float, __builtin_amdgcn_update_dpp(0, __builtin_bit_cast(int, v), 0x124, 0xf, 0xf, false));
    v += __builtin_bit_cast(float, __builtin_amdgcn_update_dpp(0, __builtin_bit_cast(int, v), 0x122, 0xf, 0xf, false));
    v += __builtin_bit_cast(float, __builtin_amdgcn_update_dpp(0, __builtin_bit_cast(int, v), 0x121, 0xf, 0xf, false));
    return v; }
DI float wsum(float v) {
#pragma unroll
    for (int o = 1; o < 64; o <<= 1) v += __shfl_xor(v, o);
    return v;
}
DI f32x4 mfma16(bf16x8 a, bf16x8 b, f32x4 c) { return __builtin_amdgcn_mfma_f32_16x16x32_bf16(a, b, c, 0, 0, 0); }
DI bf16x8 pack8(const float* v) { v4u r; r.x = pk2(v[0], v[1]); r.y = pk2(v[2], v[3]); r.z = pk2(v[4], v[5]); r.w = pk2(v[6], v[7]); return __builtin_bit_cast(bf16x8, r); }
DI bf16x8 pack44(f32x4 a, f32x4 b) { v4u r; r.x = pk2(a[0], a[1]); r.y = pk2(a[2], a[3]); r.z = pk2(b[0], b[1]); r.w = pk2(b[2], b[3]); return __builtin_bit_cast(bf16x8, r); }

struct Ctx {
    LAS unsigned char* lds; int tid, lane, wave, G, vcu, rr;
    const float *x_prompt, *x_sample, *state_conv, *state_delta, *cache_k, *cache_v; const int* page_table;
    const float *ln_g, *ln_b, *a_w_in, *a_conv, *a_log, *a_dtb, *a_norm, *a_w_out, *kv_w_k, *kv_w_v, *b_w_q, *b_w_o, *w_gate, *w_up, *w_down;
    float* out; unsigned char* ws; gu32* ctl;
};
#define WSP(T, off) ((T*)(C.ws + (off)))

DI void tr_item(const float* Wsrc, int ldsrc, int col, int k0, bf16* WT, int Kd, int rowdst0, LAS float* scr, int lane) {
    float tv[32];
#pragma unroll
    for (int i = 0; i < 32; ++i) tv[i] = Wsrc[(size_t)(k0 + 2 * i + (lane >> 5)) * ldsrc + col];
#pragma unroll
    for (int i = 0; i < 32; ++i) scr[(2 * i + (lane >> 5)) * 33 + (lane & 31)] = tv[i];
    LDS_WAIT(); asm volatile("" ::: "memory");
    const int c = lane & 7;
#pragma unroll
    for (int j = 0; j < 4; ++j) { const int n = (lane >> 3) + 8 * j; const LAS float* s = scr + (8 * c) * 33 + n;
        v4u o; o.x = pk2(s[0 * 33], s[1 * 33]); o.y = pk2(s[2 * 33], s[3 * 33]); o.z = pk2(s[4 * 33], s[5 * 33]); o.w = pk2(s[6 * 33], s[7 * 33]);
        *(GAS v4u*)(WT + (size_t)(rowdst0 + n) * Kd + k0 + 8 * c) = o; }
    LDS_WAIT(); asm volatile("" ::: "memory");
}
DI int rope_dmap(int cc) { return 4 * (cc >> 3) + (cc & 3) + 32 * ((cc >> 2) & 1); }

DI void p0_weights(const Ctx& C, int it_lo, int it_hi, int gw, int NGW) {
    LAS float* scr = (LAS float*)(C.lds + C.wave * 16384);
    const int lane = C.lane, nl = lane & 31;
    constexpr int I_IN = 16 * 128, I_SQ = 16 * 32, I_GU = 16 * 176, I_DN = 44 * 32, I_QKV = 16 * 48;
    constexpr int NIT = I_IN + I_SQ + I_GU + I_DN + I_QKV + I_SQ + I_GU + I_DN;
    if (it_hi > NIT) it_hi = NIT;
    for (int it = it_lo + gw; it < it_hi; it += NGW) {
        int r = it;
        if (r < I_IN) { const int kb = r / 128, nb = r % 128; tr_item(C.a_w_in, AINW, nb * 32 + nl, kb * 64, WSP(bf16, WS_WIN), DM, nb * 32, scr, lane); continue; } r -= I_IN;
        if (r < I_SQ) { const int kb = r / 32, nb = r % 32; tr_item(C.a_w_out, DM, nb * 32 + nl, kb * 64, WSP(bf16, WS_WOUT), DM, nb * 32, scr, lane); continue; } r -= I_SQ;
        if (r < I_GU) { const int kb = r / 176, nb = r % 176, n0 = nb * 32, tile = n0 >> 8, w = n0 & 255;
            tr_item(w < 128 ? C.w_gate : C.w_up, FF, tile * 128 + (w & 127) + nl, kb * 64, WSP(bf16, WS_WGU0), DM, n0, scr, lane); continue; } r -= I_GU;
        if (r < I_DN) { const int kb = r / 32, nb = r % 32; tr_item(C.w_down, DM, nb * 32 + nl, kb * 64, WSP(bf16, WS_WD0), FF, nb * 32, scr, lane); continue; } r -= I_DN;
        if (r < I_QKV) { const int kb = r / 48, nb = r % 48, n0 = nb * 32; const float* src; int ld, col;
            if (n0 < 1024) { src = C.b_w_q; ld = 1024; col = (n0 & ~63) + rope_dmap((n0 & 63) + nl); }
            else if (n0 < 1280) { src = C.kv_w_k; ld = 256; col = ((n0 - 1024) & ~63) + rope_dmap((n0 & 63) + nl); }
            else { src = C.kv_w_v; ld = 256; col = n0 - 1280 + nl; }
            tr_item(src, ld, col, kb * 64, WSP(bf16, WS_WQKV), DM, n0, scr, lane); continue; } r -= I_QKV;
        if (r < I_SQ) { const int kb = r / 32, nb = r % 32; tr_item(C.b_w_o, DM, nb * 32 + nl, kb * 64, WSP(bf16, WS_WO), DM, nb * 32, scr, lane); continue; } r -= I_SQ;
        if (r < I_GU) { const int kb = r / 176, nb = r % 176, n0 = nb * 32, tile = n0 >> 8, w = n0 & 255;
            tr_item((w < 128 ? C.w_gate : C.w_up) + (size_t)DM * FF, FF, tile * 128 + (w & 127) + nl, kb * 64, WSP(bf16, WS_WGU1), DM, n0, scr, lane); continue; } r -= I_GU;
        { const int kb = r / 32, nb = r % 32; tr_item(C.w_down + (size_t)FF * DM, DM, nb * 32 + nl, kb * 64, WSP(bf16, WS_WD1), FF, nb * 32, scr, lane); }
    }
}
DI void p0_rope(const Ctx& C, int gt, int NGT) {
    f32x2* tab = WSP(f32x2, WS_ROPE);
    for (int idx = gt; idx < 8200 * 32; idx += NGT) {
        const int pi = idx >> 5, f = idx & 31; const double pos = (double)(pi < 8192 ? pi : 16384 + (pi - 8192));
        double inv = 1.0; const double r = 0.74989420933245582730;
        for (int i = 0; i < 31; ++i) inv = (i < f) ? inv * r : inv;
        const double ang = pos * inv;
        const double n = __builtin_rint(ang * 0.63661977236758134308);
        double x = __builtin_fma(-n, 1.5707963267948965580, ang); x = __builtin_fma(-n, 6.1232339957367660e-17, x);
        const double x2 = x * x;
        double s = -1.0 / 1307674368000.0; s = s * x2 + 1.0 / 6227020800.0; s = s * x2 - 1.0 / 39916800.0; s = s * x2 + 1.0 / 362880.0; s = s * x2 - 1.0 / 5040.0; s = s * x2 + 1.0 / 120.0; s = s * x2 - 1.0 / 6.0; s = s * x2 * x + x;
        double c = 1.0 / 20922789888000.0; c = c * x2 - 1.0 / 87178291200.0; c = c * x2 + 1.0 / 479001600.0; c = c * x2 - 1.0 / 3628800.0; c = c * x2 + 1.0 / 40320.0; c = c * x2 - 1.0 / 720.0; c = c * x2 + 1.0 / 24.0; c = c * x2 - 0.5; c = c * x2 + 1.0;
        const int q = ((int)n) & 3;
        const double cs = (q == 0) ? c : (q == 1) ? -s : (q == 2) ? -c : s, sn = (q == 0) ? s : (q == 1) ? c : (q == 2) ? -s : -c;
        tab[idx] = (f32x2){(float)cs, (float)sn};
    }
}
DI void p0_x(const Ctx& C) {
    LAS float* wab = (LAS float*)C.lds;
    for (int idx = C.tid; idx < 16384; idx += NTHR) { const int k = idx >> 4, c = idx & 15; wab[c * 1024 + k] = C.a_w_in[(size_t)k * AINW + NPROJ + c]; }
    __syncthreads();
    const int gw = C.vcu * NWAVES + C.wave, NGW = C.G * NWAVES, sub = C.lane & 15, rr = C.lane >> 4;
    bf16* XB = WSP(bf16, WS_XB); float* AB = WSP(float, WS_AB);
    for (int task = gw; task < MT / 4; task += NGW) {
        const int row = task * 4 + rr; const float* xr = row < MP ? C.x_prompt + (size_t)row * DM : C.x_sample + (size_t)(row - MP) * DM;
        float acc[16];
#pragma unroll
        for (int c = 0; c < 16; ++c) acc[c] = 0.f;
#pragma unroll 4
        for (int i = 0; i < 16; ++i) { const int k = 64 * i + 4 * sub; const f32x4 xv = *(const GAS f32x4*)(xr + k);
            v2u o; o.x = pk2(xv[0], xv[1]); o.y = pk2(xv[2], xv[3]); *(GAS v2u*)(XB + (size_t)row * DM + k) = o;
#pragma unroll
            for (int c = 0; c < 16; ++c) { const f32x4 w = *(const LAS f32x4*)(wab + c * 1024 + k); acc[c] += (xv[0] * w[0] + xv[1] * w[1]) + (xv[2] * w[2] + xv[3] * w[3]); } }
#pragma unroll
        for (int c = 0; c < 16; ++c) { float v = acc[c]; v += __shfl_xor(v, 1); v += __shfl_xor(v, 2); v += __shfl_xor(v, 4); v += __shfl_xor(v, 8); acc[c] = v; }
        if (sub == 0) {
#pragma unroll
            for (int c = 0; c < 4; ++c) *(GAS f32x4*)(AB + (size_t)row * 16 + 4 * c) = (f32x4){acc[4 * c], acc[4 * c + 1], acc[4 * c + 2], acc[4 * c + 3]}; }
    }
}
DI void p0_cmeans(const Ctx& C, int gw, int NGW) {
    float* cm = WSP(float, WS_CMEANS);
    for (int it = gw; it < 32 * 64; it += NGW) { const int seq = it >> 6, blk = it & 63; f32x4 a0 = {0, 0, 0, 0}, a1 = a0, a2 = a0, a3 = a0;
#pragma unroll
        for (int pg = 0; pg < 2; ++pg) { const int page = C.page_table[seq * 128 + 2 * blk + pg]; const GAS f32x4* base = (const GAS f32x4*)(C.cache_k + (size_t)page * 32768) + C.lane;
#pragma unroll 1
            for (int t = 0; t < 128; t += 16) { f32x4 v[16];
#pragma unroll
                for (int q = 0; q < 16; ++q) v[q] = __builtin_nontemporal_load(base + (t + q) * 64);
#pragma unroll
                for (int q = 0; q < 16; q += 4) { a0 += v[q]; a1 += v[q + 1]; a2 += v[q + 2]; a3 += v[q + 3]; } } }
        const f32x4 m = ((a0 + a1) + (a2 + a3)) * (1.f / 256.f);
        *(GAS f32x4*)(cm + (size_t)it * 256 + 4 * C.lane) = m; }
}
struct EpiF32 {
    static constexpr bool PERM = false, AFTER_DRAIN = false; float* O; int ldc;
    DI void operator()(const f32x4 (&acc)[2][2][4][2], const pg8::Unit& u, int wr, int wc, int fr, int fq) const {
        const int row0 = u.pm * 256 + wr * 64 + fr, col0 = u.pn * 256 + wc * 32 + 4 * fq;
#pragma unroll
        for (int ai = 0; ai < 2; ++ai)
#pragma unroll
            for (int m = 0; m < 4; ++m) { float* rp = O + (size_t)(row0 + ai * 128 + m * 16) * ldc + col0;
#pragma unroll
                for (int bj = 0; bj < 2; ++bj)
#pragma unroll
                    for (int n = 0; n < 2; ++n) *(GAS f32x4*)(rp + bj * 128 + n * 16) = acc[ai][bj][m][n]; }
    }
};
struct EpiSwiglu {
    static constexpr bool PERM = true, AFTER_DRAIN = false; bf16* O;
    DI void operator()(const f32x4 (&acc)[2][2][4][2], const pg8::Unit& u, int wr, int wc, int fr, int fq) const {
        const int row0 = u.pm * 256 + wr * 64 + fr, col0 = u.pn * 128 + wc * 32 + 8 * fq;
#pragma unroll
        for (int ai = 0; ai < 2; ++ai)
#pragma unroll
            for (int m = 0; m < 4; ++m) { bf16* rp = O + (size_t)(row0 + ai * 128 + m * 16) * FF + col0; float v[8];
#pragma unroll
                for (int n = 0; n < 2; ++n)
#pragma unroll
                    for (int e = 0; e < 4; ++e) { const float g = acc[ai][0][m][n][e], uu = acc[ai][1][m][n][e]; v[4 * n + e] = silu_f(g) * uu; }
                *(GAS bf16x8*)rp = pack8(v); }
    }
};
struct EpiQkvRope {
    static constexpr bool PERM = true, AFTER_DRAIN = false; bf16 *Q, *KB, *VB; float* out; const f32x2* tab;
    DI void operator()(const f32x4 (&acc)[2][2][4][2], const pg8::Unit& u, int wr, int wc, int fr, int fq) const {
        const int row0 = u.pm * 256 + wr * 64 + fr;
#pragma unroll
        for (int ai = 0; ai < 2; ++ai)
#pragma unroll
            for (int m = 0; m < 4; ++m) { const int row = row0 + ai * 128 + m * 16;
                if (u.pn < 5) {
                    const int pi = row < MP ? (row & 8191) : 8192 + (row & 7), q8 = 4 * (wc & 1) + fq;
                    const f32x4 t0 = *(const GAS f32x4*)(tab + pi * 32 + 4 * q8), t1 = *(const GAS f32x4*)(tab + pi * 32 + 4 * q8 + 2);
                    const float cs[4] = {t0[0], t0[2], t1[0], t1[2]}, sn[4] = {t0[1], t0[3], t1[1], t1[3]};
#pragma unroll
                    for (int bj = 0; bj < 2; ++bj) { const f32x4 x1 = acc[ai][bj][m][0], x2 = acc[ai][bj][m][1]; float o1[4], o2[4];
#pragma unroll
                        for (int e = 0; e < 4; ++e) { o1[e] = x1[e] * cs[e] - x2[e] * sn[e]; o2[e] = x2[e] * cs[e] + x1[e] * sn[e]; }
                        const int hl = 2 * bj + (wc >> 1);
                        v2u w1, w2; w1.x = pk2(o1[0], o1[1]); w1.y = pk2(o1[2], o1[3]); w2.x = pk2(o2[0], o2[1]); w2.y = pk2(o2[2], o2[3]);
                        if (u.pn < 4) { bf16* p = Q + (size_t)row * DM + (4 * u.pn + hl) * 64 + 4 * q8; *(GAS v2u*)p = w1; *(GAS v2u*)(p + 32) = w2; }
                        else { bf16* p = KB + (size_t)row * 256 + hl * 64 + 4 * q8; *(GAS v2u*)p = w1; *(GAS v2u*)(p + 32) = w2;
                            float* f = (row < MP ? out + O_PK + (size_t)row * 256 : out + O_SK + (size_t)(row - MP) * 256) + hl * 64 + 4 * q8;
                            *(GAS f32x4*)f = (f32x4){o1[0], o1[1], o1[2], o1[3]}; *(GAS f32x4*)(f + 32) = (f32x4){o2[0], o2[1], o2[2], o2[3]}; } }
                } else {
#pragma unroll
                    for (int bj = 0; bj < 2; ++bj) { const int col = bj * 128 + wc * 32 + 8 * fq; const f32x4 a = acc[ai][bj][m][0], b = acc[ai][bj][m][1];
                        *(GAS bf16x8*)(VB + (size_t)row * 256 + col) = pack44(a, b);
                        float* f = (row < MP ? out + O_PV + (size_t)row * 256 : out + O_SV + (size_t)(row - MP) * 256) + col;
                        *(GAS f32x4*)f = a; *(GAS f32x4*)(f + 4) = b; }
                }
            }
    }
};
DI void conv_state_out(const Ctx& C) {
    const bf16* PROJ = WSP(bf16, WS_PROJ);
    for (int idx = C.vcu * NTHR + C.tid; idx < (2 + 32) * 3 * CONVD; idx += C.G * NTHR) {
        const int col = idx % CONVD, r = (idx / CONVD) % 3, s = idx / (3 * CONVD);
        const int row = s < 2 ? s * SEQ + SEQ - 3 + r : MP + (s - 2) * 8 + 5 + r;
        const float v = bf2f(PROJ[(size_t)row * NPROJ + col]);
        if (s < 2) C.out[O_PCONV + (size_t)idx] = v; else C.out[O_SCONV + (size_t)(idx - 2 * 3 * CONVD)] = v; }
}
constexpr int PAIR_BYTES = 16384 + 17408 + 2048;
DI float shx(float v, int m, int lane) { return __int_as_float(__builtin_amdgcn_ds_bpermute((lane ^ m) << 2, __float_as_int(v))); }
DI float shfrom(float v, int src) { return __int_as_float(__builtin_amdgcn_ds_bpermute(src << 2, __float_as_int(v))); }
DI float softplus_f(float x) { return fmaxf(x, 0.f) + log1pf(__expf(-fabsf(x))); }

#define TS_LD(slot, i, m4) tb##slot = *(const LAS f32x4*)(AM + (i) * 64 + 4 * (m4)); asm volatile("" ::: "memory");
#define TS_F(slot, i, m, e) x[i] -= x[m] * tb##slot[e];
template <int NROW> DI void tri_solve(f32x2 (&x)[64], const LAS float* AM) {
    f32x4 tb0, tb1, tb2, tb3, tb4, tb5, tb6, tb7;
    TS_LD(0, 1, 0)
    TS_LD(1, 2, 0)
    TS_LD(2, 3, 0)
    TS_LD(3, 4, 0)
    TS_LD(4, 5, 0)
    TS_LD(5, 5, 1)
    TS_LD(6, 6, 0)
    TS_LD(7, 6, 1)
    { const f32x4 ta = tb0; TS_LD(0, 7, 0) x[1] -= x[0] * ta[0]; }
    { const f32x4 ta = tb1; TS_LD(1, 7, 1) x[2] -= x[0] * ta[0]; x[2] -= x[1] * ta[1]; }
    { const f32x4 ta = tb2; TS_LD(2, 8, 0) x[3] -= x[0] * ta[0]; x[3] -= x[1] * ta[1]; x[3] -= x[2] * ta[2]; }
    { const f32x4 ta = tb3; TS_LD(3, 8, 1) x[4] -= x[0] * ta[0]; x[4] -= x[1] * ta[1]; x[4] -= x[2] * ta[2]; x[4] -= x[3] * ta[3]; }
    { const f32x4 ta = tb4; TS_LD(4, 9, 0) x[5] -= x[0] * ta[0]; x[5] -= x[1] * ta[1]; x[5] -= x[2] * ta[2]; x[5] -= x[3] * ta[3]; }
    { const f32x4 ta = tb5; TS_LD(5, 9, 1) x[5] -= x[4] * ta[0]; }
    { const f32x4 ta = tb6; TS_LD(6, 9, 2) x[6] -= x[0] * ta[0]; x[6] -= x[1] * ta[1]; x[6] -= x[2] * ta[2]; x[6] -= x[3] * ta[3]; }
    { const f32x4 ta = tb7; TS_LD(7, 10, 0) x[6] -= x[4] * ta[0]; x[6] -= x[5] * ta[1]; }
    { const f32x4 ta = tb0; TS_LD(0, 10, 1) x[7] -= x[0] * ta[0]; x[7] -= x[1] * ta[1]; x[7] -= x[2] * ta[2]; x[7] -= x[3] * ta[3]; }
    { const f32x4 ta = tb1; TS_LD(1, 10, 2) x[7] -= x[4] * ta[0]; x[7] -= x[5] * ta[1]; x[7] -= x[6] * ta[2]; }
    { const f32x4 ta = tb2; TS_LD(2, 11, 0) x[8] -= x[0] * ta[0]; x[8] -= x[1] * ta[1]; x[8] -= x[2] * ta[2]; x[8] -= x[3] * ta[3]; }
    { const f32x4 ta = tb3; TS_LD(3, 11, 1) x[8] -= x[4] * ta[0]; x[8] -= x[5] * ta[1]; x[8] -= x[6] * ta[2]; x[8] -= x[7] * ta[3]; }
    { const f32x4 ta = tb4; TS_LD(4, 11, 2) x[9] -= x[0] * ta[0]; x[9] -= x[1] * ta[1]; x[9] -= x[2] * ta[2]; x[9] -= x[3] * ta[3]; }
    { const f32x4 ta = tb5; TS_LD(5, 12, 0) x[9] -= x[4] * ta[0]; x[9] -= x[5] * ta[1]; x[9] -= x[6] * ta[2]; x[9] -= x[7] * ta[3]; }
    { const f32x4 ta = tb6; TS_LD(6, 12, 1) x[9] -= x[8] * ta[0]; }
    { const f32x4 ta = tb7; TS_LD(7, 12, 2) x[10] -= x[0] * ta[0]; x[10] -= x[1] * ta[1]; x[10] -= x[2] * ta[2]; x[10] -= x[3] * ta[3]; }
    { const f32x4 ta = tb0; TS_LD(0, 13, 0) x[10] -= x[4] * ta[0]; x[10] -= x[5] * ta[1]; x[10] -= x[6] * ta[2]; x[10] -= x[7] * ta[3]; }
    { const f32x4 ta = tb1; TS_LD(1, 13, 1) x[10] -= x[8] * ta[0]; x[10] -= x[9] * ta[1]; }
    { const f32x4 ta = tb2; TS_LD(2, 13, 2) x[11] -= x[0] * ta[0]; x[11] -= x[1] * ta[1]; x[11] -= x[2] * ta[2]; x[11] -= x[3] * ta[3]; }
    { const f32x4 ta = tb3; TS_LD(3, 13, 3) x[11] -= x[4] * ta[0]; x[11] -= x[5] * ta[1]; x[11] -= x[6] * ta[2]; x[11] -= x[7] * ta[3]; }
    { const f32x4 ta = tb4; TS_LD(4, 14, 0) x[11] -= x[8] * ta[0]; x[11] -= x[9] * ta[1]; x[11] -= x[10] * ta[2]; }
    { const f32x4 ta = tb5; TS_LD(5, 14, 1) x[12] -= x[0] * ta[0]; x[12] -= x[1] * ta[1]; x[12] -= x[2] * ta[2]; x[12] -= x[3] * ta[3]; }
    { const f32x4 ta = tb6; TS_LD(6, 14, 2) x[12] -= x[4] * ta[0]; x[12] -= x[5] * ta[1]; x[12] -= x[6] * ta[2]; x[12] -= x[7] * ta[3]; }
    { const f32x4 ta = tb7; TS_LD(7, 14, 3) x[12] -= x[8] * ta[0]; x[12] -= x[9] * ta[1]; x[12] -= x[10] * ta[2]; x[12] -= x[11] * ta[3]; }
    { const f32x4 ta = tb0; TS_LD(0, 15, 0) x[13] -= x[0] * ta[0]; x[13] -= x[1] * ta[1]; x[13] -= x[2] * ta[2]; x[13] -= x[3] * ta[3]; }
    { const f32x4 ta = tb1; TS_LD(1, 15, 1) x[13] -= x[4] * ta[0]; x[13] -= x[5] * ta[1]; x[13] -= x[6] * ta[2]; x[13] -= x[7] * ta[3]; }
    { const f32x4 ta = tb2; TS_LD(2, 15, 2) x[13] -= x[8] * ta[0]; x[13] -= x[9] * ta[1]; x[13] -= x[10] * ta[2]; x[13] -= x[11] * ta[3]; }
    { const f32x4 ta = tb3; TS_LD(3, 15, 3) x[13] -= x[12] * ta[0]; }
    { const f32x4 ta = tb4; TS_LD(4, 16, 0) x[14] -= x[0] * ta[0]; x[14] -= x[1] * ta[1]; x[14] -= x[2] * ta[2]; x[14] -= x[3] * ta[3]; }
    { const f32x4 ta = tb5; TS_LD(5, 16, 1) x[14] -= x[4] * ta[0]; x[14] -= x[5] * ta[1]; x[14] -= x[6] * ta[2]; x[14] -= x[7] * ta[3]; }
    { const f32x4 ta = tb6; TS_LD(6, 16, 2) x[14] -= x[8] * ta[0]; x[14] -= x[9] * ta[1]; x[14] -= x[10] * ta[2]; x[14] -= x[11] * ta[3]; }
    { const f32x4 ta = tb7; TS_LD(7, 16, 3) x[14] -= x[12] * ta[0]; x[14] -= x[13] * ta[1]; }
    { const f32x4 ta = tb0; TS_LD(0, 17, 0) x[15] -= x[0] * ta[0]; x[15] -= x[1] * ta[1]; x[15] -= x[2] * ta[2]; x[15] -= x[3] * ta[3]; }
    { const f32x4 ta = tb1; TS_LD(1, 17, 1) x[15] -= x[4] * ta[0]; x[15] -= x[5] * ta[1]; x[15] -= x[6] * ta[2]; x[15] -= x[7] * ta[3]; }
    { const f32x4 ta = tb2; TS_LD(2, 17, 2) x[15] -= x[8] * ta[0]; x[15] -= x[9] * ta[1]; x[15] -= x[10] * ta[2]; x[15] -= x[11] * ta[3]; }
    { const f32x4 ta = tb3; TS_LD(3, 17, 3) x[15] -= x[12] * ta[0]; x[15] -= x[13] * ta[1]; x[15] -= x[14] * ta[2]; }
    { const f32x4 ta = tb4; TS_LD(4, 17, 4) x[16] -= x[0] * ta[0]; x[16] -= x[1] * ta[1]; x[16] -= x[2] * ta[2]; x[16] -= x[3] * ta[3]; }
    { const f32x4 ta = tb5; TS_LD(5, 18, 0) x[16] -= x[4] * ta[0]; x[16] -= x[5] * ta[1]; x[16] -= x[6] * ta[2]; x[16] -= x[7] * ta[3]; }
    { const f32x4 ta = tb6; TS_LD(6, 18, 1) x[16] -= x[8] * ta[0]; x[16] -= x[9] * ta[1]; x[16] -= x[10] * ta[2]; x[16] -= x[11] * ta[3]; }
    { const f32x4 ta = tb7; TS_LD(7, 18, 2) x[16] -= x[12] * ta[0]; x[16] -= x[13] * ta[1]; x[16] -= x[14] * ta[2]; x[16] -= x[15] * ta[3]; }
    { const f32x4 ta = tb0; TS_LD(0, 18, 3) x[17] -= x[0] * ta[0]; x[17] -= x[1] * ta[1]; x[17] -= x[2] * ta[2]; x[17] -= x[3] * ta[3]; }
    { const f32x4 ta = tb1; TS_LD(1, 18, 4) x[17] -= x[4] * ta[0]; x[17] -= x[5] * ta[1]; x[17] -= x[6] * ta[2]; x[17] -= x[7] * ta[3]; }
    { const f32x4 ta = tb2; TS_LD(2, 19, 0) x[17] -= x[8] * ta[0]; x[17] -= x[9] * ta[1]; x[17] -= x[10] * ta[2]; x[17] -= x[11] * ta[3]; }
    { const f32x4 ta = tb3; TS_LD(3, 19, 1) x[17] -= x[12] * ta[0]; x[17] -= x[13] * ta[1]; x[17] -= x[14] * ta[2]; x[17] -= x[15] * ta[3]; }
    { const f32x4 ta = tb4; TS_LD(4, 19, 2) x[17] -= x[16] * ta[0]; }
    { const f32x4 ta = tb5; TS_LD(5, 19, 3) x[18] -= x[0] * ta[0]; x[18] -= x[1] * ta[1]; x[18] -= x[2] * ta[2]; x[18] -= x[3] * ta[3]; }
    { const f32x4 ta = tb6; TS_LD(6, 19, 4) x[18] -= x[4] * ta[0]; x[18] -= x[5] * ta[1]; x[18] -= x[6] * ta[2]; x[18] -= x[7] * ta[3]; }
    { const f32x4 ta = tb7; TS_LD(7, 20, 0) x[18] -= x[8] * ta[0]; x[18] -= x[9] * ta[1]; x[18] -= x[10] * ta[2]; x[18] -= x[11] * ta[3]; }
    { const f32x4 ta = tb0; TS_LD(0, 20, 1) x[18] -= x[12] * ta[0]; x[18] -= x[13] * ta[1]; x[18] -= x[14] * ta[2]; x[18] -= x[15] * ta[3]; }
    { const f32x4 ta = tb1; TS_LD(1, 20, 2) x[18] -= x[16] * ta[0]; x[18] -= x[17] * ta[1]; }
    { const f32x4 ta = tb2; TS_LD(2, 20, 3) x[19] -= x[0] * ta[0]; x[19] -= x[1] * ta[1]; x[19] -= x[2] * ta[2]; x[19] -= x[3] * ta[3]; }
    { const f32x4 ta = tb3; TS_LD(3, 20, 4) x[19] -= x[4] * ta[0]; x[19] -= x[5] * ta[1]; x[19] -= x[6] * ta[2]; x[19] -= x[7] * ta[3]; }
    { const f32x4 ta = tb4; TS_LD(4, 21, 0) x[19] -= x[8] * ta[0]; x[19] -= x[9] * ta[1]; x[19] -= x[10] * ta[2]; x[19] -= x[11] * ta[3]; }
    { const f32x4 ta = tb5; TS_LD(5, 21, 1) x[19] -= x[12] * ta[0]; x[19] -= x[13] * ta[1]; x[19] -= x[14] * ta[2]; x[19] -= x[15] * ta[3]; }
    { const f32x4 ta = tb6; TS_LD(6, 21, 2) x[19] -= x[16] * ta[0]; x[19] -= x[17] * ta[1]; x[19] -= x[18] * ta[2]; }
    { const f32x4 ta = tb7; TS_LD(7, 21, 3) x[20] -= x[0] * ta[0]; x[20] -= x[1] * ta[1]; x[20] -= x[2] * ta[2]; x[20] -= x[3] * ta[3]; }
    { const f32x4 ta = tb0; TS_LD(0, 21, 4) x[20] -= x[4] * ta[0]; x[20] -= x[5] * ta[1]; x[20] -= x[6] * ta[2]; x[20] -= x[7] * ta[3]; }
    { const f32x4 ta = tb1; TS_LD(1, 21, 5) x[20] -= x[8] * ta[0]; x[20] -= x[9] * ta[1]; x[20] -= x[10] * ta[2]; x[20] -= x[11] * ta[3]; }
    { const f32x4 ta = tb2; TS_LD(2, 22, 0) x[20] -= x[12] * ta[0]; x[20] -= x[13] * ta[1]; x[20] -= x[14] * ta[2]; x[20] -= x[15] * ta[3]; }
    { const f32x4 ta = tb3; TS_LD(3, 22, 1) x[20] -= x[16] * ta[0]; x[20] -= x[17] * ta[1]; x[20] -= x[18] * ta[2]; x[20] -= x[19] * ta[3]; }
    { const f32x4 ta = tb4; TS_LD(4, 22, 2) x[21] -= x[0] * ta[0]; x[21] -= x[1] * ta[1]; x[21] -= x[2] * ta[2]; x[21] -= x[3] * ta[3]; }
    { const f32x4 ta = tb5; TS_LD(5, 22, 3) x[21] -= x[4] * ta[0]; x[21] -= x[5] * ta[1]; x[21] -= x[6] * ta[2]; x[21] -= x[7] * ta[3]; }
    { const f32x4 ta = tb6; TS_LD(6, 22, 4) x[21] -= x[8] * ta[0]; x[21] -= x[9] * ta[1]; x[21] -= x[10] * ta[2]; x[21] -= x[11] * ta[3]; }
    { const f32x4 ta = tb7; TS_LD(7, 22, 5) x[21] -= x[12] * ta[0]; x[21] -= x[13] * ta[1]; x[21] -= x[14] * ta[2]; x[21] -= x[15] * ta[3]; }
    { const f32x4 ta = tb0; TS_LD(0, 23, 0) x[21] -= x[16] * ta[0]; x[21] -= x[17] * ta[1]; x[21] -= x[18] * ta[2]; x[21] -= x[19] * ta[3]; }
    { const f32x4 ta = tb1; TS_LD(1, 23, 1) x[21] -= x[20] * ta[0]; }
    { const f32x4 ta = tb2; TS_LD(2, 23, 2) x[22] -= x[0] * ta[0]; x[22] -= x[1] * ta[1]; x[22] -= x[2] * ta[2]; x[22] -= x[3] * ta[3]; }
    { const f32x4 ta = tb3; TS_LD(3, 23, 3) x[22] -= x[4] * ta[0]; x[22] -= x[5] * ta[1]; x[22] -= x[6] * ta[2]; x[22] -= x[7] * ta[3]; }
    { const f32x4 ta = tb4; TS_LD(4, 23, 4) x[22] -= x[8] * ta[0]; x[22] -= x[9] * ta[1]; x[22] -= x[10] * ta[2]; x[22] -= x[11] * ta[3]; }
    { const f32x4 ta = tb5; TS_LD(5, 23, 5) x[22] -= x[12] * ta[0]; x[22] -= x[13] * ta[1]; x[22] -= x[14] * ta[2]; x[22] -= x[15] * ta[3]; }
    { const f32x4 ta = tb6; TS_LD(6, 24, 0) x[22] -= x[16] * ta[0]; x[22] -= x[17] * ta[1]; x[22] -= x[18] * ta[2]; x[22] -= x[19] * ta[3]; }
    { const f32x4 ta = tb7; TS_LD(7, 24, 1) x[22] -= x[20] * ta[0]; x[22] -= x[21] * ta[1]; }
    { const f32x4 ta = tb0; TS_LD(0, 24, 2) x[23] -= x[0] * ta[0]; x[23] -= x[1] * ta[1]; x[23] -= x[2] * ta[2]; x[23] -= x[3] * ta[3]; }
    { const f32x4 ta = tb1; TS_LD(1, 24, 3) x[23] -= x[4] * ta[0]; x[23] -= x[5] * ta[1]; x[23] -= x[6] * ta[2]; x[23] -= x[7] * ta[3]; }
    { const f32x4 ta = tb2; TS_LD(2, 24, 4) x[23] -= x[8] * ta[0]; x[23] -= x[9] * ta[1]; x[23] -= x[10] * ta[2]; x[23] -= x[11] * ta[3]; }
    { const f32x4 ta = tb3; TS_LD(3, 24, 5) x[23] -= x[12] * ta[0]; x[23] -= x[13] * ta[1]; x[23] -= x[14] * ta[2]; x[23] -= x[15] * ta[3]; }
    { const f32x4 ta = tb4; TS_LD(4, 25, 0) x[23] -= x[16] * ta[0]; x[23] -= x[17] * ta[1]; x[23] -= x[18] * ta[2]; x[23] -= x[19] * ta[3]; }
    { const f32x4 ta = tb5; TS_LD(5, 25, 1) x[23] -= x[20] * ta[0]; x[23] -= x[21] * ta[1]; x[23] -= x[22] * ta[2]; }
    { const f32x4 ta = tb6; TS_LD(6, 25, 2) x[24] -= x[0] * ta[0]; x[24] -= x[1] * ta[1]; x[24] -= x[2] * ta[2]; x[24] -= x[3] * ta[3]; }
    { const f32x4 ta = tb7; TS_LD(7, 25, 3) x[24] -= x[4] * ta[0]; x[24] -= x[5] * ta[1]; x[24] -= x[6] * ta[2]; x[24] -= x[7] * ta[3]; }
    { const f32x4 ta = tb0; TS_LD(0, 25, 4) x[24] -= x[8] * ta[0]; x[24] -= x[9] * ta[1]; x[24] -= x[10] * ta[2]; x[24] -= x[11] * ta[3]; }
    { const f32x4 ta = tb1; TS_LD(1, 25, 5) x[24] -= x[12] * ta[0]; x[24] -= x[13] * ta[1]; x[24] -= x[14] * ta[2]; x[24] -= x[15] * ta[3]; }
    { const f32x4 ta = tb2; TS_LD(2, 25, 6) x[24] -= x[16] * ta[0]; x[24] -= x[17] * ta[1]; x[24] -= x[18] * ta[2]; x[24] -= x[19] * ta[3]; }
    { const f32x4 ta = tb3; TS_LD(3, 26, 0) x[24] -= x[20] * ta[0]; x[24] -= x[21] * ta[1]; x[24] -= x[22] * ta[2]; x[24] -= x[23] * ta[3]; }
    { const f32x4 ta = tb4; TS_LD(4, 26, 1) x[25] -= x[0] * ta[0]; x[25] -= x[1] * ta[1]; x[25] -= x[2] * ta[2]; x[25] -= x[3] * ta[3]; }
    { const f32x4 ta = tb5; TS_LD(5, 26, 2) x[25] -= x[4] * ta[0]; x[25] -= x[5] * ta[1]; x[25] -= x[6] * ta[2]; x[25] -= x[7] * ta[3]; }
    { const f32x4 ta = tb6; TS_LD(6, 26, 3) x[25] -= x[8] * ta[0]; x[25] -= x[9] * ta[1]; x[25] -= x[10] * ta[2]; x[25] -= x[11] * ta[3]; }
    { const f32x4 ta = tb7; TS_LD(7, 26, 4) x[25] -= x[12] * ta[0]; x[25] -= x[13] * ta[1]; x[25] -= x[14] * ta[2]; x[25] -= x[15] * ta[3]; }
    { const f32x4 ta = tb0; TS_LD(0, 26, 5) x[25] -= x[16] * ta[0]; x[25] -= x[17] * ta[1]; x[25] -= x[18] * ta[2]; x[25] -= x[19] * ta[3]; }
    { const f32x4 ta = tb1; TS_LD(1, 26, 6) x[25] -= x[20] * ta[0]; x[25] -= x[21] * ta[1]; x[25] -= x[22] * ta[2]; x[25] -= x[23] * ta[3]; }
    { const f32x4 ta = tb2; TS_LD(2, 27, 0) x[25] -= x[24] * ta[0]; }
    { const f32x4 ta = tb3; TS_LD(3, 27, 1) x[26] -= x[0] * ta[0]; x[26] -= x[1] * ta[1]; x[26] -= x[2] * ta[2]; x[26] -= x[3] * ta[3]; }
    { const f32x4 ta = tb4; TS_LD(4, 27, 2) x[26] -= x[4] * ta[0]; x[26] -= x[5] * ta[1]; x[26] -= x[6] * ta[2]; x[26] -= x[7] * ta[3]; }
    { const f32x4 ta = tb5; TS_LD(5, 27, 3) x[26] -= x[8] * ta[0]; x[26] -= x[9] * ta[1]; x[26] -= x[10] * ta[2]; x[26] -= x[11] * ta[3]; }
    { const f32x4 ta = tb6; TS_LD(6, 27, 4) x[26] -= x[12] * ta[0]; x[26] -= x[13] * ta[1]; x[26] -= x[14] * ta[2]; x[26] -= x[15] * ta[3]; }
    { const f32x4 ta = tb7; TS_LD(7, 27, 5) x[26] -= x[16] * ta[0]; x[26] -= x[17] * ta[1]; x[26] -= x[18] * ta[2]; x[26] -= x[19] * ta[3]; }
    { const f32x4 ta = tb0; TS_LD(0, 27, 6) x[26] -= x[20] * ta[0]; x[26] -= x[21] * ta[1]; x[26] -= x[22] * ta[2]; x[26] -= x[23] * ta[3]; }
    { const f32x4 ta = tb1; TS_LD(1, 28, 0) x[26] -= x[24] * ta[0]; x[26] -= x[25] * ta[1]; }
    { const f32x4 ta = tb2; TS_LD(2, 28, 1) x[27] -= x[0] * ta[0]; x[27] -= x[1] * ta[1]; x[27] -= x[2] * ta[2]; x[27] -= x[3] * ta[3]; }
    { const f32x4 ta = tb3; TS_LD(3, 28, 2) x[27] -= x[4] * ta[0]; x[27] -= x[5] * ta[1]; x[27] -= x[6] * ta[2]; x[27] -= x[7] * ta[3]; }
    { const f32x4 ta = tb4; TS_LD(4, 28, 3) x[27] -= x[8] * ta[0]; x[27] -= x[9] * ta[1]; x[27] -= x[10] * ta[2]; x[27] -= x[11] * ta[3]; }
    { const f32x4 ta = tb5; TS_LD(5, 28, 4) x[27] -= x[12] * ta[0]; x[27] -= x[13] * ta[1]; x[27] -= x[14] * ta[2]; x[27] -= x[15] * ta[3]; }
    { const f32x4 ta = tb6; TS_LD(6, 28, 5) x[27] -= x[16] * ta[0]; x[27] -= x[17] * ta[1]; x[27] -= x[18] * ta[2]; x[27] -= x[19] * ta[3]; }
    { const f32x4 ta = tb7; TS_LD(7, 28, 6) x[27] -= x[20] * ta[0]; x[27] -= x[21] * ta[1]; x[27] -= x[22] * ta[2]; x[27] -= x[23] * ta[3]; }
    { const f32x4 ta = tb0; TS_LD(0, 29, 0) x[27] -= x[24] * ta[0]; x[27] -= x[25] * ta[1]; x[27] -= x[26] * ta[2]; }
    { const f32x4 ta = tb1; TS_LD(1, 29, 1) x[28] -= x[0] * ta[0]; x[28] -= x[1] * ta[1]; x[28] -= x[2] * ta[2]; x[28] -= x[3] * ta[3]; }
    { const f32x4 ta = tb2; TS_LD(2, 29, 2) x[28] -= x[4] * ta[0]; x[28] -= x[5] * ta[1]; x[28] -= x[6] * ta[2]; x[28] -= x[7] * ta[3]; }
    { const f32x4 ta = tb3; TS_LD(3, 29, 3) x[28] -= x[8] * ta[0]; x[28] -= x[9] * ta[1]; x[28] -= x[10] * ta[2]; x[28] -= x[11] * ta[3]; }
    { const f32x4 ta = tb4; TS_LD(4, 29, 4) x[28] -= x[12] * ta[0]; x[28] -= x[13] * ta[1]; x[28] -= x[14] * ta[2]; x[28] -= x[15] * ta[3]; }
    { const f32x4 ta = tb5; TS_LD(5, 29, 5) x[28] -= x[16] * ta[0]; x[28] -= x[17] * ta[1]; x[28] -= x[18] * ta[2]; x[28] -= x[19] * ta[3]; }
    { const f32x4 ta = tb6; TS_LD(6, 29, 6) x[28] -= x[20] * ta[0]; x[28] -= x[21] * ta[1]; x[28] -= x[22] * ta[2]; x[28] -= x[23] * ta[3]; }
    { const f32x4 ta = tb7; TS_LD(7, 29, 7) x[28] -= x[24] * ta[0]; x[28] -= x[25] * ta[1]; x[28] -= x[26] * ta[2]; x[28] -= x[27] * ta[3]; }
    { const f32x4 ta = tb0; TS_LD(0, 30, 0) x[29] -= x[0] * ta[0]; x[29] -= x[1] * ta[1]; x[29] -= x[2] * ta[2]; x[29] -= x[3] * ta[3]; }
    { const f32x4 ta = tb1; TS_LD(1, 30, 1) x[29] -= x[4] * ta[0]; x[29] -= x[5] * ta[1]; x[29] -= x[6] * ta[2]; x[29] -= x[7] * ta[3]; }
    { const f32x4 ta = tb2; TS_LD(2, 30, 2) x[29] -= x[8] * ta[0]; x[29] -= x[9] * ta[1]; x[29] -= x[10] * ta[2]; x[29] -= x[11] * ta[3]; }
    { const f32x4 ta = tb3; TS_LD(3, 30, 3) x[29] -= x[12] * ta[0]; x[29] -= x[13] * ta[1]; x[29] -= x[14] * ta[2]; x[29] -= x[15] * ta[3]; }
    { const f32x4 ta = tb4; TS_LD(4, 30, 4) x[29] -= x[16] * ta[0]; x[29] -= x[17] * ta[1]; x[29] -= x[18] * ta[2]; x[29] -= x[19] * ta[3]; }
    { const f32x4 ta = tb5; TS_LD(5, 30, 5) x[29] -= x[20] * ta[0]; x[29] -= x[21] * ta[1]; x[29] -= x[22] * ta[2]; x[29] -= x[23] * ta[3]; }
    { const f32x4 ta = tb6; TS_LD(6, 30, 6) x[29] -= x[24] * ta[0]; x[29] -= x[25] * ta[1]; x[29] -= x[26] * ta[2]; x[29] -= x[27] * ta[3]; }
    { const f32x4 ta = tb7; TS_LD(7, 30, 7) x[29] -= x[28] * ta[0]; }
    { const f32x4 ta = tb0; TS_LD(0, 31, 0) x[30] -= x[0] * ta[0]; x[30] -= x[1] * ta[1]; x[30] -= x[2] * ta[2]; x[30] -= x[3] * ta[3]; }
    { const f32x4 ta = tb1; TS_LD(1, 31, 1) x[30] -= x[4] * ta[0]; x[30] -= x[5] * ta[1]; x[30] -= x[6] * ta[2]; x[30] -= x[7] * ta[3]; }
    { const f32x4 ta = tb2; TS_LD(2, 31, 2) x[30] -= x[8] * ta[0]; x[30] -= x[9] * ta[1]; x[30] -= x[10] * ta[2]; x[30] -= x[11] * ta[3]; }
    { const f32x4 ta = tb3; TS_LD(3, 31, 3) x[30] -= x[12] * ta[0]; x[30] -= x[13] * ta[1]; x[30] -= x[14] * ta[2]; x[30] -= x[15] * ta[3]; }
    { const f32x4 ta = tb4; TS_LD(4, 31, 4) x[30] -= x[16] * ta[0]; x[30] -= x[17] * ta[1]; x[30] -= x[18] * ta[2]; x[30] -= x[19] * ta[3]; }
    { const f32x4 ta = tb5; TS_LD(5, 31, 5) x[30] -= x[20] * ta[0]; x[30] -= x[21] * ta[1]; x[30] -= x[22] * ta[2]; x[30] -= x[23] * ta[3]; }
    { const f32x4 ta = tb6; TS_LD(6, 31, 6) x[30] -= x[24] * ta[0]; x[30] -= x[25] * ta[1]; x[30] -= x[26] * ta[2]; x[30] -= x[27] * ta[3]; }
    { const f32x4 ta = tb7; TS_LD(7, 31, 7) x[30] -= x[28] * ta[0]; x[30] -= x[29] * ta[1]; }
    { const f32x4 ta = tb0; TS_LD(0, 32, 0) x[31] -= x[0] * ta[0]; x[31] -= x[1] * ta[1]; x[31] -= x[2] * ta[2]; x[31] -= x[3] * ta[3]; }
    { const f32x4 ta = tb1; TS_LD(1, 32, 1) x[31] -= x[4] * ta[0]; x[31] -= x[5] * ta[1]; x[31] -= x[6] * ta[2]; x[31] -= x[7] * ta[3]; }
    { const f32x4 ta = tb2; TS_LD(2, 32, 2) x[31] -= x[8] * ta[0]; x[31] -= x[9] * ta[1]; x[31] -= x[10] * ta[2]; x[31] -= x[11] * ta[3]; }
    { const f32x4 ta = tb3; TS_LD(3, 32, 3) x[31] -= x[12] * ta[0]; x[31] -= x[13] * ta[1]; x[31] -= x[14] * ta[2]; x[31] -= x[15] * ta[3]; }
    { const f32x4 ta = tb4; TS_LD(4, 32, 4) x[31] -= x[16] * ta[0]; x[31] -= x[17] * ta[1]; x[31] -= x[18] * ta[2]; x[31] -= x[19] * ta[3]; }
    { const f32x4 ta = tb5; TS_LD(5, 32, 5) x[31] -= x[20] * ta[0]; x[31] -= x[21] * ta[1]; x[31] -= x[22] * ta[2]; x[31] -= x[23] * ta[3]; }
    { const f32x4 ta = tb6; TS_LD(6, 32, 6) x[31] -= x[24] * ta[0]; x[31] -= x[25] * ta[1]; x[31] -= x[26] * ta[2]; x[31] -= x[27] * ta[3]; }
    { const f32x4 ta = tb7; TS_LD(7, 32, 7) x[31] -= x[28] * ta[0]; x[31] -= x[29] * ta[1]; x[31] -= x[30] * ta[2]; }
    { const f32x4 ta = tb0; TS_LD(0, 33, 0) x[32] -= x[0] * ta[0]; x[32] -= x[1] * ta[1]; x[32] -= x[2] * ta[2]; x[32] -= x[3] * ta[3]; }
    { const f32x4 ta = tb1; TS_LD(1, 33, 1) x[32] -= x[4] * ta[0]; x[32] -= x[5] * ta[1]; x[32] -= x[6] * ta[2]; x[32] -= x[7] * ta[3]; }
    { const f32x4 ta = tb2; TS_LD(2, 33, 2) x[32] -= x[8] * ta[0]; x[32] -= x[9] * ta[1]; x[32] -= x[10] * ta[2]; x[32] -= x[11] * ta[3]; }
    { const f32x4 ta = tb3; TS_LD(3, 33, 3) x[32] -= x[12] * ta[0]; x[32] -= x[13] * ta[1]; x[32] -= x[14] * ta[2]; x[32] -= x[15] * ta[3]; }
    { const f32x4 ta = tb4; TS_LD(4, 33, 4) x[32] -= x[16] * ta[0]; x[32] -= x[17] * ta[1]; x[32] -= x[18] * ta[2]; x[32] -= x[19] * ta[3]; }
    { const f32x4 ta = tb5; TS_LD(5, 33, 5) x[32] -= x[20] * ta[0]; x[32] -= x[21] * ta[1]; x[32] -= x[22] * ta[2]; x[32] -= x[23] * ta[3]; }
    { const f32x4 ta = tb6; TS_LD(6, 33, 6) x[32] -= x[24] * ta[0]; x[32] -= x[25] * ta[1]; x[32] -= x[26] * ta[2]; x[32] -= x[27] * ta[3]; }
    { const f32x4 ta = tb7; TS_LD(7, 33, 7) x[32] -= x[28] * ta[0]; x[32] -= x[29] * ta[1]; x[32] -= x[30] * ta[2]; x[32] -= x[31] * ta[3]; }
    { const f32x4 ta = tb0; TS_LD(0, 33, 8) x[33] -= x[0] * ta[0]; x[33] -= x[1] * ta[1]; x[33] -= x[2] * ta[2]; x[33] -= x[3] * ta[3]; }
    { const f32x4 ta = tb1; TS_LD(1, 34, 0) x[33] -= x[4] * ta[0]; x[33] -= x[5] * ta[1]; x[33] -= x[6] * ta[2]; x[33] -= x[7] * ta[3]; }
    { const f32x4 ta = tb2; TS_LD(2, 34, 1) x[33] -= x[8] * ta[0]; x[33] -= x[9] * ta[1]; x[33] -= x[10] * ta[2]; x[33] -= x[11] * ta[3]; }
    { const f32x4 ta = tb3; TS_LD(3, 34, 2) x[33] -= x[12] * ta[0]; x[33] -= x[13] * ta[1]; x[33] -= x[14] * ta[2]; x[33] -= x[15] * ta[3]; }
    { const f32x4 ta = tb4; TS_LD(4, 34, 3) x[33] -= x[16] * ta[0]; x[33] -= x[17] * ta[1]; x[33] -= x[18] * ta[2]; x[33] -= x[19] * ta[3]; }
    { const f32x4 ta = tb5; TS_LD(5, 34, 4) x[33] -= x[20] * ta[0]; x[33] -= x[21] * ta[1]; x[33] -= x[22] * ta[2]; x[33] -= x[23] * ta[3]; }
    { const f32x4 ta = tb6; TS_LD(6, 34, 5) x[33] -= x[24] * ta[0]; x[33] -= x[25] * ta[1]; x[33] -= x[26] * ta[2]; x[33] -= x[27] * ta[3]; }
    { const f32x4 ta = tb7; TS_LD(7, 34, 6) x[33] -= x[28] * ta[0]; x[33] -= x[29] * ta[1]; x[33] -= x[30] * ta[2]; x[33] -= x[31] * ta[3]; }
    { const f32x4 ta = tb0; TS_LD(0, 34, 7) x[33] -= x[32] * ta[0]; }
    { const f32x4 ta = tb1; TS_LD(1, 34, 8) x[34] -= x[0] * ta[0]; x[34] -= x[1] * ta[1]; x[34] -= x[2] * ta[2]; x[34] -= x[3] * ta[3]; }
    { const f32x4 ta = tb2; TS_LD(2, 35, 0) x[34] -= x[4] * ta[0]; x[34] -= x[5] * ta[1]; x[34] -= x[6] * ta[2]; x[34] -= x[7] * ta[3]; }
    { const f32x4 ta = tb3; TS_LD(3, 35, 1) x[34] -= x[8] * ta[0]; x[34] -= x[9] * ta[1]; x[34] -= x[10] * ta[2]; x[34] -= x[11] * ta[3]; }
    { const f32x4 ta = tb4; TS_LD(4, 35, 2) x[34] -= x[12] * ta[0]; x[34] -= x[13] * ta[1]; x[34] -= x[14] * ta[2]; x[34] -= x[15] * ta[3]; }
    { const f32x4 ta = tb5; TS_LD(5, 35, 3) x[34] -= x[16] * ta[0]; x[34] -= x[17] * ta[1]; x[34] -= x[18] * ta[2]; x[34] -= x[19] * ta[3]; }
    { const f32x4 ta = tb6; TS_LD(6, 35, 4) x[34] -= x[20] * ta[0]; x[34] -= x[21] * ta[1]; x[34] -= x[22] * ta[2]; x[34] -= x[23] * ta[3]; }
    { const f32x4 ta = tb7; TS_LD(7, 35, 5) x[34] -= x[24] * ta[0]; x[34] -= x[25] * ta[1]; x[34] -= x[26] * ta[2]; x[34] -= x[27] * ta[3]; }
    { const f32x4 ta = tb0; TS_LD(0, 35, 6) x[34] -= x[28] * ta[0]; x[34] -= x[29] * ta[1]; x[34] -= x[30] * ta[2]; x[34] -= x[31] * ta[3]; }
    { const f32x4 ta = tb1; TS_LD(1, 35, 7) x[34] -= x[32] * ta[0]; x[34] -= x[33] * ta[1]; }
    { const f32x4 ta = tb2; TS_LD(2, 35, 8) x[35] -= x[0] * ta[0]; x[35] -= x[1] * ta[1]; x[35] -= x[2] * ta[2]; x[35] -= x[3] * ta[3]; }
    { const f32x4 ta = tb3; TS_LD(3, 36, 0) x[35] -= x[4] * ta[0]; x[35] -= x[5] * ta[1]; x[35] -= x[6] * ta[2]; x[35] -= x[7] * ta[3]; }
    { const f32x4 ta = tb4; TS_LD(4, 36, 1) x[35] -= x[8] * ta[0]; x[35] -= x[9] * ta[1]; x[35] -= x[10] * ta[2]; x[35] -= x[11] * ta[3]; }
    { const f32x4 ta = tb5; TS_LD(5, 36, 2) x[35] -= x[12] * ta[0]; x[35] -= x[13] * ta[1]; x[35] -= x[14] * ta[2]; x[35] -= x[15] * ta[3]; }
    { const f32x4 ta = tb6; TS_LD(6, 36, 3) x[35] -= x[16] * ta[0]; x[35] -= x[17] * ta[1]; x[35] -= x[18] * ta[2]; x[35] -= x[19] * ta[3]; }
    { const f32x4 ta = tb7; TS_LD(7, 36, 4) x[35] -= x[20] * ta[0]; x[35] -= x[21] * ta[1]; x[35] -= x[22] * ta[2]; x[35] -= x[23] * ta[3]; }
    { const f32x4 ta = tb0; TS_LD(0, 36, 5) x[35] -= x[24] * ta[0]; x[35] -= x[25] * ta[1]; x[35] -= x[26] * ta[2]; x[35] -= x[27] * ta[3]; }
    { const f32x4 ta = tb1; TS_LD(1, 36, 6) x[35] -= x[28] * ta[0]; x[35] -= x[29] * ta[1]; x[35] -= x[30] * ta[2]; x[35] -= x[31] * ta[3]; }
    { const f32x4 ta = tb2; TS_LD(2, 36, 7) x[35] -= x[32] * ta[0]; x[35] -= x[33] * ta[1]; x[35] -= x[34] * ta[2]; }
    { const f32x4 ta = tb3; TS_LD(3, 36, 8) x[36] -= x[0] * ta[0]; x[36] -= x[1] * ta[1]; x[36] -= x[2] * ta[2]; x[36] -= x[3] * ta[3]; }
    { const f32x4 ta = tb4; TS_LD(4, 37, 0) x[36] -= x[4] * ta[0]; x[36] -= x[5] * ta[1]; x[36] -= x[6] * ta[2]; x[36] -= x[7] * ta[3]; }
    { const f32x4 ta = tb5; TS_LD(5, 37, 1) x[36] -= x[8] * ta[0]; x[36] -= x[9] * ta[1]; x[36] -= x[10] * ta[2]; x[36] -= x[11] * ta[3]; }
    { const f32x4 ta = tb6; TS_LD(6, 37, 2) x[36] -= x[12] * ta[0]; x[36] -= x[13] * ta[1]; x[36] -= x[14] * ta[2]; x[36] -= x[15] * ta[3]; }
    { const f32x4 ta = tb7; TS_LD(7, 37, 3) x[36] -= x[16] * ta[0]; x[36] -= x[17] * ta[1]; x[36] -= x[18] * ta[2]; x[36] -= x[19] * ta[3]; }
    { const f32x4 ta = tb0; TS_LD(0, 37, 4) x[36] -= x[20] * ta[0]; x[36] -= x[21] * ta[1]; x[36] -= x[22] * ta[2]; x[36] -= x[23] * ta[3]; }
    { const f32x4 ta = tb1; TS_LD(1, 37, 5) x[36] -= x[24] * ta[0]; x[36] -= x[25] * ta[1]; x[36] -= x[26] * ta[2]; x[36] -= x[27] * ta[3]; }
    { const f32x4 ta = tb2; TS_LD(2, 37, 6) x[36] -= x[28] * ta[0]; x[36] -= x[29] * ta[1]; x[36] -= x[30] * ta[2]; x[36] -= x[31] * ta[3]; }
    { const f32x4 ta = tb3; TS_LD(3, 37, 7) x[36] -= x[32] * ta[0]; x[36] -= x[33] * ta[1]; x[36] -= x[34] * ta[2]; x[36] -= x[35] * ta[3]; }
    { const f32x4 ta = tb4; TS_LD(4, 37, 8) x[37] -= x[0] * ta[0]; x[37] -= x[1] * ta[1]; x[37] -= x[2] * ta[2]; x[37] -= x[3] * ta[3]; }
    { const f32x4 ta = tb5; TS_LD(5, 37, 9) x[37] -= x[4] * ta[0]; x[37] -= x[5] * ta[1]; x[37] -= x[6] * ta[2]; x[37] -= x[7] * ta[3]; }
    { const f32x4 ta = tb6; TS_LD(6, 38, 0) x[37] -= x[8] * ta[0]; x[37] -= x[9] * ta[1]; x[37] -= x[10] * ta[2]; x[37] -= x[11] * ta[3]; }
    { const f32x4 ta = tb7; TS_LD(7, 38, 1) x[37] -= x[12] * ta[0]; x[37] -= x[13] * ta[1]; x[37] -= x[14] * ta[2]; x[37] -= x[15] * ta[3]; }
    { const f32x4 ta = tb0; TS_LD(0, 38, 2) x[37] -= x[16] * ta[0]; x[37] -= x[17] * ta[1]; x[37] -= x[18] * ta[2]; x[37] -= x[19] * ta[3]; }
    { const f32x4 ta = tb1; TS_LD(1, 38, 3) x[37] -= x[20] * ta[0]; x[37] -= x[21] * ta[1]; x[37] -= x[22] * ta[2]; x[37] -= x[23] * ta[3]; }
    { const f32x4 ta = tb2; TS_LD(2, 38, 4) x[37] -= x[24] * ta[0]; x[37] -= x[25] * ta[1]; x[37] -= x[26] * ta[2]; x[37] -= x[27] * ta[3]; }
    { const f32x4 ta = tb3; TS_LD(3, 38, 5) x[37] -= x[28] * ta[0]; x[37] -= x[29] * ta[1]; x[37] -= x[30] * ta[2]; x[37] -= x[31] * ta[3]; }
    { const f32x4 ta = tb4; TS_LD(4, 38, 6) x[37] -= x[32] * ta[0]; x[37] -= x[33] * ta[1]; x[37] -= x[34] * ta[2]; x[37] -= x[35] * ta[3]; }
    { const f32x4 ta = tb5; TS_LD(5, 38, 7) x[37] -= x[36] * ta[0]; }
    { const f32x4 ta = tb6; TS_LD(6, 38, 8) x[38] -= x[0] * ta[0]; x[38] -= x[1] * ta[1]; x[38] -= x[2] * ta[2]; x[38] -= x[3] * ta[3]; }
    { const f32x4 ta = tb7; TS_LD(7, 38, 9) x[38] -= x[4] * ta[0]; x[38] -= x[5] * ta[1]; x[38] -= x[6] * ta[2]; x[38] -= x[7] * ta[3]; }
    { const f32x4 ta = tb0; TS_LD(0, 39, 0) x[38] -= x[8] * ta[0]; x[38] -= x[9] * ta[1]; x[38] -= x[10] * ta[2]; x[38] -= x[11] * ta[3]; }
    { const f32x4 ta = tb1; TS_LD(1, 39, 1) x[38] -= x[12] * ta[0]; x[38] -= x[13] * ta[1]; x[38] -= x[14] * ta[2]; x[38] -= x[15] * ta[3]; }
    { const f32x4 ta = tb2; TS_LD(2, 39, 2) x[38] -= x[16] * ta[0]; x[38] -= x[17] * ta[1]; x[38] -= x[18] * ta[2]; x[38] -= x[19] * ta[3]; }
    { const f32x4 ta = tb3; TS_LD(3, 39, 3) x[38] -= x[20] * ta[0]; x[38] -= x[21] * ta[1]; x[38] -= x[22] * ta[2]; x[38] -= x[23] * ta[3]; }
    { const f32x4 ta = tb4; TS_LD(4, 39, 4) x[38] -= x[24] * ta[0]; x[38] -= x[25] * ta[1]; x[38] -= x[26] * ta[2]; x[38] -= x[27] * ta[3]; }
    { const f32x4 ta = tb5; TS_LD(5, 39, 5) x[38] -= x[28] * ta[0]; x[38] -= x[29] * ta[1]; x[38] -= x[30] * ta[2]; x[38] -= x[31] * ta[3]; }
    { const f32x4 ta = tb6; TS_LD(6, 39, 6) x[38] -= x[32] * ta[0]; x[38] -= x[33] * ta[1]; x[38] -= x[34] * ta[2]; x[38] -= x[35] * ta[3]; }
    { const f32x4 ta = tb7; TS_LD(7, 39, 7) x[38] -= x[36] * ta[0]; x[38] -= x[37] * ta[1]; }
    { const f32x4 ta = tb0; TS_LD(0, 39, 8) x[39] -= x[0] * ta[0]; x[39] -= x[1] * ta[1]; x[39] -= x[2] * ta[2]; x[39] -= x[3] * ta[3]; }
    { const f32x4 ta = tb1; TS_LD(1, 39, 9) x[39] -= x[4] * ta[0]; x[39] -= x[5] * ta[1]; x[39] -= x[6] * ta[2]; x[39] -= x[7] * ta[3]; }
    { const f32x4 ta = tb2; TS_LD(2, 40, 0) x[39] -= x[8] * ta[0]; x[39] -= x[9] * ta[1]; x[39] -= x[10] * ta[2]; x[39] -= x[11] * ta[3]; }
    { const f32x4 ta = tb3; TS_LD(3, 40, 1) x[39] -= x[12] * ta[0]; x[39] -= x[13] * ta[1]; x[39] -= x[14] * ta[2]; x[39] -= x[15] * ta[3]; }
    { const f32x4 ta = tb4; TS_LD(4, 40, 2) x[39] -= x[16] * ta[0]; x[39] -= x[17] * ta[1]; x[39] -= x[18] * ta[2]; x[39] -= x[19] * ta[3]; }
    { const f32x4 ta = tb5; TS_LD(5, 40, 3) x[39] -= x[20] * ta[0]; x[39] -= x[21] * ta[1]; x[39] -= x[22] * ta[2]; x[39] -= x[23] * ta[3]; }
    { const f32x4 ta = tb6; TS_LD(6, 40, 4) x[39] -= x[24] * ta[0]; x[39] -= x[25] * ta[1]; x[39] -= x[26] * ta[2]; x[39] -= x[27] * ta[3]; }
    { const f32x4 ta = tb7; TS_LD(7, 40, 5) x[39] -= x[28] * ta[0]; x[39] -= x[29] * ta[1]; x[39] -= x[30] * ta[2]; x[39] -= x[31] * ta[3]; }
    { const f32x4 ta = tb0; TS_LD(0, 40, 6) x[39] -= x[32] * ta[0]; x[39] -= x[33] * ta[1]; x[39] -= x[34] * ta[2]; x[39] -= x[35] * ta[3]; }
    { const f32x4 ta = tb1; TS_LD(1, 40, 7) x[39] -= x[36] * ta[0]; x[39] -= x[37] * ta[1]; x[39] -= x[38] * ta[2]; }
    { const f32x4 ta = tb2; TS_LD(2, 40, 8) x[40] -= x[0] * ta[0]; x[40] -= x[1] * ta[1]; x[40] -= x[2] * ta[2]; x[40] -= x[3] * ta[3]; }
    { const f32x4 ta = tb3; TS_LD(3, 40, 9) x[40] -= x[4] * ta[0]; x[40] -= x[5] * ta[1]; x[40] -= x[6] * ta[2]; x[40] -= x[7] * ta[3]; }
    { const f32x4 ta = tb4; TS_LD(4, 41, 0) x[40] -= x[8] * ta[0]; x[40] -= x[9] * ta[1]; x[40] -= x[10] * ta[2]; x[40] -= x[11] * ta[3]; }
    { const f32x4 ta = tb5; TS_LD(5, 41, 1) x[40] -= x[12] * ta[0]; x[40] -= x[13] * ta[1]; x[40] -= x[14] * ta[2]; x[40] -= x[15] * ta[3]; }
    { const f32x4 ta = tb6; TS_LD(6, 41, 2) x[40] -= x[16] * ta[0]; x[40] -= x[17] * ta[1]; x[40] -= x[18] * ta[2]; x[40] -= x[19] * ta[3]; }
    { const f32x4 ta = tb7; TS_LD(7, 41, 3) x[40] -= x[20] * ta[0]; x[40] -= x[21] * ta[1]; x[40] -= x[22] * ta[2]; x[40] -= x[23] * ta[3]; }
    { const f32x4 ta = tb0; TS_LD(0, 41, 4) x[40] -= x[24] * ta[0]; x[40] -= x[25] * ta[1]; x[40] -= x[26] * ta[2]; x[40] -= x[27] * ta[3]; }
    { const f32x4 ta = tb1; TS_LD(1, 41, 5) x[40] -= x[28] * ta[0]; x[40] -= x[29] * ta[1]; x[40] -= x[30] * ta[2]; x[40] -= x[31] * ta[3]; }
    { const f32x4 ta = tb2; TS_LD(2, 41, 6) x[40] -= x[32] * ta[0]; x[40] -= x[33] * ta[1]; x[40] -= x[34] * ta[2]; x[40] -= x[35] * ta[3]; }
    { const f32x4 ta = tb3; TS_LD(3, 41, 7) x[40] -= x[36] * ta[0]; x[40] -= x[37] * ta[1]; x[40] -= x[38] * ta[2]; x[40] -= x[39] * ta[3]; }
    { const f32x4 ta = tb4; TS_LD(4, 41, 8) x[41] -= x[0] * ta[0]; x[41] -= x[1] * ta[1]; x[41] -= x[2] * ta[2]; x[41] -= x[3] * ta[3]; }
    { const f32x4 ta = tb5; TS_LD(5, 41, 9) x[41] -= x[4] * ta[0]; x[41] -= x[5] * ta[1]; x[41] -= x[6] * ta[2]; x[41] -= x[7] * ta[3]; }
    { const f32x4 ta = tb6; TS_LD(6, 41, 10) x[41] -= x[8] * ta[0]; x[41] -= x[9] * ta[1]; x[41] -= x[10] * ta[2]; x[41] -= x[11] * ta[3]; }
    { const f32x4 ta = tb7; TS_LD(7, 42, 0) x[41] -= x[12] * ta[0]; x[41] -= x[13] * ta[1]; x[41] -= x[14] * ta[2]; x[41] -= x[15] * ta[3]; }
    { const f32x4 ta = tb0; TS_LD(0, 42, 1) x[41] -= x[16] * ta[0]; x[41] -= x[17] * ta[1]; x[41] -= x[18] * ta[2]; x[41] -= x[19] * ta[3]; }
    { const f32x4 ta = tb1; TS_LD(1, 42, 2) x[41] -= x[20] * ta[0]; x[41] -= x[21] * ta[1]; x[41] -= x[22] * ta[2]; x[41] -= x[23] * ta[3]; }
    { const f32x4 ta = tb2; TS_LD(2, 42, 3) x[41] -= x[24] * ta[0]; x[41] -= x[25] * ta[1]; x[41] -= x[26] * ta[2]; x[41] -= x[27] * ta[3]; }
    { const f32x4 ta = tb3; TS_LD(3, 42, 4) x[41] -= x[28] * ta[0]; x[41] -= x[29] * ta[1]; x[41] -= x[30] * ta[2]; x[41] -= x[31] * ta[3]; }
    { const f32x4 ta = tb4; TS_LD(4, 42, 5) x[41] -= x[32] * ta[0]; x[41] -= x[33] * ta[1]; x[41] -= x[34] * ta[2]; x[41] -= x[35] * ta[3]; }
    { const f32x4 ta = tb5; TS_LD(5, 42, 6) x[41] -= x[36] * ta[0]; x[41] -= x[37] * ta[1]; x[41] -= x[38] * ta[2]; x[41] -= x[39] * ta[3]; }
    { const f32x4 ta = tb6; TS_LD(6, 42, 7) x[41] -= x[40] * ta[0]; }
    { const f32x4 ta = tb7; TS_LD(7, 42, 8) x[42] -= x[0] * ta[0]; x[42] -= x[1] * ta[1]; x[42] -= x[2] * ta[2]; x[42] -= x[3] * ta[3]; }
    { const f32x4 ta = tb0; TS_LD(0, 42, 9) x[42] -= x[4] * ta[0]; x[42] -= x[5] * ta[1]; x[42] -= x[6] * ta[2]; x[42] -= x[7] * ta[3]; }
    { const f32x4 ta = tb1; TS_LD(1, 42, 10) x[42] -= x[8] * ta[0]; x[42] -= x[9] * ta[1]; x[42] -= x[10] * ta[2]; x[42] -= x[11] * ta[3]; }
    { const f32x4 ta = tb2; TS_LD(2, 43, 0) x[42] -= x[12] * ta[0]; x[42] -= x[13] * ta[1]; x[42] -= x[14] * ta[2]; x[42] -= x[15] * ta[3]; }
    { const f32x4 ta = tb3; TS_LD(3, 43, 1) x[42] -= x[16] * ta[0]; x[42] -= x[17] * ta[1]; x[42] -= x[18] * ta[2]; x[42] -= x[19] * ta[3]; }
    { const f32x4 ta = tb4; TS_LD(4, 43, 2) x[42] -= x[20] * ta[0]; x[42] -= x[21] * ta[1]; x[42] -= x[22] * ta[2]; x[42] -= x[23] * ta[3]; }
    { const f32x4 ta = tb5; TS_LD(5, 43, 3) x[42] -= x[24] * ta[0]; x[42] -= x[25] * ta[1]; x[42] -= x[26] * ta[2]; x[42] -= x[27] * ta[3]; }
    { const f32x4 ta = tb6; TS_LD(6, 43, 4) x[42] -= x[28] * ta[0]; x[42] -= x[29] * ta[1]; x[42] -= x[30] * ta[2]; x[42] -= x[31] * ta[3]; }
    { const f32x4 ta = tb7; TS_LD(7, 43, 5) x[42] -= x[32] * ta[0]; x[42] -= x[33] * ta[1]; x[42] -= x[34] * ta[2]; x[42] -= x[35] * ta[3]; }
    { const f32x4 ta = tb0; TS_LD(0, 43, 6) x[42] -= x[36] * ta[0]; x[42] -= x[37] * ta[1]; x[42] -= x[38] * ta[2]; x[42] -= x[39] * ta[3]; }
    { const f32x4 ta = tb1; TS_LD(1, 43, 7) x[42] -= x[40] * ta[0]; x[42] -= x[41] * ta[1]; }
    { const f32x4 ta = tb2; TS_LD(2, 43, 8) x[43] -= x[0] * ta[0]; x[43] -= x[1] * ta[1]; x[43] -= x[2] * ta[2]; x[43] -= x[3] * ta[3]; }
    { const f32x4 ta = tb3; TS_LD(3, 43, 9) x[43] -= x[4] * ta[0]; x[43] -= x[5] * ta[1]; x[43] -= x[6] * ta[2]; x[43] -= x[7] * ta[3]; }
    { const f32x4 ta = tb4; TS_LD(4, 43, 10) x[43] -= x[8] * ta[0]; x[43] -= x[9] * ta[1]; x[43] -= x[10] * ta[2]; x[43] -= x[11] * ta[3]; }
    { const f32x4 ta = tb5; TS_LD(5, 44, 0) x[43] -= x[12] * ta[0]; x[43] -= x[13] * ta[1]; x[43] -= x[14] * ta[2]; x[43] -= x[15] * ta[3]; }
    { const f32x4 ta = tb6; TS_LD(6, 44, 1) x[43] -= x[16] * ta[0]; x[43] -= x[17] * ta[1]; x[43] -= x[18] * ta[2]; x[43] -= x[19] * ta[3]; }
    { const f32x4 ta = tb7; TS_LD(7, 44, 2) x[43] -= x[20] * ta[0]; x[43] -= x[21] * ta[1]; x[43] -= x[22] * ta[2]; x[43] -= x[23] * ta[3]; }
    { const f32x4 ta = tb0; TS_LD(0, 44, 3) x[43] -= x[24] * ta[0]; x[43] -= x[25] * ta[1]; x[43] -= x[26] * ta[2]; x[43] -= x[27] * ta[3]; }
    { const f32x4 ta = tb1; TS_LD(1, 44, 4) x[43] -= x[28] * ta[0]; x[43] -= x[29] * ta[1]; x[43] -= x[30] * ta[2]; x[43] -= x[31] * ta[3]; }
    { const f32x4 ta = tb2; TS_LD(2, 44, 5) x[43] -= x[32] * ta[0]; x[43] -= x[33] * ta[1]; x[43] -= x[34] * ta[2]; x[43] -= x[35] * ta[3]; }
    { const f32x4 ta = tb3; TS_LD(3, 44, 6) x[43] -= x[36] * ta[0]; x[43] -= x[37] * ta[1]; x[43] -= x[38] * ta[2]; x[43] -= x[39] * ta[3]; }
    { const f32x4 ta = tb4; TS_LD(4, 44, 7) x[43] -= x[40] * ta[0]; x[43] -= x[41] * ta[1]; x[43] -= x[42] * ta[2]; }
    { const f32x4 ta = tb5; TS_LD(5, 44, 8) x[44] -= x[0] * ta[0]; x[44] -= x[1] * ta[1]; x[44] -= x[2] * ta[2]; x[44] -= x[3] * ta[3]; }
    { const f32x4 ta = tb6; TS_LD(6, 44, 9) x[44] -= x[4] * ta[0]; x[44] -= x[5] * ta[1]; x[44] -= x[6] * ta[2]; x[44] -= x[7] * ta[3]; }
    { const f32x4 ta = tb7; TS_LD(7, 44, 10) x[44] -= x[8] * ta[0]; x[44] -= x[9] * ta[1]; x[44] -= x[10] * ta[2]; x[44] -= x[11] * ta[3]; }
    { const f32x4 ta = tb0; TS_LD(0, 45, 0) x[44] -= x[12] * ta[0]; x[44] -= x[13] * ta[1]; x[44] -= x[14] * ta[2]; x[44] -= x[15] * ta[3]; }
    { const f32x4 ta = tb1; TS_LD(1, 45, 1) x[44] -= x[16] * ta[0]; x[44] -= x[17] * ta[1]; x[44] -= x[18] * ta[2]; x[44] -= x[19] * ta[3]; }
    { const f32x4 ta = tb2; TS_LD(2, 45, 2) x[44] -= x[20] * ta[0]; x[44] -= x[21] * ta[1]; x[44] -= x[22] * ta[2]; x[44] -= x[23] * ta[3]; }
    { const f32x4 ta = tb3; TS_LD(3, 45, 3) x[44] -= x[24] * ta[0]; x[44] -= x[25] * ta[1]; x[44] -= x[26] * ta[2]; x[44] -= x[27] * ta[3]; }
    { const f32x4 ta = tb4; TS_LD(4, 45, 4) x[44] -= x[28] * ta[0]; x[44] -= x[29] * ta[1]; x[44] -= x[30] * ta[2]; x[44] -= x[31] * ta[3]; }
    { const f32x4 ta = tb5; TS_LD(5, 45, 5) x[44] -= x[32] * ta[0]; x[44] -= x[33] * ta[1]; x[44] -= x[34] * ta[2]; x[44] -= x[35] * ta[3]; }
    { const f32x4 ta = tb6; TS_LD(6, 45, 6) x[44] -= x[36] * ta[0]; x[44] -= x[37] * ta[1]; x[44] -= x[38] * ta[2]; x[44] -= x[39] * ta[3]; }
    { const f32x4 ta = tb7; TS_LD(7, 45, 7) x[44] -= x[40] * ta[0]; x[44] -= x[41] * ta[1]; x[44] -= x[42] * ta[2]; x[44] -= x[43] * ta[3]; }
    { const f32x4 ta = tb0; TS_LD(0, 45, 8) x[45] -= x[0] * ta[0]; x[45] -= x[1] * ta[1]; x[45] -= x[2] * ta[2]; x[45] -= x[3] * ta[3]; }
    { const f32x4 ta = tb1; TS_LD(1, 45, 9) x[45] -= x[4] * ta[0]; x[45] -= x[5] * ta[1]; x[45] -= x[6] * ta[2]; x[45] -= x[7] * ta[3]; }
    { const f32x4 ta = tb2; TS_LD(2, 45, 10) x[45] -= x[8] * ta[0]; x[45] -= x[9] * ta[1]; x[45] -= x[10] * ta[2]; x[45] -= x[11] * ta[3]; }
    { const f32x4 ta = tb3; TS_LD(3, 45, 11) x[45] -= x[12] * ta[0]; x[45] -= x[13] * ta[1]; x[45] -= x[14] * ta[2]; x[45] -= x[15] * ta[3]; }
    { const f32x4 ta = tb4; TS_LD(4, 46, 0) x[45] -= x[16] * ta[0]; x[45] -= x[17] * ta[1]; x[45] -= x[18] * ta[2]; x[45] -= x[19] * ta[3]; }
    { const f32x4 ta = tb5; TS_LD(5, 46, 1) x[45] -= x[20] * ta[0]; x[45] -= x[21] * ta[1]; x[45] -= x[22] * ta[2]; x[45] -= x[23] * ta[3]; }
    { const f32x4 ta = tb6; TS_LD(6, 46, 2) x[45] -= x[24] * ta[0]; x[45] -= x[25] * ta[1]; x[45] -= x[26] * ta[2]; x[45] -= x[27] * ta[3]; }
    { const f32x4 ta = tb7; TS_LD(7, 46, 3) x[45] -= x[28] * ta[0]; x[45] -= x[29] * ta[1]; x[45] -= x[30] * ta[2]; x[45] -= x[31] * ta[3]; }
    { const f32x4 ta = tb0; TS_LD(0, 46, 4) x[45] -= x[32] * ta[0]; x[45] -= x[33] * ta[1]; x[45] -= x[34] * ta[2]; x[45] -= x[35] * ta[3]; }
    { const f32x4 ta = tb1; TS_LD(1, 46, 5) x[45] -= x[36] * ta[0]; x[45] -= x[37] * ta[1]; x[45] -= x[38] * ta[2]; x[45] -= x[39] * ta[3]; }
    { const f32x4 ta = tb2; TS_LD(2, 46, 6) x[45] -= x[40] * ta[0]; x[45] -= x[41] * ta[1]; x[45] -= x[42] * ta[2]; x[45] -= x[43] * ta[3]; }
    { const f32x4 ta = tb3; TS_LD(3, 46, 7) x[45] -= x[44] * ta[0]; }
    { const f32x4 ta = tb4; TS_LD(4, 46, 8) x[46] -= x[0] * ta[0]; x[46] -= x[1] * ta[1]; x[46] -= x[2] * ta[2]; x[46] -= x[3] * ta[3]; }
    { const f32x4 ta = tb5; TS_LD(5, 46, 9) x[46] -= x[4] * ta[0]; x[46] -= x[5] * ta[1]; x[46] -= x[6] * ta[2]; x[46] -= x[7] * ta[3]; }
    { const f32x4 ta = tb6; TS_LD(6, 46, 10) x[46] -= x[8] * ta[0]; x[46] -= x[9] * ta[1]; x[46] -= x[10] * ta[2]; x[46] -= x[11] * ta[3]; }
    { const f32x4 ta = tb7; TS_LD(7, 46, 11) x[46] -= x[12] * ta[0]; x[46] -= x[13] * ta[1]; x[46] -= x[14] * ta[2]; x[46] -= x[15] * ta[3]; }
    { const f32x4 ta = tb0; TS_LD(0, 47, 0) x[46] -= x[16] * ta[0]; x[46] -= x[17] * ta[1]; x[46] -= x[18] * ta[2]; x[46] -= x[19] * ta[3]; }
    { const f32x4 ta = tb1; TS_LD(1, 47, 1) x[46] -= x[20] * ta[0]; x[46] -= x[21] * ta[1]; x[46] -= x[22] * ta[2]; x[46] -= x[23] * ta[3]; }
    { const f32x4 ta = tb2; TS_LD(2, 47, 2) x[46] -= x[24] * ta[0]; x[46] -= x[25] * ta[1]; x[46] -= x[26] * ta[2]; x[46] -= x[27] * ta[3]; }
    { const f32x4 ta = tb3; TS_LD(3, 47, 3) x[46] -= x[28] * ta[0]; x[46] -= x[29] * ta[1]; x[46] -= x[30] * ta[2]; x[46] -= x[31] * ta[3]; }
    { const f32x4 ta = tb4; TS_LD(4, 47, 4) x[46] -= x[32] * ta[0]; x[46] -= x[33] * ta[1]; x[46] -= x[34] * ta[2]; x[46] -= x[35] * ta[3]; }
    { const f32x4 ta = tb5; TS_LD(5, 47, 5) x[46] -= x[36] * ta[0]; x[46] -= x[37] * ta[1]; x[46] -= x[38] * ta[2]; x[46] -= x[39] * ta[3]; }
    { const f32x4 ta = tb6; TS_LD(6, 47, 6) x[46] -= x[40] * ta[0]; x[46] -= x[41] * ta[1]; x[46] -= x[42] * ta[2]; x[46] -= x[43] * ta[3]; }
    { const f32x4 ta = tb7; TS_LD(7, 47, 7) x[46] -= x[44] * ta[0]; x[46] -= x[45] * ta[1]; }
    { const f32x4 ta = tb0; TS_LD(0, 47, 8) x[47] -= x[0] * ta[0]; x[47] -= x[1] * ta[1]; x[47] -= x[2] * ta[2]; x[47] -= x[3] * ta[3]; }
    { const f32x4 ta = tb1; TS_LD(1, 47, 9) x[47] -= x[4] * ta[0]; x[47] -= x[5] * ta[1]; x[47] -= x[6] * ta[2]; x[47] -= x[7] * ta[3]; }
    { const f32x4 ta = tb2; TS_LD(2, 47, 10) x[47] -= x[8] * ta[0]; x[47] -= x[9] * ta[1]; x[47] -= x[10] * ta[2]; x[47] -= x[11] * ta[3]; }
    { const f32x4 ta = tb3; TS_LD(3, 47, 11) x[47] -= x[12] * ta[0]; x[47] -= x[13] * ta[1]; x[47] -= x[14] * ta[2]; x[47] -= x[15] * ta[3]; }
    { const f32x4 ta = tb4; TS_LD(4, 48, 0) x[47] -= x[16] * ta[0]; x[47] -= x[17] * ta[1]; x[47] -= x[18] * ta[2]; x[47] -= x[19] * ta[3]; }
    { const f32x4 ta = tb5; TS_LD(5, 48, 1) x[47] -= x[20] * ta[0]; x[47] -= x[21] * ta[1]; x[47] -= x[22] * ta[2]; x[47] -= x[23] * ta[3]; }
    { const f32x4 ta = tb6; TS_LD(6, 48, 2) x[47] -= x[24] * ta[0]; x[47] -= x[25] * ta[1]; x[47] -= x[26] * ta[2]; x[47] -= x[27] * ta[3]; }
    { const f32x4 ta = tb7; TS_LD(7, 48, 3) x[47] -= x[28] * ta[0]; x[47] -= x[29] * ta[1]; x[47] -= x[30] * ta[2]; x[47] -= x[31] * ta[3]; }
    { const f32x4 ta = tb0; TS_LD(0, 48, 4) x[47] -= x[32] * ta[0]; x[47] -= x[33] * ta[1]; x[47] -= x[34] * ta[2]; x[47] -= x[35] * ta[3]; }
    { const f32x4 ta = tb1; TS_LD(1, 48, 5) x[47] -= x[36] * ta[0]; x[47] -= x[37] * ta[1]; x[47] -= x[38] * ta[2]; x[47] -= x[39] * ta[3]; }
    { const f32x4 ta = tb2; TS_LD(2, 48, 6) x[47] -= x[40] * ta[0]; x[47] -= x[41] * ta[1]; x[47] -= x[42] * ta[2]; x[47] -= x[43] * ta[3]; }
    { const f32x4 ta = tb3; TS_LD(3, 48, 7) x[47] -= x[44] * ta[0]; x[47] -= x[45] * ta[1]; x[47] -= x[46] * ta[2]; }
    { const f32x4 ta = tb4; TS_LD(4, 48, 8) x[48] -= x[0] * ta[0]; x[48] -= x[1] * ta[1]; x[48] -= x[2] * ta[2]; x[48] -= x[3] * ta[3]; }
    { const f32x4 ta = tb5; TS_LD(5, 48, 9) x[48] -= x[4] * ta[0]; x[48] -= x[5] * ta[1]; x[48] -= x[6] * ta[2]; x[48] -= x[7] * ta[3]; }
    { const f32x4 ta = tb6; TS_LD(6, 48, 10) x[48] -= x[8] * ta[0]; x[48] -= x[9] * ta[1]; x[48] -= x[10] * ta[2]; x[48] -= x[11] * ta[3]; }
    { const f32x4 ta = tb7; TS_LD(7, 48, 11) x[48] -= x[12] * ta[0]; x[48] -= x[13] * ta[1]; x[48] -= x[14] * ta[2]; x[48] -= x[15] * ta[3]; }
    { const f32x4 ta = tb0; TS_LD(0, 49, 0) x[48] -= x[16] * ta[0]; x[48] -= x[17] * ta[1]; x[48] -= x[18] * ta[2]; x[48] -= x[19] * ta[3]; }
    { const f32x4 ta = tb1; TS_LD(1, 49, 1) x[48] -= x[20] * ta[0]; x[48] -= x[21] * ta[1]; x[48] -= x[22] * ta[2]; x[48] -= x[23] * ta[3]; }
    { const f32x4 ta = tb2; TS_LD(2, 49, 2) x[48] -= x[24] * ta[0]; x[48] -= x[25] * ta[1]; x[48] -= x[26] * ta[2]; x[48] -= x[27] * ta[3]; }
    { const f32x4 ta = tb3; TS_LD(3, 49, 3) x[48] -= x[28] * ta[0]; x[48] -= x[29] * ta[1]; x[48] -= x[30] * ta[2]; x[48] -= x[31] * ta[3]; }
    { const f32x4 ta = tb4; TS_LD(4, 49, 4) x[48] -= x[32] * ta[0]; x[48] -= x[33] * ta[1]; x[48] -= x[34] * ta[2]; x[48] -= x[35] * ta[3]; }
    { const f32x4 ta = tb5; TS_LD(5, 49, 5) x[48] -= x[36] * ta[0]; x[48] -= x[37] * ta[1]; x[48] -= x[38] * ta[2]; x[48] -= x[39] * ta[3]; }
    { const f32x4 ta = tb6; TS_LD(6, 49, 6) x[48] -= x[40] * ta[0]; x[48] -= x[41] * ta[1]; x[48] -= x[42] * ta[2]; x[48] -= x[43] * ta[3]; }
    { const f32x4 ta = tb7; TS_LD(7, 49, 7) x[48] -= x[44] * ta[0]; x[48] -= x[45] * ta[1]; x[48] -= x[46] * ta[2]; x[48] -= x[47] * ta[3]; }
    { const f32x4 ta = tb0; TS_LD(0, 49, 8) x[49] -= x[0] * ta[0]; x[49] -= x[1] * ta[1]; x[49] -= x[2] * ta[2]; x[49] -= x[3] * ta[3]; }
    { const f32x4 ta = tb1; TS_LD(1, 49, 9) x[49] -= x[4] * ta[0]; x[49] -= x[5] * ta[1]; x[49] -= x[6] * ta[2]; x[49] -= x[7] * ta[3]; }
    { const f32x4 ta = tb2; TS_LD(2, 49, 10) x[49] -= x[8] * ta[0]; x[49] -= x[9] * ta[1]; x[49] -= x[10] * ta[2]; x[49] -= x[11] * ta[3]; }
    { const f32x4 ta = tb3; TS_LD(3, 49, 11) x[49] -= x[12] * ta[0]; x[49] -= x[13] * ta[1]; x[49] -= x[14] * ta[2]; x[49] -= x[15] * ta[3]; }
    { const f32x4 ta = tb4; TS_LD(4, 49, 12) x[49] -= x[16] * ta[0]; x[49] -= x[17] * ta[1]; x[49] -= x[18] * ta[2]; x[49] -= x[19] * ta[3]; }
    { const f32x4 ta = tb5; TS_LD(5, 50, 0) x[49] -= x[20] * ta[0]; x[49] -= x[21] * ta[1]; x[49] -= x[22] * ta[2]; x[49] -= x[23] * ta[3]; }
    { const f32x4 ta = tb6; TS_LD(6, 50, 1) x[49] -= x[24] * ta[0]; x[49] -= x[25] * ta[1]; x[49] -= x[26] * ta[2]; x[49] -= x[27] * ta[3]; }
    { const f32x4 ta = tb7; TS_LD(7, 50, 2) x[49] -= x[28] * ta[0]; x[49] -= x[29] * ta[1]; x[49] -= x[30] * ta[2]; x[49] -= x[31] * ta[3]; }
    { const f32x4 ta = tb0; TS_LD(0, 50, 3) x[49] -= x[32] * ta[0]; x[49] -= x[33] * ta[1]; x[49] -= x[34] * ta[2]; x[49] -= x[35] * ta[3]; }
    { const f32x4 ta = tb1; TS_LD(1, 50, 4) x[49] -= x[36] * ta[0]; x[49] -= x[37] * ta[1]; x[49] -= x[38] * ta[2]; x[49] -= x[39] * ta[3]; }
    { const f32x4 ta = tb2; TS_LD(2, 50, 5) x[49] -= x[40] * ta[0]; x[49] -= x[41] * ta[1]; x[49] -= x[42] * ta[2]; x[49] -= x[43] * ta[3]; }
    { const f32x4 ta = tb3; TS_LD(3, 50, 6) x[49] -= x[44] * ta[0]; x[49] -= x[45] * ta[1]; x[49] -= x[46] * ta[2]; x[49] -= x[47] * ta[3]; }
    { const f32x4 ta = tb4; TS_LD(4, 50, 7) x[49] -= x[48] * ta[0]; }
    { const f32x4 ta = tb5; TS_LD(5, 50, 8) x[50] -= x[0] * ta[0]; x[50] -= x[1] * ta[1]; x[50] -= x[2] * ta[2]; x[50] -= x[3] * ta[3]; }
    { const f32x4 ta = tb6; TS_LD(6, 50, 9) x[50] -= x[4] * ta[0]; x[50] -= x[5] * ta[1]; x[50] -= x[6] * ta[2]; x[50] -= x[7] * ta[3]; }
    { const f32x4 ta = tb7; TS_LD(7, 50, 10) x[50] -= x[8] * ta[0]; x[50] -= x[9] * ta[1]; x[50] -= x[10] * ta[2]; x[50] -= x[11] * ta[3]; }
    { const f32x4 ta = tb0; TS_LD(0, 50, 11) x[50] -= x[12] * ta[0]; x[50] -= x[13] * ta[1]; x[50] -= x[14] * ta[2]; x[50] -= x[15] * ta[3]; }
    { const f32x4 ta = tb1; TS_LD(1, 50, 12) x[50] -= x[16] * ta[0]; x[50] -= x[17] * ta[1]; x[50] -= x[18] * ta[2]; x[50] -= x[19] * ta[3]; }
    { const f32x4 ta = tb2; TS_LD(2, 51, 0) x[50] -= x[20] * ta[0]; x[50] -= x[21] * ta[1]; x[50] -= x[22] * ta[2]; x[50] -= x[23] * ta[3]; }
    { const f32x4 ta = tb3; TS_LD(3, 51, 1) x[50] -= x[24] * ta[0]; x[50] -= x[25] * ta[1]; x[50] -= x[26] * ta[2]; x[50] -= x[27] * ta[3]; }
    { const f32x4 ta = tb4; TS_LD(4, 51, 2) x[50] -= x[28] * ta[0]; x[50] -= x[29] * ta[1]; x[50] -= x[30] * ta[2]; x[50] -= x[31] * ta[3]; }
    { const f32x4 ta = tb5; TS_LD(5, 51, 3) x[50] -= x[32] * ta[0]; x[50] -= x[33] * ta[1]; x[50] -= x[34] * ta[2]; x[50] -= x[35] * ta[3]; }
    { const f32x4 ta = tb6; TS_LD(6, 51, 4) x[50] -= x[36] * ta[0]; x[50] -= x[37] * ta[1]; x[50] -= x[38] * ta[2]; x[50] -= x[39] * ta[3]; }
    { const f32x4 ta = tb7; TS_LD(7, 51, 5) x[50] -= x[40] * ta[0]; x[50] -= x[41] * ta[1]; x[50] -= x[42] * ta[2]; x[50] -= x[43] * ta[3]; }
    { const f32x4 ta = tb0; TS_LD(0, 51, 6) x[50] -= x[44] * ta[0]; x[50] -= x[45] * ta[1]; x[50] -= x[46] * ta[2]; x[50] -= x[47] * ta[3]; }
    { const f32x4 ta = tb1; TS_LD(1, 51, 7) x[50] -= x[48] * ta[0]; x[50] -= x[49] * ta[1]; }
    { const f32x4 ta = tb2; TS_LD(2, 51, 8) x[51] -= x[0] * ta[0]; x[51] -= x[1] * ta[1]; x[51] -= x[2] * ta[2]; x[51] -= x[3] * ta[3]; }
    { const f32x4 ta = tb3; TS_LD(3, 51, 9) x[51] -= x[4] * ta[0]; x[51] -= x[5] * ta[1]; x[51] -= x[6] * ta[2]; x[51] -= x[7] * ta[3]; }
    { const f32x4 ta = tb4; TS_LD(4, 51, 10) x[51] -= x[8] * ta[0]; x[51] -= x[9] * ta[1]; x[51] -= x[10] * ta[2]; x[51] -= x[11] * ta[3]; }
    { const f32x4 ta = tb5; TS_LD(5, 51, 11) x[51] -= x[12] * ta[0]; x[51] -= x[13] * ta[1]; x[51] -= x[14] * ta[2]; x[51] -= x[15] * ta[3]; }
    { const f32x4 ta = tb6; TS_LD(6, 51, 12) x[51] -= x[16] * ta[0]; x[51] -= x[17] * ta[1]; x[51] -= x[18] * ta[2]; x[51] -= x[19] * ta[3]; }
    { const f32x4 ta = tb7; TS_LD(7, 52, 0) x[51] -= x[20] * ta[0]; x[51] -= x[21] * ta[1]; x[51] -= x[22] * ta[2]; x[51] -= x[23] * ta[3]; }
    { const f32x4 ta = tb0; TS_LD(0, 52, 1) x[51] -= x[24] * ta[0]; x[51] -= x[25] * ta[1]; x[51] -= x[26] * ta[2]; x[51] -= x[27] * ta[3]; }
    { const f32x4 ta = tb1; TS_LD(1, 52, 2) x[51] -= x[28] * ta[0]; x[51] -= x[29] * ta[1]; x[51] -= x[30] * ta[2]; x[51] -= x[31] * ta[3]; }
    { const f32x4 ta = tb2; TS_LD(2, 52, 3) x[51] -= x[32] * ta[0]; x[51] -= x[33] * ta[1]; x[51] -= x[34] * ta[2]; x[51] -= x[35] * ta[3]; }
    { const f32x4 ta = tb3; TS_LD(3, 52, 4) x[51] -= x[36] * ta[0]; x[51] -= x[37] * ta[1]; x[51] -= x[38] * ta[2]; x[51] -= x[39] * ta[3]; }
    { const f32x4 ta = tb4; TS_LD(4, 52, 5) x[51] -= x[40] * ta[0]; x[51] -= x[41] * ta[1]; x[51] -= x[42] * ta[2]; x[51] -= x[43] * ta[3]; }
    { const f32x4 ta = tb5; TS_LD(5, 52, 6) x[51] -= x[44] * ta[0]; x[51] -= x[45] * ta[1]; x[51] -= x[46] * ta[2]; x[51] -= x[47] * ta[3]; }
    { const f32x4 ta = tb6; TS_LD(6, 52, 7) x[51] -= x[48] * ta[0]; x[51] -= x[49] * ta[1]; x[51] -= x[50] * ta[2]; }
    { const f32x4 ta = tb7; TS_LD(7, 52, 8) x[52] -= x[0] * ta[0]; x[52] -= x[1] * ta[1]; x[52] -= x[2] * ta[2]; x[52] -= x[3] * ta[3]; }
    { const f32x4 ta = tb0; TS_LD(0, 52, 9) x[52] -= x[4] * ta[0]; x[52] -= x[5] * ta[1]; x[52] -= x[6] * ta[2]; x[52] -= x[7] * ta[3]; }
    { const f32x4 ta = tb1; TS_LD(1, 52, 10) x[52] -= x[8] * ta[0]; x[52] -= x[9] * ta[1]; x[52] -= x[10] * ta[2]; x[52] -= x[11] * ta[3]; }
    { const f32x4 ta = tb2; TS_LD(2, 52, 11) x[52] -= x[12] * ta[0]; x[52] -= x[13] * ta[1]; x[52] -= x[14] * ta[2]; x[52] -= x[15] * ta[3]; }
    { const f32x4 ta = tb3; TS_LD(3, 52, 12) x[52] -= x[16] * ta[0]; x[52] -= x[17] * ta[1]; x[52] -= x[18] * ta[2]; x[52] -= x[19] * ta[3]; }
    { const f32x4 ta = tb4; TS_LD(4, 53, 0) x[52] -= x[20] * ta[0]; x[52] -= x[21] * ta[1]; x[52] -= x[22] * ta[2]; x[52] -= x[23] * ta[3]; }
    { const f32x4 ta = tb5; TS_LD(5, 53, 1) x[52] -= x[24] * ta[0]; x[52] -= x[25] * ta[1]; x[52] -= x[26] * ta[2]; x[52] -= x[27] * ta[3]; }
    { const f32x4 ta = tb6; TS_LD(6, 53, 2) x[52] -= x[28] * ta[0]; x[52] -= x[29] * ta[1]; x[52] -= x[30] * ta[2]; x[52] -= x[31] * ta[3]; }
    { const f32x4 ta = tb7; TS_LD(7, 53, 3) x[52] -= x[32] * ta[0]; x[52] -= x[33] * ta[1]; x[52] -= x[34] * ta[2]; x[52] -= x[35] * ta[3]; }
    { const f32x4 ta = tb0; TS_LD(0, 53, 4) x[52] -= x[36] * ta[0]; x[52] -= x[37] * ta[1]; x[52] -= x[38] * ta[2]; x[52] -= x[39] * ta[3]; }
    { const f32x4 ta = tb1; TS_LD(1, 53, 5) x[52] -= x[40] * ta[0]; x[52] -= x[41] * ta[1]; x[52] -= x[42] * ta[2]; x[52] -= x[43] * ta[3]; }
    { const f32x4 ta = tb2; TS_LD(2, 53, 6) x[52] -= x[44] * ta[0]; x[52] -= x[45] * ta[1]; x[52] -= x[46] * ta[2]; x[52] -= x[47] * ta[3]; }
    { const f32x4 ta = tb3; TS_LD(3, 53, 7) x[52] -= x[48] * ta[0]; x[52] -= x[49] * ta[1]; x[52] -= x[50] * ta[2]; x[52] -= x[51] * ta[3]; }
    { const f32x4 ta = tb4; TS_LD(4, 53, 8) x[53] -= x[0] * ta[0]; x[53] -= x[1] * ta[1]; x[53] -= x[2] * ta[2]; x[53] -= x[3] * ta[3]; }
    { const f32x4 ta = tb5; TS_LD(5, 53, 9) x[53] -= x[4] * ta[0]; x[53] -= x[5] * ta[1]; x[53] -= x[6] * ta[2]; x[53] -= x[7] * ta[3]; }
    { const f32x4 ta = tb6; TS_LD(6, 53, 10) x[53] -= x[8] * ta[0]; x[53] -= x[9] * ta[1]; x[53] -= x[10] * ta[2]; x[53] -= x[11] * ta[3]; }
    { const f32x4 ta = tb7; TS_LD(7, 53, 11) x[53] -= x[12] * ta[0]; x[53] -= x[13] * ta[1]; x[53] -= x[14] * ta[2]; x[53] -= x[15] * ta[3]; }
    { const f32x4 ta = tb0; TS_LD(0, 53, 12) x[53] -= x[16] * ta[0]; x[53] -= x[17] * ta[1]; x[53] -= x[18] * ta[2]; x[53] -= x[19] * ta[3]; }
    { const f32x4 ta = tb1; TS_LD(1, 53, 13) x[53] -= x[20] * ta[0]; x[53] -= x[21] * ta[1]; x[53] -= x[22] * ta[2]; x[53] -= x[23] * ta[3]; }
    { const f32x4 ta = tb2; TS_LD(2, 54, 0) x[53] -= x[24] * ta[0]; x[53] -= x[25] * ta[1]; x[53] -= x[26] * ta[2]; x[53] -= x[27] * ta[3]; }
    { const f32x4 ta = tb3; TS_LD(3, 54, 1) x[53] -= x[28] * ta[0]; x[53] -= x[29] * ta[1]; x[53] -= x[30] * ta[2]; x[53] -= x[31] * ta[3]; }
    { const f32x4 ta = tb4; TS_LD(4, 54, 2) x[53] -= x[32] * ta[0]; x[53] -= x[33] * ta[1]; x[53] -= x[34] * ta[2]; x[53] -= x[35] * ta[3]; }
    { const f32x4 ta = tb5; TS_LD(5, 54, 3) x[53] -= x[36] * ta[0]; x[53] -= x[37] * ta[1]; x[53] -= x[38] * ta[2]; x[53] -= x[39] * ta[3]; }
    { const f32x4 ta = tb6; TS_LD(6, 54, 4) x[53] -= x[40] * ta[0]; x[53] -= x[41] * ta[1]; x[53] -= x[42] * ta[2]; x[53] -= x[43] * ta[3]; }
    { const f32x4 ta = tb7; TS_LD(7, 54, 5) x[53] -= x[44] * ta[0]; x[53] -= x[45] * ta[1]; x[53] -= x[46] * ta[2]; x[53] -= x[47] * ta[3]; }
    { const f32x4 ta = tb0; TS_LD(0, 54, 6) x[53] -= x[48] * ta[0]; x[53] -= x[49] * ta[1]; x[53] -= x[50] * ta[2]; x[53] -= x[51] * ta[3]; }
    { const f32x4 ta = tb1; TS_LD(1, 54, 7) x[53] -= x[52] * ta[0]; }
    { const f32x4 ta = tb2; TS_LD(2, 54, 8) x[54] -= x[0] * ta[0]; x[54] -= x[1] * ta[1]; x[54] -= x[2] * ta[2]; x[54] -= x[3] * ta[3]; }
    { const f32x4 ta = tb3; TS_LD(3, 54, 9) x[54] -= x[4] * ta[0]; x[54] -= x[5] * ta[1]; x[54] -= x[6] * ta[2]; x[54] -= x[7] * ta[3]; }
    { const f32x4 ta = tb4; TS_LD(4, 54, 10) x[54] -= x[8] * ta[0]; x[54] -= x[9] * ta[1]; x[54] -= x[10] * ta[2]; x[54] -= x[11] * ta[3]; }
    { const f32x4 ta = tb5; TS_LD(5, 54, 11) x[54] -= x[12] * ta[0]; x[54] -= x[13] * ta[1]; x[54] -= x[14] * ta[2]; x[54] -= x[15] * ta[3]; }
    { const f32x4 ta = tb6; TS_LD(6, 54, 12) x[54] -= x[16] * ta[0]; x[54] -= x[17] * ta[1]; x[54] -= x[18] * ta[2]; x[54] -= x[19] * ta[3]; }
    { const f32x4 ta = tb7; TS_LD(7, 54, 13) x[54] -= x[20] * ta[0]; x[54] -= x[21] * ta[1]; x[54] -= x[22] * ta[2]; x[54] -= x[23] * ta[3]; }
    { const f32x4 ta = tb0; TS_LD(0, 55, 0) x[54] -= x[24] * ta[0]; x[54] -= x[25] * ta[1]; x[54] -= x[26] * ta[2]; x[54] -= x[27] * ta[3]; }
    { const f32x4 ta = tb1; TS_LD(1, 55, 1) x[54] -= x[28] * ta[0]; x[54] -= x[29] * ta[1]; x[54] -= x[30] * ta[2]; x[54] -= x[31] * ta[3]; }
    { const f32x4 ta = tb2; TS_LD(2, 55, 2) x[54] -= x[32] * ta[0]; x[54] -= x[33] * ta[1]; x[54] -= x[34] * ta[2]; x[54] -= x[35] * ta[3]; }
    { const f32x4 ta = tb3; TS_LD(3, 55, 3) x[54] -= x[36] * ta[0]; x[54] -= x[37] * ta[1]; x[54] -= x[38] * ta[2]; x[54] -= x[39] * ta[3]; }
    { const f32x4 ta = tb4; TS_LD(4, 55, 4) x[54] -= x[40] * ta[0]; x[54] -= x[41] * ta[1]; x[54] -= x[42] * ta[2]; x[54] -= x[43] * ta[3]; }
    { const f32x4 ta = tb5; TS_LD(5, 55, 5) x[54] -= x[44] * ta[0]; x[54] -= x[45] * ta[1]; x[54] -= x[46] * ta[2]; x[54] -= x[47] * ta[3]; }
    { const f32x4 ta = tb6; TS_LD(6, 55, 6) x[54] -= x[48] * ta[0]; x[54] -= x[49] * ta[1]; x[54] -= x[50] * ta[2]; x[54] -= x[51] * ta[3]; }
    { const f32x4 ta = tb7; TS_LD(7, 55, 7) x[54] -= x[52] * ta[0]; x[54] -= x[53] * ta[1]; }
    { const f32x4 ta = tb0; TS_LD(0, 55, 8) x[55] -= x[0] * ta[0]; x[55] -= x[1] * ta[1]; x[55] -= x[2] * ta[2]; x[55] -= x[3] * ta[3]; }
    { const f32x4 ta = tb1; TS_LD(1, 55, 9) x[55] -= x[4] * ta[0]; x[55] -= x[5] * ta[1]; x[55] -= x[6] * ta[2]; x[55] -= x[7] * ta[3]; }
    { const f32x4 ta = tb2; TS_LD(2, 55, 10) x[55] -= x[8] * ta[0]; x[55] -= x[9] * ta[1]; x[55] -= x[10] * ta[2]; x[55] -= x[11] * ta[3]; }
    { const f32x4 ta = tb3; TS_LD(3, 55, 11) x[55] -= x[12] * ta[0]; x[55] -= x[13] * ta[1]; x[55] -= x[14] * ta[2]; x[55] -= x[15] * ta[3]; }
    { const f32x4 ta = tb4; TS_LD(4, 55, 12) x[55] -= x[16] * ta[0]; x[55] -= x[17] * ta[1]; x[55] -= x[18] * ta[2]; x[55] -= x[19] * ta[3]; }
    { const f32x4 ta = tb5; TS_LD(5, 55, 13) x[55] -= x[20] * ta[0]; x[55] -= x[21] * ta[1]; x[55] -= x[22] * ta[2]; x[55] -= x[23] * ta[3]; }
    { const f32x4 ta = tb6; TS_LD(6, 56, 0) x[55] -= x[24] * ta[0]; x[55] -= x[25] * ta[1]; x[55] -= x[26] * ta[2]; x[55] -= x[27] * ta[3]; }
    { const f32x4 ta = tb7; TS_LD(7, 56, 1) x[55] -= x[28] * ta[0]; x[55] -= x[29] * ta[1]; x[55] -= x[30] * ta[2]; x[55] -= x[31] * ta[3]; }
    { const f32x4 ta = tb0; TS_LD(0, 56, 2) x[55] -= x[32] * ta[0]; x[55] -= x[33] * ta[1]; x[55] -= x[34] * ta[2]; x[55] -= x[35] * ta[3]; }
    { const f32x4 ta = tb1; TS_LD(1, 56, 3) x[55] -= x[36] * ta[0]; x[55] -= x[37] * ta[1]; x[55] -= x[38] * ta[2]; x[55] -= x[39] * ta[3]; }
    { const f32x4 ta = tb2; TS_LD(2, 56, 4) x[55] -= x[40] * ta[0]; x[55] -= x[41] * ta[1]; x[55] -= x[42] * ta[2]; x[55] -= x[43] * ta[3]; }
    { const f32x4 ta = tb3; TS_LD(3, 56, 5) x[55] -= x[44] * ta[0]; x[55] -= x[45] * ta[1]; x[55] -= x[46] * ta[2]; x[55] -= x[47] * ta[3]; }
    { const f32x4 ta = tb4; TS_LD(4, 56, 6) x[55] -= x[48] * ta[0]; x[55] -= x[49] * ta[1]; x[55] -= x[50] * ta[2]; x[55] -= x[51] * ta[3]; }
    { const f32x4 ta = tb5; TS_LD(5, 56, 7) x[55] -= x[52] * ta[0]; x[55] -= x[53] * ta[1]; x[55] -= x[54] * ta[2]; }
    { const f32x4 ta = tb6; TS_LD(6, 56, 8) x[56] -= x[0] * ta[0]; x[56] -= x[1] * ta[1]; x[56] -= x[2] * ta[2]; x[56] -= x[3] * ta[3]; }
    { const f32x4 ta = tb7; TS_LD(7, 56, 9) x[56] -= x[4] * ta[0]; x[56] -= x[5] * ta[1]; x[56] -= x[6] * ta[2]; x[56] -= x[7] * ta[3]; }
    { const f32x4 ta = tb0; TS_LD(0, 56, 10) x[56] -= x[8] * ta[0]; x[56] -= x[9] * ta[1]; x[56] -= x[10] * ta[2]; x[56] -= x[11] * ta[3]; }
    { const f32x4 ta = tb1; TS_LD(1, 56, 11) x[56] -= x[12] * ta[0]; x[56] -= x[13] * ta[1]; x[56] -= x[14] * ta[2]; x[56] -= x[15] * ta[3]; }
    { const f32x4 ta = tb2; TS_LD(2, 56, 12) x[56] -= x[16] * ta[0]; x[56] -= x[17] * ta[1]; x[56] -= x[18] * ta[2]; x[56] -= x[19] * ta[3]; }
    { const f32x4 ta = tb3; TS_LD(3, 56, 13) x[56] -= x[20] * ta[0]; x[56] -= x[21] * ta[1]; x[56] -= x[22] * ta[2]; x[56] -= x[23] * ta[3]; }
    { const f32x4 ta = tb4; TS_LD(4, 57, 0) x[56] -= x[24] * ta[0]; x[56] -= x[25] * ta[1]; x[56] -= x[26] * ta[2]; x[56] -= x[27] * ta[3]; }
    { const f32x4 ta = tb5; TS_LD(5, 57, 1) x[56] -= x[28] * ta[0]; x[56] -= x[29] * ta[1]; x[56] -= x[30] * ta[2]; x[56] -= x[31] * ta[3]; }
    { const f32x4 ta = tb6; TS_LD(6, 57, 2) x[56] -= x[32] * ta[0]; x[56] -= x[33] * ta[1]; x[56] -= x[34] * ta[2]; x[56] -= x[35] * ta[3]; }
    { const f32x4 ta = tb7; TS_LD(7, 57, 3) x[56] -= x[36] * ta[0]; x[56] -= x[37] * ta[1]; x[56] -= x[38] * ta[2]; x[56] -= x[39] * ta[3]; }
    { const f32x4 ta = tb0; TS_LD(0, 57, 4) x[56] -= x[40] * ta[0]; x[56] -= x[41] * ta[1]; x[56] -= x[42] * ta[2]; x[56] -= x[43] * ta[3]; }
    { const f32x4 ta = tb1; TS_LD(1, 57, 5) x[56] -= x[44] * ta[0]; x[56] -= x[45] * ta[1]; x[56] -= x[46] * ta[2]; x[56] -= x[47] * ta[3]; }
    { const f32x4 ta = tb2; TS_LD(2, 57, 6) x[56] -= x[48] * ta[0]; x[56] -= x[49] * ta[1]; x[56] -= x[50] * ta[2]; x[56] -= x[51] * ta[3]; }
    { const f32x4 ta = tb3; TS_LD(3, 57, 7) x[56] -= x[52] * ta[0]; x[56] -= x[53] * ta[1]; x[56] -= x[54] * ta[2]; x[56] -= x[55] * ta[3]; }
    { const f32x4 ta = tb4; TS_LD(4, 57, 8) x[57] -= x[0] * ta[0]; x[57] -= x[1] * ta[1]; x[57] -= x[2] * ta[2]; x[57] -= x[3] * ta[3]; }
    { const f32x4 ta = tb5; TS_LD(5, 57, 9) x[57] -= x[4] * ta[0]; x[57] -= x[5] * ta[1]; x[57] -= x[6] * ta[2]; x[57] -= x[7] * ta[3]; }
    { const f32x4 ta = tb6; TS_LD(6, 57, 10) x[57] -= x[8] * ta[0]; x[57] -= x[9] * ta[1]; x[57] -= x[10] * ta[2]; x[57] -= x[11] * ta[3]; }
    { const f32x4 ta = tb7; TS_LD(7, 57, 11) x[57] -= x[12] * ta[0]; x[57] -= x[13] * ta[1]; x[57] -= x[14] * ta[2]; x[57] -= x[15] * ta[3]; }
    { const f32x4 ta = tb0; TS_LD(0, 57, 12) x[57] -= x[16] * ta[0]; x[57] -= x[17] * ta[1]; x[57] -= x[18] * ta[2]; x[57] -= x[19] * ta[3]; }
    { const f32x4 ta = tb1; TS_LD(1, 57, 13) x[57] -= x[20] * ta[0]; x[57] -= x[21] * ta[1]; x[57] -= x[22] * ta[2]; x[57] -= x[23] * ta[3]; }
    { const f32x4 ta = tb2; TS_LD(2, 57, 14) x[57] -= x[24] * ta[0]; x[57] -= x[25] * ta[1]; x[57] -= x[26] * ta[2]; x[57] -= x[27] * ta[3]; }
    { const f32x4 ta = tb3; TS_LD(3, 58, 0) x[57] -= x[28] * ta[0]; x[57] -= x[29] * ta[1]; x[57] -= x[30] * ta[2]; x[57] -= x[31] * ta[3]; }
    { const f32x4 ta = tb4; TS_LD(4, 58, 1) x[57] -= x[32] * ta[0]; x[57] -= x[33] * ta[1]; x[57] -= x[34] * ta[2]; x[57] -= x[35] * ta[3]; }
    { const f32x4 ta = tb5; TS_LD(5, 58, 2) x[57] -= x[36] * ta[0]; x[57] -= x[37] * ta[1]; x[57] -= x[38] * ta[2]; x[57] -= x[39] * ta[3]; }
    { const f32x4 ta = tb6; TS_LD(6, 58, 3) x[57] -= x[40] * ta[0]; x[57] -= x[41] * ta[1]; x[57] -= x[42] * ta[2]; x[57] -= x[43] * ta[3]; }
    { const f32x4 ta = tb7; TS_LD(7, 58, 4) x[57] -= x[44] * ta[0]; x[57] -= x[45] * ta[1]; x[57] -= x[46] * ta[2]; x[57] -= x[47] * ta[3]; }
    { const f32x4 ta = tb0; TS_LD(0, 58, 5) x[57] -= x[48] * ta[0]; x[57] -= x[49] * ta[1]; x[57] -= x[50] * ta[2]; x[57] -= x[51] * ta[3]; }
    { const f32x4 ta = tb1; TS_LD(1, 58, 6) x[57] -= x[52] * ta[0]; x[57] -= x[53] * ta[1]; x[57] -= x[54] * ta[2]; x[57] -= x[55] * ta[3]; }
    { const f32x4 ta = tb2; TS_LD(2, 58, 7) x[57] -= x[56] * ta[0]; }
    { const f32x4 ta = tb3; TS_LD(3, 58, 8) x[58] -= x[0] * ta[0]; x[58] -= x[1] * ta[1]; x[58] -= x[2] * ta[2]; x[58] -= x[3] * ta[3]; }
    { const f32x4 ta = tb4; TS_LD(4, 58, 9) x[58] -= x[4] * ta[0]; x[58] -= x[5] * ta[1]; x[58] -= x[6] * ta[2]; x[58] -= x[7] * ta[3]; }
    { const f32x4 ta = tb5; TS_LD(5, 58, 10) x[58] -= x[8] * ta[0]; x[58] -= x[9] * ta[1]; x[58] -= x[10] * ta[2]; x[58] -= x[11] * ta[3]; }
    { const f32x4 ta = tb6; TS_LD(6, 58, 11) x[58] -= x[12] * ta[0]; x[58] -= x[13] * ta[1]; x[58] -= x[14] * ta[2]; x[58] -= x[15] * ta[3]; }
    { const f32x4 ta = tb7; TS_LD(7, 58, 12) x[58] -= x[16] * ta[0]; x[58] -= x[17] * ta[1]; x[58] -= x[18] * ta[2]; x[58] -= x[19] * ta[3]; }
    { const f32x4 ta = tb0; TS_LD(0, 58, 13) x[58] -= x[20] * ta[0]; x[58] -= x[21] * ta[1]; x[58] -= x[22] * ta[2]; x[58] -= x[23] * ta[3]; }
    { const f32x4 ta = tb1; TS_LD(1, 58, 14) x[58] -= x[24] * ta[0]; x[58] -= x[25] * ta[1]; x[58] -= x[26] * ta[2]; x[58] -= x[27] * ta[3]; }
    { const f32x4 ta = tb2; TS_LD(2, 59, 0) x[58] -= x[28] * ta[0]; x[58] -= x[29] * ta[1]; x[58] -= x[30] * ta[2]; x[58] -= x[31] * ta[3]; }
    { const f32x4 ta = tb3; TS_LD(3, 59, 1) x[58] -= x[32] * ta[0]; x[58] -= x[33] * ta[1]; x[58] -= x[34] * ta[2]; x[58] -= x[35] * ta[3]; }
    { const f32x4 ta = tb4; TS_LD(4, 59, 2) x[58] -= x[36] * ta[0]; x[58] -= x[37] * ta[1]; x[58] -= x[38] * ta[2]; x[58] -= x[39] * ta[3]; }
    { const f32x4 ta = tb5; TS_LD(5, 59, 3) x[58] -= x[40] * ta[0]; x[58] -= x[41] * ta[1]; x[58] -= x[42] * ta[2]; x[58] -= x[43] * ta[3]; }
    { const f32x4 ta = tb6; TS_LD(6, 59, 4) x[58] -= x[44] * ta[0]; x[58] -= x[45] * ta[1]; x[58] -= x[46] * ta[2]; x[58] -= x[47] * ta[3]; }
    { const f32x4 ta = tb7; TS_LD(7, 59, 5) x[58] -= x[48] * ta[0]; x[58] -= x[49] * ta[1]; x[58] -= x[50] * ta[2]; x[58] -= x[51] * ta[3]; }
    { const f32x4 ta = tb0; TS_LD(0, 59, 6) x[58] -= x[52] * ta[0]; x[58] -= x[53] * ta[1]; x[58] -= x[54] * ta[2]; x[58] -= x[55] * ta[3]; }
    { const f32x4 ta = tb1; TS_LD(1, 59, 7) x[58] -= x[56] * ta[0]; x[58] -= x[57] * ta[1]; }
    { const f32x4 ta = tb2; TS_LD(2, 59, 8) x[59] -= x[0] * ta[0]; x[59] -= x[1] * ta[1]; x[59] -= x[2] * ta[2]; x[59] -= x[3] * ta[3]; }
    { const f32x4 ta = tb3; TS_LD(3, 59, 9) x[59] -= x[4] * ta[0]; x[59] -= x[5] * ta[1]; x[59] -= x[6] * ta[2]; x[59] -= x[7] * ta[3]; }
    { const f32x4 ta = tb4; TS_LD(4, 59, 10) x[59] -= x[8] * ta[0]; x[59] -= x[9] * ta[1]; x[59] -= x[10] * ta[2]; x[59] -= x[11] * ta[3]; }
    { const f32x4 ta = tb5; TS_LD(5, 59, 11) x[59] -= x[12] * ta[0]; x[59] -= x[13] * ta[1]; x[59] -= x[14] * ta[2]; x[59] -= x[15] * ta[3]; }
    { const f32x4 ta = tb6; TS_LD(6, 59, 12) x[59] -= x[16] * ta[0]; x[59] -= x[17] * ta[1]; x[59] -= x[18] * ta[2]; x[59] -= x[19] * ta[3]; }
    { const f32x4 ta = tb7; TS_LD(7, 59, 13) x[59] -= x[20] * ta[0]; x[59] -= x[21] * ta[1]; x[59] -= x[22] * ta[2]; x[59] -= x[23] * ta[3]; }
    { const f32x4 ta = tb0; TS_LD(0, 59, 14) x[59] -= x[24] * ta[0]; x[59] -= x[25] * ta[1]; x[59] -= x[26] * ta[2]; x[59] -= x[27] * ta[3]; }
    { const f32x4 ta = tb1; TS_LD(1, 60, 0) x[59] -= x[28] * ta[0]; x[59] -= x[29] * ta[1]; x[59] -= x[30] * ta[2]; x[59] -= x[31] * ta[3]; }
    { const f32x4 ta = tb2; TS_LD(2, 60, 1) x[59] -= x[32] * ta[0]; x[59] -= x[33] * ta[1]; x[59] -= x[34] * ta[2]; x[59] -= x[35] * ta[3]; }
    { const f32x4 ta = tb3; TS_LD(3, 60, 2) x[59] -= x[36] * ta[0]; x[59] -= x[37] * ta[1]; x[59] -= x[38] * ta[2]; x[59] -= x[39] * ta[3]; }
    { const f32x4 ta = tb4; TS_LD(4, 60, 3) x[59] -= x[40] * ta[0]; x[59] -= x[41] * ta[1]; x[59] -= x[42] * ta[2]; x[59] -= x[43] * ta[3]; }
    { const f32x4 ta = tb5; TS_LD(5, 60, 4) x[59] -= x[44] * ta[0]; x[59] -= x[45] * ta[1]; x[59] -= x[46] * ta[2]; x[59] -= x[47] * ta[3]; }
    { const f32x4 ta = tb6; TS_LD(6, 60, 5) x[59] -= x[48] * ta[0]; x[59] -= x[49] * ta[1]; x[59] -= x[50] * ta[2]; x[59] -= x[51] * ta[3]; }
    { const f32x4 ta = tb7; TS_LD(7, 60, 6) x[59] -= x[52] * ta[0]; x[59] -= x[53] * ta[1]; x[59] -= x[54] * ta[2]; x[59] -= x[55] * ta[3]; }
    { const f32x4 ta = tb0; TS_LD(0, 60, 7) x[59] -= x[56] * ta[0]; x[59] -= x[57] * ta[1]; x[59] -= x[58] * ta[2]; }
    { const f32x4 ta = tb1; TS_LD(1, 60, 8) x[60] -= x[0] * ta[0]; x[60] -= x[1] * ta[1]; x[60] -= x[2] * ta[2]; x[60] -= x[3] * ta[3]; }
    { const f32x4 ta = tb2; TS_LD(2, 60, 9) x[60] -= x[4] * ta[0]; x[60] -= x[5] * ta[1]; x[60] -= x[6] * ta[2]; x[60] -= x[7] * ta[3]; }
    { const f32x4 ta = tb3; TS_LD(3, 60, 10) x[60] -= x[8] * ta[0]; x[60] -= x[9] * ta[1]; x[60] -= x[10] * ta[2]; x[60] -= x[11] * ta[3]; }
    { const f32x4 ta = tb4; TS_LD(4, 60, 11) x[60] -= x[12] * ta[0]; x[60] -= x[13] * ta[1]; x[60] -= x[14] * ta[2]; x[60] -= x[15] * ta[3]; }
    { const f32x4 ta = tb5; TS_LD(5, 60, 12) x[60] -= x[16] * ta[0]; x[60] -= x[17] * ta[1]; x[60] -= x[18] * ta[2]; x[60] -= x[19] * ta[3]; }
    { const f32x4 ta = tb6; TS_LD(6, 60, 13) x[60] -= x[20] * ta[0]; x[60] -= x[21] * ta[1]; x[60] -= x[22] * ta[2]; x[60] -= x[23] * ta[3]; }
    { const f32x4 ta = tb7; TS_LD(7, 60, 14) x[60] -= x[24] * ta[0]; x[60] -= x[25] * ta[1]; x[60] -= x[26] * ta[2]; x[60] -= x[27] * ta[3]; }
    { const f32x4 ta = tb0; TS_LD(0, 61, 0) x[60] -= x[28] * ta[0]; x[60] -= x[29] * ta[1]; x[60] -= x[30] * ta[2]; x[60] -= x[31] * ta[3]; }
    { const f32x4 ta = tb1; TS_LD(1, 61, 1) x[60] -= x[32] * ta[0]; x[60] -= x[33] * ta[1]; x[60] -= x[34] * ta[2]; x[60] -= x[35] * ta[3]; }
    { const f32x4 ta = tb2; TS_LD(2, 61, 2) x[60] -= x[36] * ta[0]; x[60] -= x[37] * ta[1]; x[60] -= x[38] * ta[2]; x[60] -= x[39] * ta[3]; }
    { const f32x4 ta = tb3; TS_LD(3, 61, 3) x[60] -= x[40] * ta[0]; x[60] -= x[41] * ta[1]; x[60] -= x[42] * ta[2]; x[60] -= x[43] * ta[3]; }
    { const f32x4 ta = tb4; TS_LD(4, 61, 4) x[60] -= x[44] * ta[0]; x[60] -= x[45] * ta[1]; x[60] -= x[46] * ta[2]; x[60] -= x[47] * ta[3]; }
    { const f32x4 ta = tb5; TS_LD(5, 61, 5) x[60] -= x[48] * ta[0]; x[60] -= x[49] * ta[1]; x[60] -= x[50] * ta[2]; x[60] -= x[51] * ta[3]; }
    { const f32x4 ta = tb6; TS_LD(6, 61, 6) x[60] -= x[52] * ta[0]; x[60] -= x[53] * ta[1]; x[60] -= x[54] * ta[2]; x[60] -= x[55] * ta[3]; }
    { const f32x4 ta = tb7; TS_LD(7, 61, 7) x[60] -= x[56] * ta[0]; x[60] -= x[57] * ta[1]; x[60] -= x[58] * ta[2]; x[60] -= x[59] * ta[3]; }
    { const f32x4 ta = tb0; TS_LD(0, 61, 8) x[61] -= x[0] * ta[0]; x[61] -= x[1] * ta[1]; x[61] -= x[2] * ta[2]; x[61] -= x[3] * ta[3]; }
    { const f32x4 ta = tb1; TS_LD(1, 61, 9) x[61] -= x[4] * ta[0]; x[61] -= x[5] * ta[1]; x[61] -= x[6] * ta[2]; x[61] -= x[7] * ta[3]; }
    { const f32x4 ta = tb2; TS_LD(2, 61, 10) x[61] -= x[8] * ta[0]; x[61] -= x[9] * ta[1]; x[61] -= x[10] * ta[2]; x[61] -= x[11] * ta[3]; }
    { const f32x4 ta = tb3; TS_LD(3, 61, 11) x[61] -= x[12] * ta[0]; x[61] -= x[13] * ta[1]; x[61] -= x[14] * ta[2]; x[61] -= x[15] * ta[3]; }
    { const f32x4 ta = tb4; TS_LD(4, 61, 12) x[61] -= x[16] * ta[0]; x[61] -= x[17] * ta[1]; x[61] -= x[18] * ta[2]; x[61] -= x[19] * ta[3]; }
    { const f32x4 ta = tb5; TS_LD(5, 61, 13) x[61] -= x[20] * ta[0]; x[61] -= x[21] * ta[1]; x[61] -= x[22] * ta[2]; x[61] -= x[23] * ta[3]; }
    { const f32x4 ta = tb6; TS_LD(6, 61, 14) x[61] -= x[24] * ta[0]; x[61] -= x[25] * ta[1]; x[61] -= x[26] * ta[2]; x[61] -= x[27] * ta[3]; }
    { const f32x4 ta = tb7; TS_LD(7, 61, 15) x[61] -= x[28] * ta[0]; x[61] -= x[29] * ta[1]; x[61] -= x[30] * ta[2]; x[61] -= x[31] * ta[3]; }
    { const f32x4 ta = tb0; TS_LD(0, 62, 0) x[61] -= x[32] * ta[0]; x[61] -= x[33] * ta[1]; x[61] -= x[34] * ta[2]; x[61] -= x[35] * ta[3]; }
    { const f32x4 ta = tb1; TS_LD(1, 62, 1) x[61] -= x[36] * ta[0]; x[61] -= x[37] * ta[1]; x[61] -= x[38] * ta[2]; x[61] -= x[39] * ta[3]; }
    { const f32x4 ta = tb2; TS_LD(2, 62, 2) x[61] -= x[40] * ta[0]; x[61] -= x[41] * ta[1]; x[61] -= x[42] * ta[2]; x[61] -= x[43] * ta[3]; }
    { const f32x4 ta = tb3; TS_LD(3, 62, 3) x[61] -= x[44] * ta[0]; x[61] -= x[45] * ta[1]; x[61] -= x[46] * ta[2]; x[61] -= x[47] * ta[3]; }
    { const f32x4 ta = tb4; TS_LD(4, 62, 4) x[61] -= x[48] * ta[0]; x[61] -= x[49] * ta[1]; x[61] -= x[50] * ta[2]; x[61] -= x[51] * ta[3]; }
    { const f32x4 ta = tb5; TS_LD(5, 62, 5) x[61] -= x[52] * ta[0]; x[61] -= x[53] * ta[1]; x[61] -= x[54] * ta[2]; x[61] -= x[55] * ta[3]; }
    { const f32x4 ta = tb6; TS_LD(6, 62, 6) x[61] -= x[56] * ta[0]; x[61] -= x[57] * ta[1]; x[61] -= x[58] * ta[2]; x[61] -= x[59] * ta[3]; }
    { const f32x4 ta = tb7; TS_LD(7, 62, 7) x[61] -= x[60] * ta[0]; }
    { const f32x4 ta = tb0; TS_LD(0, 62, 8) x[62] -= x[0] * ta[0]; x[62] -= x[1] * ta[1]; x[62] -= x[2] * ta[2]; x[62] -= x[3] * ta[3]; }
    { const f32x4 ta = tb1; TS_LD(1, 62, 9) x[62] -= x[4] * ta[0]; x[62] -= x[5] * ta[1]; x[62] -= x[6] * ta[2]; x[62] -= x[7] * ta[3]; }
    { const f32x4 ta = tb2; TS_LD(2, 62, 10) x[62] -= x[8] * ta[0]; x[62] -= x[9] * ta[1]; x[62] -= x[10] * ta[2]; x[62] -= x[11] * ta[3]; }
    { const f32x4 ta = tb3; TS_LD(3, 62, 11) x[62] -= x[12] * ta[0]; x[62] -= x[13] * ta[1]; x[62] -= x[14] * ta[2]; x[62] -= x[15] * ta[3]; }
    { const f32x4 ta = tb4; TS_LD(4, 62, 12) x[62] -= x[16] * ta[0]; x[62] -= x[17] * ta[1]; x[62] -= x[18] * ta[2]; x[62] -= x[19] * ta[3]; }
    { const f32x4 ta = tb5; TS_LD(5, 62, 13) x[62] -= x[20] * ta[0]; x[62] -= x[21] * ta[1]; x[62] -= x[22] * ta[2]; x[62] -= x[23] * ta[3]; }
    { const f32x4 ta = tb6; TS_LD(6, 62, 14) x[62] -= x[24] * ta[0]; x[62] -= x[25] * ta[1]; x[62] -= x[26] * ta[2]; x[62] -= x[27] * ta[3]; }
    { const f32x4 ta = tb7; TS_LD(7, 62, 15) x[62] -= x[28] * ta[0]; x[62] -= x[29] * ta[1]; x[62] -= x[30] * ta[2]; x[62] -= x[31] * ta[3]; }
    { const f32x4 ta = tb0; TS_LD(0, 63, 0) x[62] -= x[32] * ta[0]; x[62] -= x[33] * ta[1]; x[62] -= x[34] * ta[2]; x[62] -= x[35] * ta[3]; }
    { const f32x4 ta = tb1; TS_LD(1, 63, 1) x[62] -= x[36] * ta[0]; x[62] -= x[37] * ta[1]; x[62] -= x[38] * ta[2]; x[62] -= x[39] * ta[3]; }
    { const f32x4 ta = tb2; TS_LD(2, 63, 2) x[62] -= x[40] * ta[0]; x[62] -= x[41] * ta[1]; x[62] -= x[42] * ta[2]; x[62] -= x[43] * ta[3]; }
    { const f32x4 ta = tb3; TS_LD(3, 63, 3) x[62] -= x[44] * ta[0]; x[62] -= x[45] * ta[1]; x[62] -= x[46] * ta[2]; x[62] -= x[47] * ta[3]; }
    { const f32x4 ta = tb4; TS_LD(4, 63, 4) x[62] -= x[48] * ta[0]; x[62] -= x[49] * ta[1]; x[62] -= x[50] * ta[2]; x[62] -= x[51] * ta[3]; }
    { const f32x4 ta = tb5; TS_LD(5, 63, 5) x[62] -= x[52] * ta[0]; x[62] -= x[53] * ta[1]; x[62] -= x[54] * ta[2]; x[62] -= x[55] * ta[3]; }
    { const f32x4 ta = tb6; TS_LD(6, 63, 6) x[62] -= x[56] * ta[0]; x[62] -= x[57] * ta[1]; x[62] -= x[58] * ta[2]; x[62] -= x[59] * ta[3]; }
    { const f32x4 ta = tb7; TS_LD(7, 63, 7) x[62] -= x[60] * ta[0]; x[62] -= x[61] * ta[1]; }
    { const f32x4 ta = tb0; TS_LD(0, 63, 8) x[63] -= x[0] * ta[0]; x[63] -= x[1] * ta[1]; x[63] -= x[2] * ta[2]; x[63] -= x[3] * ta[3]; }
    { const f32x4 ta = tb1; TS_LD(1, 63, 9) x[63] -= x[4] * ta[0]; x[63] -= x[5] * ta[1]; x[63] -= x[6] * ta[2]; x[63] -= x[7] * ta[3]; }
    { const f32x4 ta = tb2; TS_LD(2, 63, 10) x[63] -= x[8] * ta[0]; x[63] -= x[9] * ta[1]; x[63] -= x[10] * ta[2]; x[63] -= x[11] * ta[3]; }
    { const f32x4 ta = tb3; TS_LD(3, 63, 11) x[63] -= x[12] * ta[0]; x[63] -= x[13] * ta[1]; x[63] -= x[14] * ta[2]; x[63] -= x[15] * ta[3]; }
    { const f32x4 ta = tb4; TS_LD(4, 63, 12) x[63] -= x[16] * ta[0]; x[63] -= x[17] * ta[1]; x[63] -= x[18] * ta[2]; x[63] -= x[19] * ta[3]; }
    { const f32x4 ta = tb5; TS_LD(5, 63, 13) x[63] -= x[20] * ta[0]; x[63] -= x[21] * ta[1]; x[63] -= x[22] * ta[2]; x[63] -= x[23] * ta[3]; }
    { const f32x4 ta = tb6; TS_LD(6, 63, 14) x[63] -= x[24] * ta[0]; x[63] -= x[25] * ta[1]; x[63] -= x[26] * ta[2]; x[63] -= x[27] * ta[3]; }
    { const f32x4 ta = tb7; TS_LD(7, 63, 15) x[63] -= x[28] * ta[0]; x[63] -= x[29] * ta[1]; x[63] -= x[30] * ta[2]; x[63] -= x[31] * ta[3]; }
    { const f32x4 ta = tb0; x[63] -= x[32] * ta[0]; x[63] -= x[33] * ta[1]; x[63] -= x[34] * ta[2]; x[63] -= x[35] * ta[3]; }
    { const f32x4 ta = tb1; x[63] -= x[36] * ta[0]; x[63] -= x[37] * ta[1]; x[63] -= x[38] * ta[2]; x[63] -= x[39] * ta[3]; }
    { const f32x4 ta = tb2; x[63] -= x[40] * ta[0]; x[63] -= x[41] * ta[1]; x[63] -= x[42] * ta[2]; x[63] -= x[43] * ta[3]; }
    { const f32x4 ta = tb3; x[63] -= x[44] * ta[0]; x[63] -= x[45] * ta[1]; x[63] -= x[46] * ta[2]; x[63] -= x[47] * ta[3]; }
    { const f32x4 ta = tb4; x[63] -= x[48] * ta[0]; x[63] -= x[49] * ta[1]; x[63] -= x[50] * ta[2]; x[63] -= x[51] * ta[3]; }
    { const f32x4 ta = tb5; x[63] -= x[52] * ta[0]; x[63] -= x[53] * ta[1]; x[63] -= x[54] * ta[2]; x[63] -= x[55] * ta[3]; }
    { const f32x4 ta = tb6; x[63] -= x[56] * ta[0]; x[63] -= x[57] * ta[1]; x[63] -= x[58] * ta[2]; x[63] -= x[59] * ta[3]; }
    { const f32x4 ta = tb7; x[63] -= x[60] * ta[0]; x[63] -= x[61] * ta[1]; x[63] -= x[62] * ta[2]; }
}
#undef TS_LD
#undef TS_F

DI void prep_item(const Ctx& C, LAS unsigned char* pl, int item, int half) {
    int lane_ = C.lane; asm volatile("" : "+v"(lane_));
    const int lane = lane_, h = item & 7, c = (item >> 3) & 127, b = item >> 10, R0 = b * SEQ + c * 64;
    LAS float* AM = (LAS float*)pl; LAS unsigned char* KIMG = pl + 16384;
    LAS float* Gs = (LAS float*)(pl + 16384 + 17408 + half * 1024); LAS float* Bs = Gs + 64; LAS float* Es = Gs + 128; LAS float* Cs = Gs + 192;
    const bf16* PROJ = WSP(bf16, WS_PROJ); const float* AB = WSP(float, WS_AB);
    unsigned char* blk = C.ws + WS_DEL + (size_t)item * DEL_ITEM;
    float Glast;
    { const float a = AB[(size_t)(R0 + lane) * 16 + h], bb = AB[(size_t)(R0 + lane) * 16 + 8 + h];
      const float g = -__expf(C.a_log[h]) * softplus_f(a + C.a_dtb[h]), beta = sigmoid_f(bb);
      float G = g;
#pragma unroll
      for (int o = 1; o < 64; o <<= 1) { const float t = shfrom(G, (lane - o) & 63); if (lane >= o) G += t; }
      Glast = shfrom(G, 63 + (lane & 0));
      Gs[lane] = G; Bs[lane] = beta; Es[lane] = __expf(Glast - G); Cs[lane] = beta * __expf(G);
      if (half == 1 && lane == 0) WSP(float, WS_GLB)[item] = __expf(Glast);
      LDS_WAIT(); }
    const int il = lane & 15, g4 = lane >> 4;
    if (half == 1) {
        const int rg = lane >> 4, ch = lane & 15, t0 = c * 64 + 16 * rg;
        LAS unsigned char* QIMG = pl;
#pragma unroll
        for (int part = 1; part >= 0; --part) {
            const int col = part * 1024 + h * 128 + 8 * ch;
            float cw[4][8];
#pragma unroll
            for (int w = 0; w < 4; ++w) { const f32x4 w0 = *(const GAS f32x4*)(C.a_conv + w * CONVD + col), w1 = *(const GAS f32x4*)(C.a_conv + w * CONVD + col + 4);
#pragma unroll
                for (int e = 0; e < 4; ++e) { cw[w][e] = w0[e]; cw[w][4 + e] = w1[e]; } }
            v4u xr[19];
#pragma unroll
            for (int r = 0; r < 19; ++r) { const int tr = t0 - 3 + r; const v4u ld = *(const GAS v4u*)(PROJ + (size_t)(b * SEQ + (tr < 0 ? 0 : tr)) * NPROJ + col); xr[r] = tr < 0 ? (v4u){0u, 0u, 0u, 0u} : ld; }
#pragma unroll
            for (int rr = 0; rr < 16; ++rr) { float y[8]; float ss = 0.f;
#pragma unroll
                for (int e = 0; e < 8; ++e) { float a_ = 0.f;
#pragma unroll
                    for (int w = 0; w < 4; ++w) { const unsigned u = (e < 2) ? xr[rr + w].x : (e < 4) ? xr[rr + w].y : (e < 6) ? xr[rr + w].z : xr[rr + w].w; a_ += cw[w][e] * ((e & 1) ? bfhi(u) : bflo(u)); }
                    y[e] = silu_f(a_); ss += y[e] * y[e]; }
                ss = rowsum16(ss);
                const float inv = rsqrtf(ss + 1e-6f) * (part == 0 ? 0.08838834764831845f : 1.f);
                const int i = 16 * rg + rr;
#pragma unroll
                for (int e = 0; e < 8; ++e) y[e] *= inv;
                const bf16x8 fr = pack8(y);
                if (part == 1) *(LAS bf16x8*)(KIMG + i * 272 + 16 * ch) = fr;
                else { *(LAS bf16x8*)(QIMG + i * 256 + 16 * ch) = fr;
                    const float eG = __expf(Gs[i]);
                    bf16* qp = (bf16*)(blk + DEL_QP) + (size_t)(((i >> 4) * 4 + (ch >> 2)) * 64) * 8;
#pragma unroll
                    for (int eh = 0; eh < 2; ++eh) { v2u o; o.x = pk2(y[4 * eh] * eG, y[4 * eh + 1] * eG); o.y = pk2(y[4 * eh + 2] * eG, y[4 * eh + 3] * eG);
                        *(GAS v2u*)(qp + (16 * (2 * (ch & 1) + eh) + (i & 15)) * 8 + 4 * ((ch >> 1) & 1)) = o; } }
            }
        }
        LDS_WAIT();
#pragma unroll 1
        for (int ni = 0; ni < 4; ++ni) {
            bf16x8 qf[4];
#pragma unroll
            for (int ks = 0; ks < 4; ++ks) qf[ks] = *(const LAS bf16x8*)(QIMG + (16 * ni + il) * 256 + (32 * ks + 8 * g4) * 2);
            const int i = 16 * ni + il; const float Gi = Gs[i];
#pragma unroll
            for (int mj = 0; mj < 4; ++mj) {
                const bool need_qk = (ni >= mj) || (ni == 0 && mj == 1) || (ni == 2 && mj == 3);
                if (need_qk) {
                    f32x4 acc = {0.f, 0.f, 0.f, 0.f};
                    if (ni >= mj) {
#pragma unroll
                        for (int ks = 0; ks < 4; ++ks) acc = mfma16(*(const LAS bf16x8*)(KIMG + (16 * mj + il) * 272 + (32 * ks + 8 * g4) * 2), qf[ks], acc);
                    }
                    float v[4];
#pragma unroll
                    for (int r = 0; r < 4; ++r) { const int j = 16 * mj + 4 * g4 + r; v[r] = (i >= j) ? acc[r] * __expf(Gi - Gs[j]) : 0.f; }
                    v2u o; o.x = pk2(v[0], v[1]); o.y = pk2(v[2], v[3]);
                    *(GAS v2u*)((bf16*)(blk + DEL_QKP) + (size_t)(((ni * 2 + (mj >> 1)) * 64 + lane) * 8 + 4 * (mj & 1))) = o;
                }
            }
        }
        LDS_WAIT(); asm volatile("" ::: "memory");
#pragma unroll 1
        for (int mi = 0; mi < 4; ++mi) {
            bf16x8 ka[4];
#pragma unroll
            for (int ks = 0; ks < 4; ++ks) ka[ks] = *(const LAS bf16x8*)(KIMG + (16 * mi + il) * 272 + (32 * ks + 8 * g4) * 2);
            float Gr[4], Br[4];
#pragma unroll
            for (int r = 0; r < 4; ++r) { Gr[r] = Gs[16 * mi + 4 * g4 + r]; Br[r] = Bs[16 * mi + 4 * g4 + r]; }
#pragma unroll 1
            for (int nj = 0; nj <= mi; ++nj) {
                f32x4 acc = {0.f, 0.f, 0.f, 0.f};
#pragma unroll
                for (int ks = 0; ks < 4; ++ks) acc = mfma16(ka[ks], *(const LAS bf16x8*)(KIMG + (16 * nj + il) * 272 + (32 * ks + 8 * g4) * 2), acc);
                const float Gc = Gs[16 * nj + il];
#pragma unroll
                for (int r = 0; r < 4; ++r) { const int i2 = 16 * mi + 4 * g4 + r, j = 16 * nj + il;
                    AM[i2 * 64 + j] = (i2 > j) ? Br[r] * acc[r] * __expf(Gr[r] - Gc) : 0.f; }
            }
        }
    }
}
DI void prep_item2(const Ctx& C, LAS unsigned char* pl, int item, int half) {
    int lane_ = C.lane; asm volatile("" : "+v"(lane_));
    const int lane = lane_, h = item & 7, c = (item >> 3) & 127, b = item >> 10, R0 = b * SEQ + c * 64;
    const LAS float* AM = (const LAS float*)pl; const LAS unsigned char* KIMG = pl + 16384;
    const LAS float* Gs = (const LAS float*)(pl + 16384 + 17408 + half * 1024); const LAS float* Bs = Gs + 64; const LAS float* Es = Gs + 128; const LAS float* Cs = Gs + 192;
    unsigned char* blk = C.ws + WS_DEL + (size_t)item * DEL_ITEM;
    const int il = lane & 15, g4 = lane >> 4;
    f32x2 x[64];
    if (half == 1) {
#pragma unroll
        for (int f = 0; f < 16; ++f) { const int dt = f >> 1, ks = f & 1, d = 16 * dt + il; float v[8];
#pragma unroll
            for (int e = 0; e < 8; ++e) { const int j = 32 * ks + 16 * (e >> 2) + 4 * g4 + (e & 3); v[e] = bf2f(*(const LAS unsigned short*)(KIMG + j * 272 + d * 2)) * Es[j]; }
            *(GAS bf16x8*)((bf16*)(blk + DEL_KTP) + (size_t)(f * 64 + lane) * 8) = pack8(v); }
#pragma unroll
        for (int j = 0; j < 64; ++j) { const unsigned u = *(const LAS unsigned*)(KIMG + j * 272 + lane * 4); const float cj = Cs[j]; x[j] = (f32x2){bflo(u) * cj, bfhi(u) * cj}; if ((j & 15) == 15) asm volatile("" ::: "memory"); }
    } else {
        const bf16* PROJ = WSP(bf16, WS_PROJ); const int col = 2048 + h * 128 + 2 * lane, t0 = c * 64;
        f32x2 cw[4];
#pragma unroll
        for (int w = 0; w < 4; ++w) cw[w] = *(const GAS f32x2*)(C.a_conv + w * CONVD + col);
        unsigned xr[67];
#pragma unroll
        for (int r = 0; r < 67; ++r) { const int tr = t0 - 3 + r; const unsigned ld = *(const GAS unsigned*)(PROJ + (size_t)(b * SEQ + (tr < 0 ? 0 : tr)) * NPROJ + col); xr[r] = tr < 0 ? 0u : ld; }
#pragma unroll
        for (int j = 0; j < 64; ++j) { float a0 = 0.f, a1 = 0.f;
#pragma unroll
            for (int w = 0; w < 4; ++w) { a0 += cw[w][0] * bflo(xr[j + w]); a1 += cw[w][1] * bfhi(xr[j + w]); }
            const float bj = Bs[j]; x[j] = (f32x2){silu_f(a0) * bj, silu_f(a1) * bj}; }
    }
    tri_solve<64>(x, AM);
    if (half == 1) {
        const int d = 2 * lane, ks = d >> 5, ap = d & 31, p = 8 * ((ap >> 2) & 3) + 4 * (ap >> 4) + (ap & 3);
        bf16* wp = (bf16*)blk;
#pragma unroll
        for (int i = 0; i < 64; ++i) *(GAS unsigned*)(wp + (size_t)((((i >> 4) * 4 + ks) * 64 + 16 * (p >> 3) + (i & 15)) * 8 + (p & 7))) = pk2(x[i][0], x[i][1]);
    } else {
        bf16* up = (bf16*)(blk + DEL_U);
#pragma unroll
        for (int cc = 0; cc < 2; ++cc) { const int dv = 2 * lane + cc, dvs = dv >> 4;
#pragma unroll
            for (int mt = 0; mt < 4; ++mt)
#pragma unroll
                for (int q4 = 0; q4 < 4; ++q4) { const int i0 = 16 * mt + 4 * q4; v2u o; o.x = pk2(x[i0][cc], x[i0 + 1][cc]); o.y = pk2(x[i0 + 2][cc], x[i0 + 3][cc]);
                    *(GAS v2u*)(up + (size_t)((dvs * 64 + 16 * q4 + (dv & 15)) * 16 + 4 * mt)) = o; } }
    }
}
#if defined(PROBE_DLY)
#define P2_T(n) do { if ((n) == PROBE_DLY && (int)blockIdx.x == PROBE_BLK) p2_t0_ = __builtin_amdgcn_s_memrealtime(); } while (0)
#define P2_TE(n) do { if ((n) == PROBE_DLY && (int)blockIdx.x == PROBE_BLK) *dacc += __builtin_amdgcn_s_memrealtime() - p2_t0_; } while (0)
#else
#define P2_T(n) do { } while (0)
#define P2_TE(n) do { } while (0)
#endif
DI void prep_phase(const Ctx& C, unsigned long long* dacc) {
    unsigned long long p2_t0_ = 0ull; (void)p2_t0_; (void)dacc;
    const int pair = C.wave & 3, half = C.wave >> 2; LAS unsigned char* pl = C.lds + pair * PAIR_BYTES;
    for (int base = C.vcu * 4; base < NITEM; base += C.G * 4) { const int item = base + pair;
        P2_T(21); prep_item(C, pl, item, half); P2_TE(21);
        P2_T(23); LDS_BARRIER(); P2_TE(23);
        P2_T(22); prep_item2(C, pl, item, half); P2_TE(22);
        P2_T(23); LDS_BARRIER(); P2_TE(23);
    }
}

constexpr int NSL = 1, NSCAN = 128 / NSL;
constexpr int SX_SB = 0, SX_VN = 2 * NSL * 4096;
#if defined(PROBE_DLY)
#define SCAN_T(n) do { if ((n) == PROBE_DLY && (int)blockIdx.x == PROBE_BLK && C.wave == 0) scan_t0_ = __builtin_amdgcn_s_memrealtime(); } while (0)
#define SCAN_TE(n) do { if ((n) == PROBE_DLY && (int)blockIdx.x == PROBE_BLK && C.wave == 0) *dly_acc += __builtin_amdgcn_s_memrealtime() - scan_t0_; } while (0)
#else
#define SCAN_T(n) do { } while (0)
#define SCAN_TE(n) do { } while (0)
#endif
DI void scan_phase(const Ctx& C, int bx, unsigned long long* dly_acc) {
    unsigned long long scan_t0_ = 0ull; (void)scan_t0_; (void)dly_acc;
    const int lane = C.lane, il = lane & 15, g4 = lane >> 4;
    static_assert(NSL == 1, "stream mapping below is written for one slice per workgroup");
    const int xcd = bx & 7, kk = bx >> 3, bh = xcd * 2 + (kk >> 3), dvs0 = kk & 7, b = bh >> 3, h = bh & 7;
    const unsigned char* blk0 = C.ws + WS_DEL + (size_t)((b * 128) * 8 + h) * DEL_ITEM + lane * 16;
    LAS unsigned char* X = C.lds;
    for (int i = C.tid; i < 2 * NSL * 256; i += NTHR) *(LAS v4u*)(X + SX_SB + i * 16) = (v4u){0u, 0u, 0u, 0u};
    LDS_BARRIER();
#define ITEM(c) (blk0 + (size_t)((c) < 128 ? (c) : 127) * 8 * DEL_ITEM)
    if (C.wave < 4) {
        const int w = C.wave;
        struct Set { bf16x8 wp[4], kt[4]; v2u u[NSL]; };
        Set S0, S1, S2, S3;
        auto issue = [&](int c, Set& s) { const unsigned char* p = ITEM(c);
#pragma unroll
            for (int ks = 0; ks < 4; ++ks) s.wp[ks] = *(const GAS bf16x8*)(p + (w * 4 + ks) * 1024);
#pragma unroll
            for (int f = 0; f < 4; ++f) s.kt[f] = *(const GAS bf16x8*)(p + DEL_KTP + (w * 4 + f) * 1024);
#pragma unroll
            for (int sl = 0; sl < NSL; ++sl) s.u[sl] = *(const GAS v2u*)(p - lane * 16 + DEL_U + (dvs0 + sl) * 2048 + lane * 32 + 8 * w); };
        const float* GLB = WSP(float, WS_GLB);
        const float gl_lo = GLB[(b * 128 + lane) * 8 + h], gl_hi = GLB[(b * 128 + 64 + lane) * 8 + h];
        f32x4 sd0[NSL], sd1[NSL];
#pragma unroll
        for (int sl = 0; sl < NSL; ++sl) { sd0[sl] = (f32x4){0.f, 0.f, 0.f, 0.f}; sd1[sl] = sd0[sl]; }
        issue(0, S0); issue(1, S1); issue(2, S2); issue(3, S3);
        auto step = [&](int c, Set& s) {
            const float gl = __shfl(c < 64 ? gl_lo : gl_hi, c & 63);
#pragma unroll
            for (int sl = 0; sl < NSL; ++sl) {
                const LAS unsigned char* sb = X + SX_SB + ((c & 1) * NSL + sl) * 4096 + lane * 16;
                f32x4 acc = {0.f, 0.f, 0.f, 0.f};
#pragma unroll
                for (int ks = 0; ks < 4; ++ks) acc = mfma16(s.wp[ks], *(const LAS bf16x8*)(sb + ks * 1024), acc);
                const f32x4 vn = {bflo(s.u[sl].x) - acc[0], bfhi(s.u[sl].x) - acc[1], bflo(s.u[sl].y) - acc[2], bfhi(s.u[sl].y) - acc[3]};
                v2u o; o.x = pk2(vn[0], vn[1]); o.y = pk2(vn[2], vn[3]); *(LAS v2u*)(X + SX_VN + ((c & 1) * NSL + sl) * 2048 + w * 512 + lane * 8) = o; }
            SCAN_TE(14); SCAN_T(11); LDS_BARRIER(); SCAN_TE(11); SCAN_T(13);
#pragma unroll
            for (int sl = 0; sl < NSL; ++sl) {
                const LAS unsigned char* vp = X + SX_VN + ((c & 1) * NSL + sl) * 2048 + lane * 8;
                const v2u t0 = *(const LAS v2u*)(vp), t1 = *(const LAS v2u*)(vp + 512), t2 = *(const LAS v2u*)(vp + 1024), t3 = *(const LAS v2u*)(vp + 1536);
                const bf16x8 vb0 = __builtin_bit_cast(bf16x8, (v4u){t0.x, t0.y, t1.x, t1.y}), vb1 = __builtin_bit_cast(bf16x8, (v4u){t2.x, t2.y, t3.x, t3.y});
                f32x4 a0 = sd0[sl] * gl, a1 = sd1[sl] * gl;
                a0 = mfma16(s.kt[0], vb0, a0); a1 = mfma16(s.kt[2], vb0, a1); a0 = mfma16(s.kt[1], vb1, a0); a1 = mfma16(s.kt[3], vb1, a1);
                sd0[sl] = a0; sd1[sl] = a1;
                *(LAS bf16x8*)(X + SX_SB + (((c + 1) & 1) * NSL + sl) * 4096 + w * 1024 + lane * 16) = pack44(a0, a1); }
            issue(c + 4, s);
            SCAN_TE(13); SCAN_T(12); LDS_BARRIER(); SCAN_TE(12); SCAN_T(14);
        };
#pragma unroll 1
        for (int c = 0; c < 128; c += 4) { step(c, S0); step(c + 1, S1); step(c + 2, S2); step(c + 3, S3); }
#pragma unroll
        for (int sl = 0; sl < NSL; ++sl) { float* pd = C.out + O_PDELTA + (size_t)((b * 8 + h) * 128) * 128 + 16 * (dvs0 + sl) + il;
#pragma unroll
            for (int r = 0; r < 4; ++r) { pd[(size_t)(32 * w + 4 * g4 + r) * 128] = sd0[sl][r]; pd[(size_t)(32 * w + 16 + 4 * g4 + r) * 128] = sd1[sl][r]; } }
    } else {
        const int w = C.wave - 4;
        struct SetO { bf16x8 qp[4], qk[2]; };
        SetO S0, S1, S2, S3;
        auto issue = [&](int c, SetO& s) { const unsigned char* p = ITEM(c);
#pragma unroll
            for (int ks = 0; ks < 4; ++ks) s.qp[ks] = *(const GAS bf16x8*)(p + DEL_QP + (w * 4 + ks) * 1024);
            s.qk[0] = *(const GAS bf16x8*)(p + DEL_QKP + (w * 2) * 1024); s.qk[1] = *(const GAS bf16x8*)(p + DEL_QKP + (w * 2 + (w >> 1)) * 1024); };
        bf16* O = WSP(bf16, WS_O);
        issue(0, S0); issue(1, S1); issue(2, S2); issue(3, S3);
        auto step = [&](int c, SetO& s) {
            LDS_BARRIER();
#pragma unroll
            for (int sl = 0; sl < NSL; ++sl) {
                const LAS unsigned char* sb = X + SX_SB + ((c & 1) * NSL + sl) * 4096 + lane * 16;
                f32x4 acc = {0.f, 0.f, 0.f, 0.f};
#pragma unroll
                for (int ks = 0; ks < 4; ++ks) acc = mfma16(s.qp[ks], *(const LAS bf16x8*)(sb + ks * 1024), acc);
                const LAS unsigned char* vp = X + SX_VN + ((c & 1) * NSL + sl) * 2048 + lane * 8;
                const v2u t0 = *(const LAS v2u*)(vp), t1 = *(const LAS v2u*)(vp + 512), t2 = *(const LAS v2u*)(vp + 1024), t3 = *(const LAS v2u*)(vp + 1536);
                const bf16x8 vb0 = __builtin_bit_cast(bf16x8, (v4u){t0.x, t0.y, t1.x, t1.y}), vb1 = __builtin_bit_cast(bf16x8, (v4u){t2.x, t2.y, t3.x, t3.y});
                acc = mfma16(s.qk[0], vb0, acc);
                if (w >= 2) acc = mfma16(s.qk[1], vb1, acc);
                bf16* orow = O + (size_t)(b * SEQ + c * 64 + 16 * w + 4 * g4) * DM + h * 128 + 16 * (dvs0 + sl) + il;
#pragma unroll
                for (int r = 0; r < 4; ++r) orow[(size_t)r * DM] = (bf16)(pk2(acc[r], 0.f) & 0xffffu); }
            issue(c + 4, s);
            LDS_BARRIER();
        };
#pragma unroll 1
        for (int c = 0; c < 128; c += 4) { step(c, S0); step(c + 1, S1); step(c + 2, S2); step(c + 3, S3); }
    }
#undef ITEM
}
DI void sample_delta(const Ctx& C, int vs) {
    const int  pair = C.wave >> 1, half = C.wave & 1, lane = C.lane, tt = half * 64 + lane;
    LAS float* qs = (LAS float*)(C.lds + pair * 9216); LAS float* ksm = qs + 1024; LAS float* red = ksm + 1024;
    const bf16* PROJ = WSP(bf16, WS_PROJ); const float* AB = WSP(float, WS_AB); bf16* O = WSP(bf16, WS_O);
    for (int base = vs * 4; base < 256; base += (C.G - NSCAN) * 4) {
        const int idx = base + pair, seq = idx >> 3, h = idx & 7, R0 = MP + seq * 8;
        float yq[8], yk[8], yv[8];
#pragma unroll
        for (int part = 0; part < 3; ++part) { const int col = part * 1024 + h * 128 + tt; float xp[11], cw[4];
#pragma unroll
            for (int r = 0; r < 3; ++r) xp[r] = C.state_conv[(size_t)(seq * 3 + r) * CONVD + col];
#pragma unroll
            for (int t = 0; t < 8; ++t) xp[3 + t] = bf2f(PROJ[(size_t)(R0 + t) * NPROJ + col]);
#pragma unroll
            for (int w = 0; w < 4; ++w) cw[w] = C.a_conv[w * CONVD + col];
#pragma unroll
            for (int t = 0; t < 8; ++t) { const float y = silu_f(cw[0] * xp[t] + cw[1] * xp[t + 1] + cw[2] * xp[t + 2] + cw[3] * xp[t + 3]);
                if (part == 0) yq[t] = y; else if (part == 1) yk[t] = y; else yv[t] = y; } }
#pragma unroll
        for (int t = 0; t < 8; ++t) { const float sq = wsum(yq[t] * yq[t]), sk = wsum(yk[t] * yk[t]); if (lane == 0) { red[t * 2 + half] = sq; red[16 + t * 2 + half] = sk; } }
        LDS_BARRIER();
#pragma unroll
        for (int t = 0; t < 8; ++t) { const float nq = rsqrtf(red[t * 2] + red[t * 2 + 1] + 1e-6f) * 0.08838834764831845f, nk = rsqrtf(red[16 + t * 2] + red[16 + t * 2 + 1] + 1e-6f);
            qs[t * 128 + tt] = yq[t] * nq; ksm[t * 128 + tt] = yk[t] * nk; }
        LDS_BARRIER();
        float s[128];
        const float* sp = C.state_delta + (size_t)((seq * 8 + h) * 128) * 128 + tt;
#pragma unroll
        for (int d = 0; d < 128; ++d) { s[d] = sp[(size_t)d * 128]; if ((d & 15) == 15) asm volatile("" ::: "memory"); }
#pragma unroll
        for (int t = 0; t < 8; ++t) {
            const float a = AB[(size_t)(R0 + t) * 16 + h], bb = AB[(size_t)(R0 + t) * 16 + 8 + h];
            const float eg = __expf(-__expf(C.a_log[h]) * softplus_f(a + C.a_dtb[h])), beta = sigmoid_f(bb);
            float dot = 0.f;
#pragma unroll
            for (int d4 = 0; d4 < 32; ++d4) { const f32x4 kk = *(const LAS f32x4*)(ksm + t * 128 + 4 * d4);
#pragma unroll
                for (int e = 0; e < 4; ++e) { s[4 * d4 + e] *= eg; dot += kk[e] * s[4 * d4 + e]; }
                if ((d4 & 7) == 7) asm volatile("" ::: "memory"); }
            const float err = (yv[t] - dot) * beta; float o = 0.f;
#pragma unroll
            for (int d4 = 0; d4 < 32; ++d4) { const f32x4 kk = *(const LAS f32x4*)(ksm + t * 128 + 4 * d4), qq = *(const LAS f32x4*)(qs + t * 128 + 4 * d4);
#pragma unroll
                for (int e = 0; e < 4; ++e) { s[4 * d4 + e] += kk[e] * err; o += qq[e] * s[4 * d4 + e]; }
                if ((d4 & 3) == 3) asm volatile("" ::: "memory"); }
            O[(size_t)(R0 + t) * DM + h * 128 + tt] = (bf16)(pk2(o, 0.f) & 0xffffu);
            asm volatile("" ::: "memory");
        }
        float* so = C.out + O_SDELTA + (size_t)((seq * 8 + h) * 128) * 128 + tt;
#pragma unroll
        for (int d = 0; d < 128; ++d) { so[(size_t)d * 128] = s[d]; if ((d & 15) == 15) asm volatile("" ::: "memory"); }
        LDS_BARRIER();
    }
}
DI void onorm_phase(const Ctx& C) {
    const int gw = C.vcu * NWAVES + C.wave, NGW = C.G * NWAVES, sub = C.lane & 15;
    const bf16* O = WSP(bf16, WS_O); const bf16* PROJ = WSP(bf16, WS_PROJ); bf16* OG = WSP(bf16, WS_OG);
    const f32x4 n0 = *(const GAS f32x4*)(C.a_norm + 8 * sub), n1 = *(const GAS f32x4*)(C.a_norm + 8 * sub + 4);
    for (int it = gw; it < MT * 8 / 4; it += NGW) { const int grp = it * 4 + (C.lane >> 4), row = grp >> 3, h = grp & 7, col = h * 128 + 8 * sub;
        const v4u ou = *(const GAS v4u*)(O + (size_t)row * DM + col); const f32x4 o0 = {bflo(ou.x), bfhi(ou.x), bflo(ou.y), bfhi(ou.y)}, o1 = {bflo(ou.z), bfhi(ou.z), bflo(ou.w), bfhi(ou.w)};
        const v4u z = *(const GAS v4u*)(PROJ + (size_t)row * NPROJ + 3072 + col);
        float ss = (o0[0] * o0[0] + o0[1] * o0[1]) + (o0[2] * o0[2] + o0[3] * o0[3]) + (o1[0] * o1[0] + o1[1] * o1[1]) + (o1[2] * o1[2] + o1[3] * o1[3]);
        ss = rowsum16(ss);
        const float r = rsqrtf(ss * (1.f / 128.f) + 1e-6f);
        float v[8] = {o0[0] * r * n0[0] * silu_f(bflo(z.x)), o0[1] * r * n0[1] * silu_f(bfhi(z.x)), o0[2] * r * n0[2] * silu_f(bflo(z.y)), o0[3] * r * n0[3] * silu_f(bfhi(z.y)),
                      o1[0] * r * n1[0] * silu_f(bflo(z.z)), o1[1] * r * n1[1] * silu_f(bfhi(z.z)), o1[2] * r * n1[2] * silu_f(bflo(z.w)), o1[3] * r * n1[3] * silu_f(bfhi(z.w))};
        *(GAS bf16x8*)(OG + (size_t)row * DM + col) = pack8(v); }
}
template <bool RES_BF16> DI void ln_phase(const Ctx& C, const void* resA_, const void* resB_, const bf16* mix, const float* g, const float* bb, float* outf, bf16* outb) {
    const int gw = C.vcu * NWAVES + C.wave, NGW = C.G * NWAVES, lane = C.lane;
    f32x4 gv[4], bv[4];
#pragma unroll
    for (int j = 0; j < 4; ++j) { gv[j] = *(const GAS f32x4*)(g + 4 * lane + 256 * j); bv[j] = *(const GAS f32x4*)(bb + 4 * lane + 256 * j); }
    for (int row = gw; row < MT; row += NGW) {
        const bf16* mr = mix + (size_t)row * DM;
        f32x4 v[4]; float s = 0.f;
#pragma unroll
        for (int j = 0; j < 4; ++j) { f32x4 a;
            if (RES_BF16) { const bf16* rr = (row < MP ? (const bf16*)resA_ + (size_t)row * DM : (const bf16*)resB_ + (size_t)(row - MP) * DM); const v2u ru = *(const GAS v2u*)(rr + 4 * lane + 256 * j); a = (f32x4){bflo(ru.x), bfhi(ru.x), bflo(ru.y), bfhi(ru.y)}; }
            else { const float* rr = (row < MP ? (const float*)resA_ + (size_t)row * DM : (const float*)resB_ + (size_t)(row - MP) * DM); a = *(const GAS f32x4*)(rr + 4 * lane + 256 * j); }
            const v2u mu = *(const GAS v2u*)(mr + 4 * lane + 256 * j); const f32x4 m = {bflo(mu.x), bfhi(mu.x), bflo(mu.y), bfhi(mu.y)}; v[j] = a * ALPHA + m; s += (v[j][0] + v[j][1]) + (v[j][2] + v[j][3]); }
        const float mean = wsum(s) * (1.f / DM); float s2 = 0.f;
#pragma unroll
        for (int j = 0; j < 4; ++j) { v[j] = v[j] - mean; s2 += (v[j][0] * v[j][0] + v[j][1] * v[j][1]) + (v[j][2] * v[j][2] + v[j][3] * v[j][3]); }
        const float rstd = rsqrtf(wsum(s2) * (1.f / DM) + 1e-5f);
#pragma unroll
        for (int j = 0; j < 4; ++j) { const f32x4 y = v[j] * rstd * gv[j] + bv[j];
            if (outf) *(GAS f32x4*)(outf + (size_t)row * DM + 4 * lane + 256 * j) = y;
            if (outb) { v2u o; o.x = pk2(y[0], y[1]); o.y = pk2(y[2], y[3]); *(GAS v2u*)(outb + (size_t)row * DM + 4 * lane + 256 * j) = o; } }
    }
}
constexpr float SM_SCALE = 0.125f, SM_C2 = 0.125f * 1.4426950408889634f;
DI float exp2_f(float x) { return __builtin_amdgcn_exp2f(x); }

template <bool CAUSAL, class KF, class VF>
DI void moba_tile(const KF& kfrag, const VF& vfrag, const bf16x8 (&qf)[2][2], int kt_max, int q0, int lane, float (&m_out)[2], float (&l_out)[2], f32x4 (&ot)[4][2]) {
    const int il = lane & 15, g4 = lane >> 4;
    f32x4 st[16][2];
    const float NEG = -__builtin_inff();
#pragma unroll
    for (int mt = 0; mt < 16; ++mt) {
        if (mt < kt_max) {
            const bf16x8 k0 = kfrag(mt, 0), k1 = kfrag(mt, 1);
#pragma unroll
            for (int nt = 0; nt < 2; ++nt) { f32x4 acc = {0.f, 0.f, 0.f, 0.f}; acc = mfma16(k0, qf[nt][0], acc); acc = mfma16(k1, qf[nt][1], acc);
                if (CAUSAL) {
#pragma unroll
                    for (int r = 0; r < 4; ++r) if (16 * mt + 4 * g4 + r > q0 + 16 * nt + il) acc[r] = NEG; }
                st[mt][nt] = acc; }
        } else { st[mt][0] = (f32x4){NEG, NEG, NEG, NEG}; st[mt][1] = st[mt][0]; }
        if (mt & 1) asm volatile("" ::: "memory");
    }
#pragma unroll
    for (int nt = 0; nt < 2; ++nt) { float m = NEG;
#pragma unroll
        for (int mt = 0; mt < 16; ++mt) m = fmaxf(m, fmaxf(fmaxf(st[mt][nt][0], st[mt][nt][1]), fmaxf(st[mt][nt][2], st[mt][nt][3])));
        m = fmaxf(m, __shfl_xor(m, 16)); m = fmaxf(m, __shfl_xor(m, 32));
        float l = 0.f; const float mc = m * SM_C2;
#pragma unroll
        for (int mt = 0; mt < 16; ++mt)
#pragma unroll
            for (int r = 0; r < 4; ++r) { const float p = exp2_f(st[mt][nt][r] * SM_C2 - mc); st[mt][nt][r] = p; l += p; }
        l += __shfl_xor(l, 16); l += __shfl_xor(l, 32);
        m_out[nt] = m * SM_SCALE; l_out[nt] = l; }
#pragma unroll
    for (int mt = 0; mt < 4; ++mt) { ot[mt][0] = (f32x4){0.f, 0.f, 0.f, 0.f}; ot[mt][1] = ot[mt][0]; }
#pragma unroll
    for (int ks = 0; ks < 8; ++ks) {
        if (2 * ks < kt_max) {
            const bf16x8 p0 = pack44(st[2 * ks][0], st[2 * ks + 1][0]), p1 = pack44(st[2 * ks][1], st[2 * ks + 1][1]);
#pragma unroll
            for (int mt = 0; mt < 4; ++mt) { const bf16x8 vf = vfrag(mt, ks); ot[mt][0] = mfma16(vf, p0, ot[mt][0]); ot[mt][1] = mfma16(vf, p1, ot[mt][1]); }
        }
        asm volatile("" ::: "memory");
    }
}
struct LdsK { const LAS unsigned char* p; int lane; DI bf16x8 operator()(int mt, int ks) const { return *(const LAS bf16x8*)(p + ((mt * 2 + ks) * 64 + lane) * 16); } };
struct LdsV { const LAS unsigned char* p; int lane; DI bf16x8 operator()(int mt, int ks) const { return *(const LAS bf16x8*)(p + ((mt * 8 + ks) * 64 + lane) * 16); } };
DI void stage_kv(int tid, const bf16* Kblk  , const bf16* Vt  , LAS unsigned char* Kl, LAS unsigned char* Vl) {
#pragma unroll
    for (int q = 0; q < 4; ++q) { const int ch = tid + q * NTHR, key = ch >> 3, ci = ch & 7;
        const v4u v = *(const GAS v4u*)(Kblk + (size_t)key * 256 + 8 * ci);
        *(LAS v4u*)(Kl + ((((key >> 4) * 2 + (ci >> 2)) * 64) + (ci & 3) * 16 + (key & 15)) * 16) = v; }
#pragma unroll
    for (int q = 0; q < 4; ++q) { const int ch = tid + q * NTHR, d = ch >> 5, c32 = ch & 31;
        const v4u v = *(const GAS v4u*)(Vt + (size_t)d * 256 + 8 * c32);
        *(LAS v4u*)(Vl + ((((d >> 4) * 8 + (c32 >> 2)) * 64) + (c32 & 3) * 16 + (d & 15)) * 16) = v; }
}

DI void attn_p11(const Ctx& C) {
    float* PM = WSP(float, WS_PMEANS); const float* pk = C.out + O_PK;
    LAS float* red = (LAS float*)C.lds;
    for (int it = C.vcu; it < 64; it += C.G) {
        const float* base = pk + (size_t)(it * 256 + C.wave * 32) * 256 + 4 * C.lane; f32x4 a = {0.f, 0.f, 0.f, 0.f};
#pragma unroll 8
        for (int r = 0; r < 32; ++r) a += *(const GAS f32x4*)(base + (size_t)r * 256);
        *(LAS f32x4*)(red + C.wave * 256 + 4 * C.lane) = a;
        LDS_WAIT(); __syncthreads();
        if (C.tid < 256) { float s = 0.f;
#pragma unroll
            for (int w = 0; w < 8; ++w) s += red[w * 256 + C.tid];
            PM[it * 256 + C.tid] = s * (1.f / 256.f); }
        __syncthreads();
    }
    LAS unsigned short* img = (LAS unsigned short*)(C.lds + 16384);
    const bf16* VB = WSP(bf16, WS_VB); bf16* VTP = WSP(bf16, WS_VTP);
    for (int it = C.vcu; it < 256; it += C.G) { const int n = it & 31, g = (it >> 5) & 3, b = it >> 7;
#pragma unroll
        for (int q = 0; q < 4; ++q) { const int ch = C.tid + q * NTHR, key = ch >> 3, ci = ch & 7;
            const v4u v = *(const GAS v4u*)(VB + (size_t)(b * SEQ + n * 256 + key) * 256 + g * 64 + 8 * ci);
            LAS unsigned* dst = (LAS unsigned*)(img + key * 68 + 8 * ci); dst[0] = v.x; dst[1] = v.y; dst[2] = v.z; dst[3] = v.w; }
        LDS_WAIT(); __syncthreads();
#pragma unroll
        for (int q = 0; q < 4; ++q) { const int task = C.tid + q * NTHR, d = task >> 5, ks = (task >> 2) & 7, g4 = task & 3; unsigned short e8[8];
#pragma unroll
            for (int e = 0; e < 8; ++e) e8[e] = img[(32 * ks + 16 * (e >> 2) + 4 * g4 + (e & 3)) * 68 + d];
            v4u o; o.x = e8[0] | ((unsigned)e8[1] << 16); o.y = e8[2] | ((unsigned)e8[3] << 16); o.z = e8[4] | ((unsigned)e8[5] << 16); o.w = e8[6] | ((unsigned)e8[7] << 16);
            *(GAS v4u*)(VTP + ((size_t)((b * 4 + g) * 32 + n) * 64 + d) * 256 + 32 * ks + 8 * g4) = o; }
        __syncthreads();
    }
}
#define TOP3_INS(v_, i_) do { const float tv_ = (v_); const int ti_ = (i_); const bool g0_ = tv_ > v0, g1_ = tv_ > v1, g2_ = tv_ > v2; \
    const float nv2_ = g1_ ? v1 : (g2_ ? tv_ : v2); const int ni2_ = g1_ ? i1 : (g2_ ? ti_ : i2); \
    const float nv1_ = g0_ ? v0 : (g1_ ? tv_ : v1); const int ni1_ = g0_ ? i0 : (g1_ ? ti_ : i1); \
    v0 = g0_ ? tv_ : v0; i0 = g0_ ? ti_ : i0; v1 = nv1_; i1 = ni1_; v2 = nv2_; i2 = ni2_; } while (0)
DI void attn_p12(const Ctx& C) {
    const float* PM = WSP(float, WS_PMEANS); const bf16* Q = WSP(bf16, WS_Q); unsigned* LIST = WSP(unsigned, WS_LIST);
    LAS float* mn = (LAS float*)C.lds;
    const int lane = C.lane;
    for (int it = C.vcu; it < 512; it += C.G) {
        const int tr = it & 63, g = (it >> 6) & 3, b = it >> 8, own = tr >> 1;
        for (int i = C.tid; i < 32 * 64; i += NTHR) mn[i] = PM[(size_t)(b * 32 + (i >> 6)) * 256 + g * 64 + (i & 63)];
        LDS_WAIT(); __syncthreads();
        const int h4 = C.wave & 3, t = tr * 128 + (C.wave >> 2) * 64 + lane;
        if (own > 0) {
            float q[64];
            const bf16* qp = Q + (size_t)(b * SEQ + t) * DM + (4 * g + h4) * 64;
#pragma unroll
            for (int c8 = 0; c8 < 8; ++c8) { const v4u v = *(const GAS v4u*)(qp + 8 * c8);
                q[8 * c8] = bflo(v.x); q[8 * c8 + 1] = bfhi(v.x); q[8 * c8 + 2] = bflo(v.y); q[8 * c8 + 3] = bfhi(v.y); q[8 * c8 + 4] = bflo(v.z); q[8 * c8 + 5] = bfhi(v.z); q[8 * c8 + 6] = bflo(v.w); q[8 * c8 + 7] = bfhi(v.w); }
            float v0 = -__builtin_inff(), v1 = v0, v2 = v0; int i0 = -1, i1 = -1, i2 = -1;
#pragma unroll 1
            for (int n = 0; n < own; ++n) { float s = 0.f;
#pragma unroll
                for (int d4 = 0; d4 < 16; ++d4) { const f32x4 m = *(const LAS f32x4*)(mn + n * 64 + 4 * d4); s += (q[4 * d4] * m[0] + q[4 * d4 + 1] * m[1]) + (q[4 * d4 + 2] * m[2] + q[4 * d4 + 3] * m[3]); }
                TOP3_INS(s, n); }
            unsigned long long mymask = 0ull;
#pragma unroll 1
            for (int n = 0; n < own; ++n) { const bool s_ = (i0 == n) || (i1 == n) || (i2 == n); const unsigned long long mask = __ballot(s_); if (lane == n) mymask = mask; }
            unsigned mybase = 0u;
            if (lane < own && mymask) mybase = __hip_atomic_fetch_add(C.ctl + CW_PCNT + ((b * 4 + g) * 32 + lane) * 4 + h4, (unsigned)__builtin_popcountll(mymask), __ATOMIC_RELAXED, __HIP_MEMORY_SCOPE_AGENT);
#pragma unroll
            for (int j = 0; j < 3; ++j) { const int n = (j == 0) ? i0 : (j == 1) ? i1 : i2; const int nn = n < 0 ? 0 : n;
                const unsigned basep = __shfl(mybase, nn); const unsigned mlo = __shfl((unsigned)mymask, nn), mhi = __shfl((unsigned)(mymask >> 32), nn);
                const unsigned long long mask = ((unsigned long long)mhi << 32) | mlo;
                if (n >= 0) LIST[(size_t)(((b * 4 + g) * 32 + n) * 4 + h4) * 8192 + basep + __builtin_popcountll(mask & ((1ull << lane) - 1ull))] = (unsigned)t | ((unsigned)j << 13); }
        }
        __syncthreads();
    }
    const float* CM = WSP(float, WS_CMEANS); unsigned* SL = WSP(unsigned, WS_SLIST);
    for (int it = C.vcu; it < 128; it += C.G) { const int g = it & 3, seq = it >> 2, q32 = C.tid >> 4, sub = C.tid & 15, tq = q32 >> 2, h4 = q32 & 3;
        float q[64]; const bf16* qp = Q + (size_t)(MP + seq * 8 + tq) * DM + (4 * g + h4) * 64;
#pragma unroll
        for (int c8 = 0; c8 < 8; ++c8) { const v4u v = *(const GAS v4u*)(qp + 8 * c8);
            q[8 * c8] = bflo(v.x); q[8 * c8 + 1] = bfhi(v.x); q[8 * c8 + 2] = bflo(v.y); q[8 * c8 + 3] = bfhi(v.y); q[8 * c8 + 4] = bflo(v.z); q[8 * c8 + 5] = bfhi(v.z); q[8 * c8 + 6] = bflo(v.w); q[8 * c8 + 7] = bfhi(v.w); }
        float v0 = -__builtin_inff(), v1 = v0, v2 = v0; int i0 = -1, i1 = -1, i2 = -1;
#pragma unroll 1
        for (int j = 0; j < 4; ++j) { const int n = 4 * sub + j; const float* mp = CM + (size_t)(seq * 64 + n) * 256 + g * 64; float s = 0.f;
#pragma unroll
            for (int d4 = 0; d4 < 16; ++d4) { const f32x4 m = *(const GAS f32x4*)(mp + 4 * d4); s += (q[4 * d4] * m[0] + q[4 * d4 + 1] * m[1]) + (q[4 * d4 + 2] * m[2] + q[4 * d4 + 3] * m[3]); }
            TOP3_INS(s, n); }
#pragma unroll
        for (int o = 1; o < 16; o <<= 1) { const float a0 = __shfl_xor(v0, o), a1 = __shfl_xor(v1, o), a2 = __shfl_xor(v2, o); const int j0 = __shfl_xor(i0, o), j1 = __shfl_xor(i1, o), j2 = __shfl_xor(i2, o);
            TOP3_INS(a0, j0); TOP3_INS(a1, j1); TOP3_INS(a2, j2); }
        if (sub == 0) {
#pragma unroll
            for (int s = 0; s < 3; ++s) { const int lid = (seq * 4 + g) * 64 + (s == 0 ? i0 : s == 1 ? i1 : i2); const unsigned pos = __hip_atomic_fetch_add(C.ctl + CW_SCNT + lid, 1u, __ATOMIC_RELAXED, __HIP_MEMORY_SCOPE_AGENT);
                SL[(size_t)lid * 32 + pos] = (unsigned)q32 | ((unsigned)s << 5); } }
        __syncthreads();
        if (C.tid < 64) { const int lid = (seq * 4 + g) * 64 + C.tid; if (__hip_atomic_load(C.ctl + CW_SCNT + lid, __ATOMIC_RELAXED, __HIP_MEMORY_SCOPE_AGENT) != 0u) { const unsigned p = __hip_atomic_fetch_add(C.ctl + CW_SCNT + 8192, 1u, __ATOMIC_RELAXED, __HIP_MEMORY_SCOPE_AGENT); WSP(unsigned, WS_GLB + 131072)[p] = (unsigned)lid; } }
    }
}
struct GlobK { const float* r0; const float* r1; int g, lane;
    DI bf16x8 operator()(int mt, int ks) const { const int key = 16 * mt + (lane & 15); const float* p = (key < 128 ? r0 + (size_t)key * 256 : r1 + (size_t)(key - 128) * 256) + 32 * ks + 8 * (lane >> 4);
        return pack44(*(const GAS f32x4*)p, *(const GAS f32x4*)(p + 4)); } };
struct GlobV { const float* r0; const float* r1; int lane;
    DI bf16x8 operator()(int mt, int ks) const { float v[8];
#pragma unroll
        for (int e = 0; e < 8; ++e) { const int key = 32 * ks + 16 * (e >> 2) + 4 * (lane >> 4) + (e & 3); v[e] = (key < 128 ? r0 + (size_t)key * 256 : r1 + (size_t)(key - 128) * 256)[16 * mt + (lane & 15)]; }
        return pack8(v); } };
#if defined(PROBE_DLY)
#define P13_T(n) do { if ((n) == PROBE_DLY && (int)blockIdx.x == PROBE_BLK) p13_t0_ = __builtin_amdgcn_s_memrealtime(); } while (0)
#define P13_TE(n) do { if ((n) == PROBE_DLY && (int)blockIdx.x == PROBE_BLK) *dacc += __builtin_amdgcn_s_memrealtime() - p13_t0_; } while (0)
#else
#define P13_T(n) do { } while (0)
#define P13_TE(n) do { } while (0)
#endif
DI void attn_p13_sample(const Ctx& C, int wi, int nw) {
    const int tid_f = C.wave * 64 + lane_id();
    const unsigned* SL = WSP(unsigned, WS_SLIST); float* SP = WSP(float, WS_SPART); const bf16* Q = WSP(bf16, WS_Q);
    LAS int* seq = (LAS int*)(C.lds + 131072); int nit = 0;
    if (tid_f == 0) { const int tot = (int)__hip_atomic_load(C.ctl + CW_SCNT + 8192, __ATOMIC_RELAXED, __HIP_MEMORY_SCOPE_AGENT); int n = 0; for (int k = wi; k < tot && n < 120; k += nw) seq[1 + n++] = (int)WSP(unsigned, WS_GLB + 131072)[k]; seq[0] = n; }
    LDS_BARRIER();
    nit = seq[0];
    if (nit == 0) return;
    if (C.wave >= 1) {
        struct LSet { f32x4 kv[5][2], vv[3][4]; };
        LSet A, B;
        auto issue = [&](int idx, LSet& s) {
            const int it = seq[1 + (idx < nit ? idx : nit - 1)];
            int tid_l = tid_f; asm volatile("" : "+v"(tid_l)); const int lt = tid_l - 64;
            const int n = it & 63, g = (it >> 6) & 3, sq = it >> 8;
            const int pg0 = C.page_table[sq * 128 + 2 * n], pg1 = C.page_table[sq * 128 + 2 * n + 1];
            const float* k0 = C.cache_k + (size_t)pg0 * 32768 + g * 64; const float* k1 = C.cache_k + (size_t)pg1 * 32768 + g * 64;
            const float* v0 = C.cache_v + (size_t)pg0 * 32768 + g * 64; const float* v1 = C.cache_v + (size_t)pg1 * 32768 + g * 64;
#pragma unroll
            for (int q = 0; q < 5; ++q) { const int u0 = lt + q * 448, u = u0 < 2048 ? u0 : 2047; const int key = u >> 3, d8 = u & 7; const float* p = (key < 128 ? k0 + (size_t)key * 256 : k1 + (size_t)(key - 128) * 256) + 8 * d8;
                s.kv[q][0] = __builtin_nontemporal_load((const GAS f32x4*)p); s.kv[q][1] = __builtin_nontemporal_load((const GAS f32x4*)(p + 4)); }
#pragma unroll
            for (int q = 0; q < 3; ++q) { const int u0 = lt + q * 448, u = u0 < 1024 ? u0 : 1023; const int kq = u >> 4, d4 = u & 15;
#pragma unroll
                for (int j = 0; j < 4; ++j) { const int key = 4 * kq + j; s.vv[q][j] = __builtin_nontemporal_load((const GAS f32x4*)((key < 128 ? v0 + (size_t)key * 256 : v1 + (size_t)(key - 128) * 256) + 4 * d4)); } }
        };
        auto commit = [&](int buf, const LSet& s) {
            int tid_l = tid_f; asm volatile("" : "+v"(tid_l)); const int lt = tid_l - 64;
            LAS unsigned char* Kl = C.lds + buf * 65536; LAS unsigned char* Vl = Kl + 32768;
#pragma unroll
            for (int q = 0; q < 5; ++q) { const int u0 = lt + q * 448, u = u0 < 2048 ? u0 : 2047; const int key = u >> 3, d8 = u & 7;
                *(LAS bf16x8*)(Kl + ((((key >> 4) * 2 + (d8 >> 2)) * 64) + (d8 & 3) * 16 + (key & 15)) * 16) = pack44(s.kv[q][0], s.kv[q][1]); }
#pragma unroll
            for (int q = 0; q < 3; ++q) { const int u0 = lt + q * 448, u = u0 < 1024 ? u0 : 1023; const int kq = u >> 4, d4 = u & 15, key0 = 4 * kq, ks8 = key0 >> 5, kp = key0 & 31, hi = kp >> 4, gq = (kp >> 2) & 3;
#pragma unroll
                for (int e = 0; e < 4; ++e) { const int d = 4 * d4 + e; v2u o; o.x = pk2(s.vv[q][0][e], s.vv[q][1][e]); o.y = pk2(s.vv[q][2][e], s.vv[q][3][e]);
                    *(LAS v2u*)(Vl + ((((d >> 4) * 8 + ks8) * 64) + 16 * gq + (d & 15)) * 16 + 8 * hi) = o; } }
        };
        issue(0, A); issue(1, B); commit(0, A); issue(2, A);
        LDS_BARRIER();
#pragma unroll 1
        for (int i = 0; i < nit; i += 2) {
            commit(1, B); issue(i + 3, B); LDS_BARRIER();
            if (i + 1 < nit) { commit(0, A); issue(i + 4, A); LDS_BARRIER(); }
        }
    } else {
        LDS_BARRIER();
#pragma unroll 1
        for (int i = 0; i < nit; ++i) {
            const int it = seq[1 + i], bi = i & 1;
            int tid_l = tid_f; asm volatile("" : "+v"(tid_l)); const int lane = tid_l & 63, il = lane & 15, g4 = lane >> 4;
            const int cnt = (int)__hip_atomic_load(C.ctl + CW_SCNT + it, __ATOMIC_RELAXED, __HIP_MEMORY_SCOPE_AGENT);
            const int g = (it >> 6) & 3, seqi = it >> 8;
            int q32[2], sl[2]; bool ok[2]; bf16x8 qf[2][2];
#pragma unroll
            for (int nt = 0; nt < 2; ++nt) { const int pi = nt * 16 + il; ok[nt] = pi < cnt; const unsigned e = SL[(size_t)it * 32 + (ok[nt] ? pi : 0)]; q32[nt] = e & 31; sl[nt] = e >> 5;
                const bf16* qp = Q + (size_t)(MP + seqi * 8 + (q32[nt] >> 2)) * DM + (4 * g + (q32[nt] & 3)) * 64 + 8 * g4;
                qf[nt][0] = *(const GAS bf16x8*)qp; qf[nt][1] = *(const GAS bf16x8*)(qp + 32); }
            float m[2], l[2]; f32x4 ot[4][2];
            moba_tile<false>(LdsK{C.lds + bi * 65536, lane}, LdsV{C.lds + bi * 65536 + 32768, lane}, qf, 16, 0, lane, m, l, ot);
#pragma unroll
            for (int nt = 0; nt < 2; ++nt) if (ok[nt]) { const size_t rec = ((size_t)(seqi * 8 + (q32[nt] >> 2)) * 16 + 4 * g + (q32[nt] & 3)) * 3 + sl[nt];
#pragma unroll
                for (int mt = 0; mt < 4; ++mt) *(GAS f32x4*)(SP + rec * 68 + 16 * mt + 4 * g4) = ot[mt][nt];
                if (g4 == 0) { SP[rec * 68 + 64] = m[nt]; SP[rec * 68 + 65] = l[nt]; } }
            LDS_BARRIER();
        }
    }
}
DI void attn_p13_prompt(const Ctx& C, int wi, int nw) {
    int lane = C.lane, il = lane & 15, g4 = lane >> 4;
    LAS unsigned char* Kl = C.lds; LAS unsigned char* Vl = C.lds + 32768; LAS int* start = (LAS int*)(C.lds + 65536);
    LAS int* wtot = (LAS int*)(C.lds + 65536 + 4352);
    { const unsigned c0 = __hip_atomic_load(C.ctl + CW_PCNT + 2 * C.tid, __ATOMIC_RELAXED, __HIP_MEMORY_SCOPE_AGENT), c1 = __hip_atomic_load(C.ctl + CW_PCNT + 2 * C.tid + 1, __ATOMIC_RELAXED, __HIP_MEMORY_SCOPE_AGENT);
      const int t0 = (int)(c0 + 255) >> 8, t1 = (int)(c1 + 255) >> 8; int s = t0 + t1, inc = s;
#pragma unroll
      for (int o = 1; o < 64; o <<= 1) { const int v = __shfl_up(inc, o); if (lane >= o) inc += v; }
      if (lane == 63) wtot[C.wave] = inc;
      LDS_WAIT(); __syncthreads();
      int wb = 0;
#pragma unroll
      for (int w = 0; w < 8; ++w) if (w < C.wave) wb += wtot[w];
      const int ex = wb + inc - s; start[2 * C.tid] = ex; start[2 * C.tid + 1] = ex + t0; if (C.tid == NTHR - 1) start[1024] = ex + s;
      LDS_WAIT(); __syncthreads(); }
    const int T = start[1024], per = (T + nw - 1) / nw, i_lo = wi * per, i_hi = (i_lo + per < T) ? i_lo + per : T;
    const bf16* Q = WSP(bf16, WS_Q); const bf16* KB = WSP(bf16, WS_KB); const bf16* VTP = WSP(bf16, WS_VTP); const unsigned* LIST = WSP(unsigned, WS_LIST);
    bf16* OP = WSP(bf16, WS_OPART); float* ML = WSP(float, WS_ML);
    int cur_blk = -1;
    auto find = [&](int item, int& lid, int& tile) { int lo = 0, hi = 1024; while (hi - lo > 1) { const int mid = (lo + hi) >> 1; if (start[mid] <= item) lo = mid; else hi = mid; } lid = lo; tile = item - start[lo]; };
    auto ld_entries = [&](int lid, int tile, int lane_, unsigned (&e)[2]) {
#pragma unroll
        for (int nt = 0; nt < 2; ++nt) { const int pi = tile * 256 + (lane_ >> 6) * 0 + ((C.wave * 32 + nt * 16 + (lane_ & 15)) & 255); e[nt] = LIST[(size_t)lid * 8192 + ((tile * 256 + C.wave * 32 + nt * 16 + (lane_ & 15)) & 8191)]; (void)pi; } };
    auto ld_q = [&](int lid, const unsigned (&e)[2], int lane_, bf16x8 (&qf)[2][2]) { const int h = 4 * ((lid >> 7) & 3) + (lid & 3), b = lid >> 9;
#pragma unroll
        for (int nt = 0; nt < 2; ++nt) { const bf16* qp = Q + (size_t)(b * SEQ + (e[nt] & 8191)) * DM + h * 64 + 8 * (lane_ >> 4); qf[nt][0] = *(const GAS bf16x8*)qp; qf[nt][1] = *(const GAS bf16x8*)(qp + 32); } };
    int lidC = 0, tileC = 0; unsigned eC[2];
    if (i_lo < i_hi) { find(i_lo, lidC, tileC); ld_entries(lidC, tileC, lane, eC); }
#pragma unroll 1
    for (int item = i_lo; item < i_hi; ++item) {
        int tid_l = C.tid; asm volatile("" : "+v"(tid_l)); lane = tid_l & 63; il = lane & 15; g4 = lane >> 4;
        const int lid = lidC, tile = tileC, h4 = lid & 3, n = (lid >> 2) & 31, g = (lid >> 7) & 3, b = lid >> 9, blkid = lid >> 2;
        const int cnt = (int)__hip_atomic_load(C.ctl + CW_PCNT + lid, __ATOMIC_RELAXED, __HIP_MEMORY_SCOPE_AGENT);
        bf16x8 qfC[2][2]; ld_q(lidC, eC, lane, qfC);
        int lidN, tileN; unsigned eN[2]; find(item + 1 < i_hi ? item + 1 : i_hi - 1, lidN, tileN); ld_entries(lidN, tileN, lane, eN);
        if (blkid != cur_blk) { LDS_BARRIER(); stage_kv(tid_l, KB + (size_t)(b * SEQ + n * 256) * 256 + g * 64, VTP + (size_t)blkid * 64 * 256, Kl, Vl); cur_blk = blkid; LDS_BARRIER(); }
        const int h = 4 * g + h4;
        if (tile * 256 + C.wave * 32 < cnt) {
            float m[2], l[2]; f32x4 ot[4][2];
            moba_tile<false>(LdsK{Kl, lane}, LdsV{Vl, lane}, qfC, 16, 0, lane, m, l, ot);
#pragma unroll
            for (int nt = 0; nt < 2; ++nt) if (tile * 256 + C.wave * 32 + nt * 16 + il < cnt) { const size_t rec = ((size_t)(b * SEQ + (int)(eC[nt] & 8191u)) * 16 + h) * 3 + ((eC[nt] >> 13) & 3u);
#pragma unroll
                for (int mt = 0; mt < 4; ++mt) { v2u o; o.x = pk2(ot[mt][nt][0], ot[mt][nt][1]); o.y = pk2(ot[mt][nt][2], ot[mt][nt][3]); *(GAS v2u*)(OP + rec * 64 + 16 * mt + 4 * g4) = o; }
                if (g4 == 0) *(GAS f32x2*)(ML + rec * 2) = (f32x2){m[nt], l[nt]}; }
        }
        lidC = lidN; tileC = tileN; eC[0] = eN[0]; eC[1] = eN[1];
    }
    __syncthreads();
}
DI void attn_p13(const Ctx& C, unsigned long long* dacc) {
    unsigned long long p13_t0_ = 0ull; (void)p13_t0_; (void)dacc;
    { Ctx C1 = C; C1.lane = lane_id(); C1.tid = C1.wave * 64 + C1.lane; P13_T(6); attn_p13_prompt(C1, C.vcu, C.G); P13_TE(6); }
    { Ctx C2 = C; C2.lane = lane_id(); C2.tid = C2.wave * 64 + C2.lane; P13_T(7); attn_p13_sample(C2, C.vcu, C.G); P13_TE(7); }
}
DI void attn_p14(const Ctx& C) {
    int lane = C.lane, il = lane & 15, g4 = lane >> 4;
    LAS unsigned char* Kl = C.lds; LAS unsigned char* Vl = C.lds + 32768;
    const bf16* Q = WSP(bf16, WS_Q); const bf16* KB = WSP(bf16, WS_KB); const bf16* VB = WSP(bf16, WS_VB); const bf16* VTP = WSP(bf16, WS_VTP);
    const bf16* OP = WSP(bf16, WS_OPART); const float* ML = WSP(float, WS_ML); bf16* ATT = WSP(bf16, WS_OG);
#pragma unroll 1
    for (int it = C.vcu; it < 256; it += C.G) { const int n = it & 31, g = (it >> 5) & 3, b = it >> 7;
        LDS_BARRIER(); stage_kv(C.tid, KB + (size_t)(b * SEQ + n * 256) * 256 + g * 64, VTP + (size_t)it * 64 * 256, Kl, Vl); LDS_BARRIER();
        const int nsl = n < 3 ? n : 3;
#pragma unroll 1
        for (int h4 = 0; h4 < 4; ++h4) { { int tid_l = C.tid; asm volatile("" : "+v"(tid_l)); lane = tid_l & 63; il = lane & 15; g4 = lane >> 4; }
            const int h = 4 * g + h4, q0 = C.wave * 32; bf16x8 qf[2][2];
#pragma unroll
            for (int nt = 0; nt < 2; ++nt) { const bf16* qp = Q + (size_t)(b * SEQ + n * 256 + q0 + nt * 16 + il) * DM + h * 64 + 8 * g4; qf[nt][0] = *(const GAS bf16x8*)qp; qf[nt][1] = *(const GAS bf16x8*)(qp + 32); }
            float m[2], l[2]; f32x4 ot[4][2];
            moba_tile<true>(LdsK{Kl, lane}, LdsV{Vl, lane}, qf, 2 * C.wave + 2, q0, lane, m, l, ot);
            f32x2 mlv[2][3]; v2u opv[2][3][4];
#pragma unroll
            for (int nt = 0; nt < 2; ++nt) { const size_t rec = ((size_t)(b * SEQ + n * 256 + q0 + nt * 16 + il) * 16 + h) * 3;
#pragma unroll
                for (int s = 0; s < 3; ++s) { const size_t rs = rec + (s < nsl ? s : 0); mlv[nt][s] = *(const GAS f32x2*)(ML + rs * 2);
#pragma unroll
                    for (int mt = 0; mt < 4; ++mt) opv[nt][s][mt] = *(const GAS v2u*)(OP + rs * 64 + 16 * mt + 4 * g4); } }
#pragma unroll
            for (int nt = 0; nt < 2; ++nt) { const int row = b * SEQ + n * 256 + q0 + nt * 16 + il;
                float M = m[nt];
#pragma unroll
                for (int s = 0; s < 3; ++s) if (s < nsl) M = fmaxf(M, mlv[nt][s][0]);
                const float LOG2E = 1.4426950408889634f; const float w0 = exp2_f((m[nt] - M) * LOG2E); float L = l[nt] * w0, ws[3];
#pragma unroll
                for (int s = 0; s < 3; ++s) { ws[s] = (s < nsl) ? exp2_f((mlv[nt][s][0] - M) * LOG2E) : 0.f; L += (s < nsl) ? mlv[nt][s][1] * ws[s] : 0.f; }
                const float inv = 1.f / L;
#pragma unroll
                for (int mt = 0; mt < 4; ++mt) { f32x4 o = ot[mt][nt] * w0;
#pragma unroll
                    for (int s = 0; s < 3; ++s) if (s < nsl) { const v2u pv = opv[nt][s][mt]; o += (f32x4){bflo(pv.x), bfhi(pv.x), bflo(pv.y), bfhi(pv.y)} * ws[s]; }
                    o = o * inv; v2u w; w.x = pk2(o[0], o[1]); w.y = pk2(o[2], o[3]); *(GAS v2u*)(ATT + (size_t)row * DM + h * 64 + 16 * mt + 4 * g4) = w; } }
        }
    }
    const float* SP = WSP(float, WS_SPART);
    for (int idx = (C.vcu * NTHR + C.tid) >> 4; idx < 32 * 8 * 16; idx += (C.G * NTHR) >> 4) { const int sub = C.tid & 15, h = idx & 15, t = (idx >> 4) & 7, seq = idx >> 7, row = MP + seq * 8 + t, g = h >> 2;
        const v2u qv = *(const GAS v2u*)(Q + (size_t)row * DM + h * 64 + 4 * sub); const float q0 = bflo(qv.x), q1 = bfhi(qv.x), q2 = bflo(qv.y), q3 = bfhi(qv.y);
        const size_t rec = ((size_t)(seq * 8 + t) * 16 + h) * 3;
        float M = -__builtin_inff(), sc[8];
#pragma unroll
        for (int t2 = 0; t2 < 8; ++t2) { const v2u kv = *(const GAS v2u*)(KB + (size_t)(MP + seq * 8 + t2) * 256 + g * 64 + 4 * sub);
            float s = (q0 * bflo(kv.x) + q1 * bfhi(kv.x)) + (q2 * bflo(kv.y) + q3 * bfhi(kv.y));
            s += __shfl_xor(s, 1); s += __shfl_xor(s, 2); s += __shfl_xor(s, 4); s += __shfl_xor(s, 8);
            s = (t2 <= t) ? s * SM_SCALE : -__builtin_inff(); sc[t2] = s; M = fmaxf(M, s); }
        float ms[3], ls[3];
#pragma unroll
        for (int s = 0; s < 3; ++s) { ms[s] = SP[(rec + s) * 68 + 64]; ls[s] = SP[(rec + s) * 68 + 65]; M = fmaxf(M, ms[s]); }
        f32x4 o = {0.f, 0.f, 0.f, 0.f}; float L = 0.f;
#pragma unroll
        for (int s = 0; s < 3; ++s) { const float w = __expf(ms[s] - M); L += ls[s] * w; o += *(const GAS f32x4*)(SP + (rec + s) * 68 + 4 * sub) * w; }
#pragma unroll
        for (int t2 = 0; t2 < 8; ++t2) { const float p = __expf(sc[t2] - M); L += p; const v2u vv = *(const GAS v2u*)(VB + (size_t)(MP + seq * 8 + t2) * 256 + g * 64 + 4 * sub);
            o += (f32x4){bflo(vv.x), bfhi(vv.x), bflo(vv.y), bfhi(vv.y)} * p; }
        const float inv = 1.f / L; v2u w; w.x = pk2(o[0] * inv, o[1] * inv); w.y = pk2(o[2] * inv, o[3] * inv);
        *(GAS v2u*)(ATT + (size_t)row * DM + h * 64 + 4 * sub) = w;
    }
}
template <class EPI, int MTI = 4, int NTJ = 4, int PER = 4> DI void sgemm_phase(const Ctx& C, const bf16* A  , const bf16* Bt  , int K, int ntn, const EPI& epi, int wk0 = 0, int nwk = 0) {
    const int wi = (nwk ? C.rr - wk0 : C.vcu), nw = (nwk ? nwk : C.G);
    if (wi < 0 || wi >= nw) return;
    LAS float* red = (LAS float*)C.lds;
    constexpr int per = PER;
    constexpr int RT = 16 * MTI, CT = 16 * NTJ;
#pragma unroll 1
    for (int tile = wi; tile < (256 / RT) * ntn; tile += nw) {
        int tid_l = C.tid; asm volatile("" : "+v"(tid_l)); const int lane = tid_l & 63, il = lane & 15, g4 = lane >> 4;
        const int m0 = (tile / ntn) * RT, nt = tile % ntn;
        f32x4 acc[MTI][NTJ];
#pragma unroll
        for (int i = 0; i < MTI; ++i)
#pragma unroll
            for (int j = 0; j < NTJ; ++j) acc[i][j] = (f32x4){0.f, 0.f, 0.f, 0.f};
        const bf16* ap = A + (size_t)(m0 + il) * K + (size_t)C.wave * per * 32 + 8 * g4;
        const bf16* bp[NTJ];
#pragma unroll
        for (int j = 0; j < NTJ; ++j) bp[j] = Bt + (size_t)(epi.brow(nt, j) + il) * K + (size_t)C.wave * per * 32 + 8 * g4;
        bf16x8 af[PER][MTI], bfr[PER][NTJ];
#pragma unroll
        for (int s = 0; s < PER; ++s) {
#pragma unroll
            for (int i = 0; i < MTI; ++i) af[s][i] = *(const GAS bf16x8*)(ap + (size_t)(16 * i) * K + 32 * s);
#pragma unroll
            for (int j = 0; j < NTJ; ++j) bfr[s][j] = *(const GAS bf16x8*)(bp[j] + 32 * s); }
#pragma unroll
        for (int s = 0; s < PER; ++s)
#pragma unroll
            for (int i = 0; i < MTI; ++i)
#pragma unroll
                for (int j = 0; j < NTJ; ++j) acc[i][j] = mfma16(af[s][i], bfr[s][j], acc[i][j]);
        LAS float* my = red + C.wave * (RT * CT);
#pragma unroll
        for (int i = 0; i < MTI; ++i)
#pragma unroll
            for (int j = 0; j < NTJ; ++j)
#pragma unroll
                for (int r = 0; r < 4; ++r) my[(16 * i + 4 * g4 + r) * CT + 16 * j + il] = acc[i][j][r];
        LDS_BARRIER();
        if (tid_l < RT * CT / 8) { const int row = tid_l / (CT / 8), c8 = tid_l % (CT / 8); f32x4 s0 = {0.f, 0.f, 0.f, 0.f}, s1 = s0;
#pragma unroll
          for (int w = 0; w < 8; ++w) { s0 += *(const LAS f32x4*)(red + w * (RT * CT) + row * CT + 8 * c8); s1 += *(const LAS f32x4*)(red + w * (RT * CT) + row * CT + 8 * c8 + 4); }
          *(LAS f32x4*)(red + row * CT + 8 * c8) = s0; *(LAS f32x4*)(red + row * CT + 8 * c8 + 4) = s1; }
        LDS_BARRIER();
        epi.store(red, m0, nt, tid_l);
        LDS_BARRIER();
    }
}
struct SEpiBf16 { bf16* O; int ldc;
    DI int brow(int nt, int j) const { return nt * 64 + 16 * j; }
    DI void store(const LAS float* t, int m0, int nt, int tid) const { const int row = tid >> 3, c8 = tid & 7; const f32x4 a = *(const LAS f32x4*)(t + row * 64 + 8 * c8), b = *(const LAS f32x4*)(t + row * 64 + 8 * c8 + 4);
        *(GAS bf16x8*)(O + (size_t)(MP + m0 + row) * ldc + nt * 64 + 8 * c8) = pack44(a, b); } };
struct SEpiF32 { float* O; int ldc;
    DI int brow(int nt, int j) const { return nt * 64 + 16 * j; }
    DI void store(const LAS float* t, int m0, int nt, int tid) const { const int row = tid >> 3, c8 = tid & 7; float* o = O + (size_t)(MP + m0 + row) * ldc + nt * 64 + 8 * c8;
        *(GAS f32x4*)o = *(const LAS f32x4*)(t + row * 64 + 8 * c8); *(GAS f32x4*)(o + 4) = *(const LAS f32x4*)(t + row * 64 + 8 * c8 + 4); } };
struct SEpiSwiglu { bf16* O;
    DI int brow(int nt, int j) const { const int hc = 32 * nt; return (hc >> 7) * 256 + (hc & 127) + (j >> 1) * 128 + (j & 1) * 16; }
    DI void store(const LAS float* t, int m0, int nt, int tid) const { const int row = tid >> 3, c8 = tid & 7; if (c8 < 4) { float v[8];
#pragma unroll
            for (int e = 0; e < 8; ++e) v[e] = silu_f(t[row * 64 + 8 * c8 + e]) * t[row * 64 + 32 + 8 * c8 + e];
            *(GAS bf16x8*)(O + (size_t)(MP + m0 + row) * FF + 32 * nt + 8 * c8) = pack8(v); } } };
struct SEpiQkv { bf16 *Q, *KB, *VB; float* out; const f32x2* tab;
    DI int brow(int nt, int j) const { return nt * 64 + 16 * j; }
    DI void store(const LAS float* t, int m0, int nt, int tid) const { const int row = tid >> 3, c8 = tid & 7, srow = m0 + row, grow = MP + srow;
        const f32x4 a = *(const LAS f32x4*)(t + row * 64 + 8 * c8), b = *(const LAS f32x4*)(t + row * 64 + 8 * c8 + 4);
        if (nt < 20) { const int pi = 8192 + (srow & 7); const f32x4 t0 = *(const GAS f32x4*)(tab + pi * 32 + 4 * c8), t1 = *(const GAS f32x4*)(tab + pi * 32 + 4 * c8 + 2);
            const float cs[4] = {t0[0], t0[2], t1[0], t1[2]}, sn[4] = {t0[1], t0[3], t1[1], t1[3]}; float o1[4], o2[4];
#pragma unroll
            for (int e = 0; e < 4; ++e) { o1[e] = a[e] * cs[e] - b[e] * sn[e]; o2[e] = b[e] * cs[e] + a[e] * sn[e]; }
            v2u w1, w2; w1.x = pk2(o1[0], o1[1]); w1.y = pk2(o1[2], o1[3]); w2.x = pk2(o2[0], o2[1]); w2.y = pk2(o2[2], o2[3]);
            if (nt < 16) { bf16* p = Q + (size_t)grow * DM + nt * 64 + 4 * c8; *(GAS v2u*)p = w1; *(GAS v2u*)(p + 32) = w2; }
            else { bf16* p = KB + (size_t)grow * 256 + (nt - 16) * 64 + 4 * c8; *(GAS v2u*)p = w1; *(GAS v2u*)(p + 32) = w2;
                float* f = out + O_SK + (size_t)srow * 256 + (nt - 16) * 64 + 4 * c8; *(GAS f32x4*)f = (f32x4){o1[0], o1[1], o1[2], o1[3]}; *(GAS f32x4*)(f + 32) = (f32x4){o2[0], o2[1], o2[2], o2[3]}; }
        } else { const int col = (nt - 20) * 64 + 8 * c8; *(GAS bf16x8*)(VB + (size_t)grow * 256 + col) = pack44(a, b);
            float* f = out + O_SV + (size_t)srow * 256 + col; *(GAS f32x4*)f = a; *(GAS f32x4*)(f + 4) = b; } } };
struct SEpiF32s { bf16* O; int ldc;
    DI int brow(int nt, int j) const { return nt * 32 + 16 * j; }
    DI void store(const LAS float* t, int m0, int nt, int tid) const { if (tid < 128) { const int row = tid >> 2, c8 = tid & 3;
        *(GAS bf16x8*)(O + (size_t)(MP + m0 + row) * ldc + nt * 32 + 8 * c8) = pack44(*(const LAS f32x4*)(t + row * 32 + 8 * c8), *(const LAS f32x4*)(t + row * 32 + 8 * c8 + 4)); } } };
constexpr int NPHASE = 20;
struct Args { const void* in[22]; float* out; unsigned char* ws; int ph_lo, ph_hi, li, pad; };
__global__ void __launch_bounds__(NTHR, 2) yoco_fwd(Args args) {
    extern __shared__ __attribute__((aligned(16))) unsigned char lds_raw[];
    Ctx C;
    C.lds = (LAS unsigned char*)lds_raw;
    C.wave = __builtin_amdgcn_readfirstlane((int)threadIdx.x >> 6); C.lane = lane_id(); C.tid = C.wave * 64 + C.lane;
#define REFRESH() do { C.lane = lane_id(); C.tid = C.wave * 64 + C.lane; } while (0)
    C.G = gridDim.x; { const int bx = blockIdx.x; C.vcu = (C.G % 8 == 0) ? (bx % 8) * (C.G / 8) + bx / 8 : bx; C.rr = bx; }
    C.x_prompt = (const float*)args.in[0]; C.x_sample = (const float*)args.in[1]; C.state_conv = (const float*)args.in[2]; C.state_delta = (const float*)args.in[3];
    C.cache_k = (const float*)args.in[4]; C.cache_v = (const float*)args.in[5]; C.page_table = (const int*)args.in[6]; C.ln_g = (const float*)args.in[7]; C.ln_b = (const float*)args.in[8];
    C.a_w_in = (const float*)args.in[9]; C.a_conv = (const float*)args.in[10]; C.a_log = (const float*)args.in[11]; C.a_dtb = (const float*)args.in[12]; C.a_norm = (const float*)args.in[13];
    C.a_w_out = (const float*)args.in[14]; C.kv_w_k = (const float*)args.in[15]; C.kv_w_v = (const float*)args.in[16]; C.b_w_q = (const float*)args.in[17]; C.b_w_o = (const float*)args.in[18];
    C.w_gate = (const float*)args.in[19]; C.w_up = (const float*)args.in[20]; C.w_down = (const float*)args.in[21];
    C.out = args.out; C.ws = args.ws; C.ctl = (gu32*)(args.ws + WS_CTL);
    volatile LAS unsigned* MISC = (volatile LAS unsigned*)(C.lds + MISC_OFF);
    if (C.tid < 64) MISC[C.tid] = 0u;
    __syncthreads();
    const int lo = args.ph_lo, hi = args.ph_hi;
#if defined(PROBE_DLY)
    unsigned long long dly_t0_ = 0ull, dly_span_ = 0ull;
#define DLY_BEGIN(n) do { if ((n) == PROBE_DLY && (int)blockIdx.x == PROBE_BLK) dly_t0_ = __builtin_amdgcn_s_memrealtime(); } while (0)
#define DLY_END(n) do { if ((n) == PROBE_DLY && (int)blockIdx.x == PROBE_BLK) dly_span_ += __builtin_amdgcn_s_memrealtime() - dly_t0_; } while (0)
#define DLY_ACC (&dly_span_)
#else
#define DLY_ACC ((unsigned long long*)nullptr)
#define DLY_BEGIN(n) do { } while (0)
#define DLY_END(n) do { } while (0)
#endif
    XcdBarrier bar; bar.bar = (unsigned*)(C.ctl + 32768) + args.li * 4096; bar.x = 0; bar.st = nullptr;
    if (hi - lo > 1) { bar = xcd_barrier_post((unsigned*)(C.ctl + 32768) + args.li * 4096, MISC + 8, C.tid);
        if (C.tid == 0) __hip_atomic_store(C.ctl + 30208 + blockIdx.x, xb_xcc_id() + 1u, __ATOMIC_RELAXED, __HIP_MEMORY_SCOPE_AGENT); }
#define IN(k) (lo <= (k) && (k) < hi)
#define PLACE_IDS() do { if (IN(0) && IN(1) && C.G == 256) { REFRESH(); unsigned less_ = 0u; if (C.tid < 256) { const unsigned xm = __hip_atomic_load(C.ctl + 30208 + blockIdx.x, __ATOMIC_RELAXED, __HIP_MEMORY_SCOPE_AGENT), xt = __hip_atomic_load(C.ctl + 30208 + C.tid, __ATOMIC_RELAXED, __HIP_MEMORY_SCOPE_AGENT); \
            less_ = ((xt << 16) | (unsigned)C.tid) < ((xm << 16) | (unsigned)blockIdx.x) ? 1u : 0u; } \
        const unsigned pc_ = (unsigned)__builtin_popcountll(__ballot(less_ != 0u)); if (C.lane == 0) MISC[16 + C.wave] = pc_; __syncthreads(); \
        unsigned vid_ = 0u; for (int w_ = 0; w_ < 8; ++w_) vid_ += MISC[16 + w_]; vid_ = (unsigned)__builtin_amdgcn_readfirstlane((int)vid_); __syncthreads(); \
        C.vcu = (int)vid_; C.rr = (int)((vid_ % 32u) * 8u + vid_ / 32u); } } while (0)
#if defined(PROBE_TS)
    unsigned long long* ts_ = (unsigned long long*)(C.ws + WS_GLB + 65536);
#define STAMP(k) do { if (blockIdx.x == 0 && C.tid == 0) ts_[k] = __builtin_amdgcn_s_memrealtime(); } while (0)
#define SEAM(k) do { if (IN(k) && IN((k) + 1)) { REFRESH(); xcd_barrier(bar, C.tid); STAMP((k) + 1); } } while (0)
    STAMP(0);
#else
#if defined(PROBE_DLY)
#define SEAM(k) do { if (IN(k) && IN((k) + 1)) { REFRESH(); const bool m_ = (PROBE_DLY == 300 || PROBE_DLY == 301 + (k)) && (int)blockIdx.x == PROBE_BLK; unsigned long long t0_ = 0ull; if (m_) t0_ = __builtin_amdgcn_s_memrealtime(); xcd_barrier(bar, C.tid); if (m_) dly_span_ += __builtin_amdgcn_s_memrealtime() - t0_; } } while (0)
#else
#define SEAM(k) do { if (IN(k) && IN((k) + 1)) { REFRESH(); xcd_barrier(bar, C.tid); } } while (0)
#endif
#endif
    if (IN(0)) { REFRESH(); DLY_BEGIN(100 + 0); p0_weights(C, 0, 6784, C.vcu * NWAVES + C.wave, C.G * NWAVES);
#if defined(CMEANS_IN_P0)
        p0_cmeans(C, C.vcu * NWAVES + C.wave, C.G * NWAVES);
#endif
        __syncthreads(); p0_x(C); __syncthreads(); }
    DLY_END(100 + 0);
    SEAM(0);
    PLACE_IDS();
    if (IN(1)) { REFRESH(); DLY_BEGIN(100 + 1); { SEpiBf16 se{WSP(bf16, WS_PROJ), NPROJ}; sgemm_phase(C, WSP(bf16, WS_XB) + (size_t)MP * DM, WSP(bf16, WS_WIN), DM, NPROJ / 64, se); }
        pg8::Gemm g{WSP(bf16, WS_XB), WSP(bf16, WS_WIN), MP, NPROJ, DM}; pg8::StaticOrder S; S.init(MP, NPROJ, C.G, C.rr);
        pg8::EpiBf16<0> E{WSP(bf16, WS_PROJ), NPROJ, nullptr, 0, 0, 1.f};
        pg8::gemm_phase<pg8::EpiBf16<0>, pg8::StaticOrder, true, true>(C.lds, g, S, E, C.tid); }
    DLY_END(100 + 1);
    SEAM(1);
    if (IN(2)) { REFRESH(); DLY_BEGIN(100 + 2); conv_state_out(C); prep_phase(C, DLY_ACC); }
    DLY_END(100 + 2);
    SEAM(2);
    if (IN(3)) { REFRESH(); DLY_BEGIN(100 + 3);
#if defined(PROBE_XCC)
        volatile LAS int* role_ = (volatile LAS int*)(C.lds + MISC_OFF + 64);
        if (C.tid == 0) { const unsigned x = xb_xcc_id(); const unsigned t = __hip_atomic_fetch_add(C.ctl + 24576 + 64 * x, 1u, __ATOMIC_RELAXED, __HIP_MEMORY_SCOPE_AGENT); role_[0] = (int)(t < 16u ? (x * 16u + t) : (128u + x * 16u + (t - 16u))); }
        __syncthreads();
        const int vbx = role_[0];
#else
        const int vbx = C.rr;
#endif
        if (vbx < NSCAN) { DLY_BEGIN(1); scan_phase(C, vbx, DLY_ACC); DLY_END(1);
        } else { DLY_BEGIN(2); sample_delta(C, vbx - NSCAN); DLY_END(2); DLY_BEGIN(3);
            p0_cmeans(C, (vbx - NSCAN) * NWAVES + C.wave, (C.G - NSCAN) * NWAVES);
            DLY_END(3);
            LDS_BARRIER(); p0_weights(C, 6784, 12288, (vbx - NSCAN) * NWAVES + C.wave, (C.G - NSCAN) * NWAVES); p0_rope(C, (vbx - NSCAN) * NTHR + C.tid, (C.G - NSCAN) * NTHR);
        } }
    DLY_END(100 + 3);
    SEAM(3);
    if (IN(4)) { REFRESH(); DLY_BEGIN(100 + 4); onorm_phase(C); }
    DLY_END(100 + 4);
    SEAM(4);
    if (IN(5)) { REFRESH(); DLY_BEGIN(100 + 5); { SEpiF32s se{WSP(bf16, WS_MIX), DM}; sgemm_phase<SEpiF32s, 2, 2>(C, WSP(bf16, WS_OG) + (size_t)MP * DM, WSP(bf16, WS_WOUT), DM, DM / 32, se); }
        pg8::Gemm g{WSP(bf16, WS_OG), WSP(bf16, WS_WOUT), MP, DM, DM}; pg8::StaticOrder S; S.init(MP, DM, C.G, C.rr);
        pg8::EpiBf16<0> E{WSP(bf16, WS_MIX), DM, nullptr, 0, 0, 1.f}; pg8::gemm_phase<pg8::EpiBf16<0>, pg8::StaticOrder, true, true>(C.lds, g, S, E, C.tid); }
    DLY_END(100 + 5);
    SEAM(5);
    if (IN(6)) { REFRESH(); DLY_BEGIN(100 + 6); ln_phase<true>(C, WSP(bf16, WS_XB), WSP(bf16, WS_XB) + (size_t)MP * DM, WSP(bf16, WS_MIX), C.ln_g, C.ln_b, nullptr, WSP(bf16, WS_HB)); }
    DLY_END(100 + 6);
    SEAM(6);
    if (IN(7)) { REFRESH(); DLY_BEGIN(100 + 7);         pg8::Gemm g{WSP(bf16, WS_HB), WSP(bf16, WS_WGU0), MP, NGU, DM}; pg8::StaticOrder S; S.init(MP, NGU, C.G, C.rr);
        EpiSwiglu E{WSP(bf16, WS_FF)}; pg8::gemm_phase<EpiSwiglu, pg8::StaticOrder, true, true>(C.lds, g, S, E, C.tid);
        { REFRESH(); SEpiSwiglu se{WSP(bf16, WS_FF)}; sgemm_phase(C, WSP(bf16, WS_HB) + (size_t)MP * DM, WSP(bf16, WS_WGU0), DM, FF / 32, se, 128, 128); } }
    DLY_END(100 + 7);
    SEAM(7);
    if (IN(8)) { REFRESH(); DLY_BEGIN(100 + 8); { SEpiF32s se{WSP(bf16, WS_MIX), DM}; sgemm_phase<SEpiF32s, 2, 2, 11>(C, WSP(bf16, WS_FF) + (size_t)MP * FF, WSP(bf16, WS_WD0), FF, DM / 32, se); }
        pg8::Gemm g{WSP(bf16, WS_FF), WSP(bf16, WS_WD0), MP, DM, FF}; pg8::StaticOrder S; S.init(MP, DM, C.G, C.rr);
        pg8::EpiBf16<0> E{WSP(bf16, WS_MIX), DM, nullptr, 0, 0, 1.f}; pg8::gemm_phase<pg8::EpiBf16<0>, pg8::StaticOrder, true, true>(C.lds, g, S, E, C.tid); }
    DLY_END(100 + 8);
    SEAM(8);
    if (IN(9)) { REFRESH(); DLY_BEGIN(100 + 9); ln_phase<true>(C, WSP(bf16, WS_HB), WSP(bf16, WS_HB) + (size_t)MP * DM, WSP(bf16, WS_MIX), C.ln_g + DM, C.ln_b + DM, nullptr, WSP(bf16, WS_X1B)); }
    DLY_END(100 + 9);
    SEAM(9);
    if (IN(10)) { REFRESH(); DLY_BEGIN(100 + 10);         pg8::Gemm g{WSP(bf16, WS_X1B), WSP(bf16, WS_WQKV), MP, NQKV, DM}; pg8::StaticOrder S; S.init(MP, NQKV, C.G, C.rr);
        EpiQkvRope E{WSP(bf16, WS_Q), WSP(bf16, WS_KB), WSP(bf16, WS_VB), C.out, WSP(f32x2, WS_ROPE)}; pg8::gemm_phase<EpiQkvRope, pg8::StaticOrder, true, true>(C.lds, g, S, E, C.tid);
        { REFRESH(); SEpiQkv se{WSP(bf16, WS_Q), WSP(bf16, WS_KB), WSP(bf16, WS_VB), C.out, WSP(f32x2, WS_ROPE)}; sgemm_phase(C, WSP(bf16, WS_X1B) + (size_t)MP * DM, WSP(bf16, WS_WQKV), DM, NQKV / 64, se, 128, 128); } }
    DLY_END(100 + 10);
    SEAM(10);
    if (IN(11)) { REFRESH(); DLY_BEGIN(100 + 11); attn_p11(C); }
    DLY_END(100 + 11);
    SEAM(11);
    if (IN(12)) { REFRESH(); DLY_BEGIN(100 + 12); attn_p12(C); }
    DLY_END(100 + 12);
    SEAM(12);
    if (IN(13)) { REFRESH(); DLY_BEGIN(100 + 13); attn_p13(C, DLY_ACC); }
    DLY_END(100 + 13);
    SEAM(13);
    if (IN(14)) { REFRESH(); DLY_BEGIN(100 + 14); attn_p14(C); }
    DLY_END(100 + 14);
    SEAM(14);
    if (IN(15)) { REFRESH(); DLY_BEGIN(100 + 15); { SEpiF32s se{WSP(bf16, WS_MIX), DM}; sgemm_phase<SEpiF32s, 2, 2>(C, WSP(bf16, WS_OG) + (size_t)MP * DM, WSP(bf16, WS_WO), DM, DM / 32, se); }
        pg8::Gemm g{WSP(bf16, WS_OG), WSP(bf16, WS_WO), MP, DM, DM}; pg8::StaticOrder S; S.init(MP, DM, C.G, C.rr);
        pg8::EpiBf16<0> E{WSP(bf16, WS_MIX), DM, nullptr, 0, 0, 1.f}; pg8::gemm_phase<pg8::EpiBf16<0>, pg8::StaticOrder, true, true>(C.lds, g, S, E, C.tid); }
    DLY_END(100 + 15);
    SEAM(15);
    if (IN(16)) { REFRESH(); DLY_BEGIN(100 + 16); ln_phase<true>(C, WSP(bf16, WS_X1B), WSP(bf16, WS_X1B) + (size_t)MP * DM, WSP(bf16, WS_MIX), C.ln_g + 2 * DM, C.ln_b + 2 * DM, nullptr, WSP(bf16, WS_HB)); }
    DLY_END(100 + 16);
    SEAM(16);
    if (IN(17)) { REFRESH(); DLY_BEGIN(100 + 17);         pg8::Gemm g{WSP(bf16, WS_HB), WSP(bf16, WS_WGU1), MP, NGU, DM}; pg8::StaticOrder S; S.init(MP, NGU, C.G, C.rr);
        EpiSwiglu E{WSP(bf16, WS_FF)}; pg8::gemm_phase<EpiSwiglu, pg8::StaticOrder, true, true>(C.lds, g, S, E, C.tid);
        { REFRESH(); SEpiSwiglu se{WSP(bf16, WS_FF)}; sgemm_phase(C, WSP(bf16, WS_HB) + (size_t)MP * DM, WSP(bf16, WS_WGU1), DM, FF / 32, se, 128, 128); } }
    DLY_END(100 + 17);
    SEAM(17);
    if (IN(18)) { REFRESH(); DLY_BEGIN(100 + 18); { SEpiF32s se{WSP(bf16, WS_MIX), DM}; sgemm_phase<SEpiF32s, 2, 2, 11>(C, WSP(bf16, WS_FF) + (size_t)MP * FF, WSP(bf16, WS_WD1), FF, DM / 32, se); }
        pg8::Gemm g{WSP(bf16, WS_FF), WSP(bf16, WS_WD1), MP, DM, FF}; pg8::StaticOrder S; S.init(MP, DM, C.G, C.rr);
        pg8::EpiBf16<0> E{WSP(bf16, WS_MIX), DM, nullptr, 0, 0, 1.f}; pg8::gemm_phase<pg8::EpiBf16<0>, pg8::StaticOrder, true, true>(C.lds, g, S, E, C.tid); }
    DLY_END(100 + 18);
    SEAM(18);
    if (IN(19)) { REFRESH(); DLY_BEGIN(100 + 19); ln_phase<true>(C, WSP(bf16, WS_HB), WSP(bf16, WS_HB) + (size_t)MP * DM, WSP(bf16, WS_MIX), C.ln_g + 3 * DM, C.ln_b + 3 * DM, C.out + O_Y, nullptr); }
    DLY_END(100 + 19);

#if defined(PROBE_XBAR)
    for (int xb_ = 0; xb_ < 20; ++xb_) { REFRESH(); xcd_barrier(bar, C.tid); }
#endif
#if defined(PROBE_DLY)
    if ((int)blockIdx.x == PROBE_BLK) { const unsigned long long t0 = __builtin_amdgcn_s_memrealtime(); while (__builtin_amdgcn_s_memrealtime() - t0 < dly_span_) __builtin_amdgcn_s_sleep(8); }
#endif
#if defined(PROBE_TS)
    REFRESH(); xcd_barrier(bar, C.tid); STAMP(20);
    if (blockIdx.x == 0) { __syncthreads();
        const size_t offs[10] = {O_Y, O_Y + (size_t)MP * DM, O_PCONV, O_PDELTA, O_PK, O_PV, O_SCONV, O_SDELTA, O_SK, O_SV};
        const int pa[10] = {0, 2, 14, 4, 6, 8, 10, 12, 15, 16};
        for (int o = 0; o < 10; ++o) { const bool single = (o == 2 || o == 8 || o == 9);
            unsigned long long d0 = (__hip_atomic_load(ts_ + pa[o] + 1, __ATOMIC_RELAXED, __HIP_MEMORY_SCOPE_AGENT) - __hip_atomic_load(ts_ + pa[o], __ATOMIC_RELAXED, __HIP_MEMORY_SCOPE_AGENT)) / 100ull;
            unsigned long long d1 = single ? 0ull : (__hip_atomic_load(ts_ + pa[o] + 2, __ATOMIC_RELAXED, __HIP_MEMORY_SCOPE_AGENT) - __hip_atomic_load(ts_ + pa[o] + 1, __ATOMIC_RELAXED, __HIP_MEMORY_SCOPE_AGENT)) / 100ull;
            if (d0 > 315ull) d0 = 315ull; if (d1 > 315ull) d1 = 315ull;
            const int N = single ? (int)d0 : (int)(d0 * 316ull + d1);
            for (int i = C.tid; i < N; i += NTHR) C.out[offs[o] + i] = __uint_as_float(0xAAAAAAAAu); } }
#endif
#undef IN
#undef SEAM
}

#ifndef MK_SPLIT
#define MK_SPLIT 0
#endif
extern "C" void kernel_launch(void* const* d_in, const int* in_sizes, int n_in, void* d_out, int out_size, void* d_ws, size_t ws_size, hipStream_t stream) {
    static int grid = 0;
    if (grid == 0) {
        if (n_in != 22 || ws_size < WS_END) { fprintf(stderr, "kernel_launch: unexpected sizes n_in %d out %d ws %zu\n", n_in, out_size, ws_size); grid = -1; return; }
        int dev = 0, cus = 0;
        if (hipGetDevice(&dev) != hipSuccess || hipDeviceGetAttribute(&cus, hipDeviceAttributeMultiprocessorCount, dev) != hipSuccess) { grid = -1; return; }
        if (hipFuncSetAttribute((const void*)yoco_fwd, hipFuncAttributeMaxDynamicSharedMemorySize, LDS_BYTES) != hipSuccess) { fprintf(stderr, "kernel_launch: hipFuncSetAttribute failed\n"); grid = -1; return; }
        int per_cu = 0;
        if (hipOccupancyMaxActiveBlocksPerMultiprocessor(&per_cu, (const void*)yoco_fwd, NTHR, LDS_BYTES) != hipSuccess || per_cu < 1) { fprintf(stderr, "kernel_launch: occupancy query says %d\n", per_cu); }
        (void)hipGetLastError();
        grid = cus;
    }
    if (grid < 0) return;
    (void)hipMemsetAsync((char*)d_ws + WS_CTL, 0, CTL_ZERO_BYTES, stream);
    Args a{};
    for (int i = 0; i < 22; ++i) a.in[i] = d_in[i];
    a.out = (float*)d_out; a.ws = (unsigned char*)d_ws;
#if MK_SPLIT
#ifndef MK_REPEAT
#define MK_REPEAT 0u
#endif
    for (int p = 0; p < NPHASE; ++p) { a.ph_lo = p; a.ph_hi = p + 1; a.li = p; const int reps = ((MK_REPEAT >> p) & 1u) ? 2 : 1;
        for (int r = 0; r < reps; ++r) hipLaunchKernelGGL(yoco_fwd, dim3(grid), dim3(NTHR), LDS_BYTES, stream, a); }
#else
    a.ph_lo = 0; a.ph_hi = NPHASE; a.li = 0; hipLaunchKernelGGL(yoco_fwd, dim3(grid), dim3(NTHR), LDS_BYTES, stream, a);
#endif
}
```

```cpp
#include <hip/hip_runtime.h>
#include <cstdio>
#include <cstdint>
namespace pg8 {
#define PG8_LAS __attribute__((address_space(3)))
typedef unsigned short bf16_t;
typedef short bf16x8 __attribute__((ext_vector_type(8)));
typedef float f32x4 __attribute__((ext_vector_type(4)));
typedef unsigned u32x4 __attribute__((ext_vector_type(4)));
constexpr int BM = 256, BK = 64, HALF = 128, HTB = HALF * BK * 2  , STAGE_BYTES = 8 * HTB, NXCD = 8, WGM = 8;

__host__ __device__ __forceinline__ int lds_byte(int r, int c) { const int st = (r >> 4) * 2 + (c >> 5), rr = r & 15, cc = c & 31, ob = rr * 64 + cc * 2; return st * 1024 + (ob ^ (((ob >> 9) & 1) << 5)); }
__host__ __device__ __forceinline__ void stage_rc(int b, int& R, int& C) { const int st = b / 1024, sb = b % 1024, swz = sb ^ (((sb >> 9) & 1) << 5); R = (st >> 1) * 16 + swz / 64; C = (st & 1) * 32 + (swz % 64) / 2; }
__host__ __device__ __forceinline__ int perm32(int rho) { const int n = rho >> 4, i = rho & 15; return 8 * (i >> 2) + 4 * n + (i & 3); }

struct Unit { int pm, pn; };
struct Gemm { const bf16_t* A; const bf16_t* Bt; int M, N, K; };

struct StaticOrder {
    int nM, nN, nwg, G, c;
    __host__ __device__ void init(int M, int N, int G_, int c_) { nM = M / BM; nN = N / BM; nwg = nM * nN; G = G_; c = c_; }
    __host__ __device__ bool next(int i, Unit& u) const {
        const long L = (long)i * G + c; if (L >= nwg) return false;
        int wgid = (int)L; { const int q = nwg / NXCD, r = nwg % NXCD, xcd = wgid % NXCD, off = wgid / NXCD; wgid = (xcd < r ? xcd * (q + 1) : r * (q + 1) + (xcd - r) * q) + off; }
        const int nig = WGM * nN, gid = wgid / nig, fm = gid * WGM, gsz = (nM - fm) < WGM ? (nM - fm) : WGM;
        u.pm = fm + ((wgid % nig) % gsz); u.pn = (wgid % nig) / gsz; return true;
    }
    __device__ __forceinline__ void a_ready(const Unit&) const {}
    __device__ __forceinline__ void done(const Unit&) const {}
};

__device__ __forceinline__ unsigned cvt_pk_bf16(float lo, float hi) { unsigned r; asm volatile("v_cvt_pk_bf16_f32 %0, %1, %2" : "=v"(r) : "v"(lo), "v"(hi)); return r; }
typedef float f32x2 __attribute__((ext_vector_type(2)));
__device__ __forceinline__ f32x2 gelu_pk(f32x2 v) {
    const f32x2 av = __builtin_elementwise_abs(v), d = av * 0.2316418882f + 1.0f;
    f32x2 t; t.x = __builtin_amdgcn_rcpf(d.x); t.y = __builtin_amdgcn_rcpf(d.y);
    f32x2 q = t * 0.5307027145f + (-0.7265760135f); q = q * t + 0.7107068705f; q = q * t + (-0.142248368f); q = q * t + 0.127414796f; q = q * t;
    const f32x2 s = (v * v) * (-0.72134752044f);
    f32x2 e; e.x = __builtin_amdgcn_exp2f(s.x); e.y = __builtin_amdgcn_exp2f(s.y);
    const f32x2 m = v * (q * e), r = v - m;
    f32x2 o; o.x = v.x < 0.f ? m.x : r.x; o.y = v.y < 0.f ? m.y : r.y; return o;
}

template <int ACT  > struct EpiBf16 {
    static constexpr bool PERM = true, AFTER_DRAIN = false; static_assert(ACT == 0 || ACT == 1, "EpiBf16: ACT is 0 (none) or 1 (gelu_pk)");
    bf16_t* O; int ldc; const float* bias; int split_cols; size_t split_stride; float scale0;
    __device__ __forceinline__ void operator()(const f32x4 (&acc)[2][2][4][2], const Unit& u, int wr, int wc, int fr, int fq) const {
        const int row0 = u.pm * BM + wr * 64 + fr; int colt = u.pn * BM; bf16_t* base = O;
        float sc = 1.f; if (split_cols) { const int t = colt / split_cols; base += (size_t)t * split_stride; colt -= t * split_cols; if (t == 0) sc = scale0; }
        const int col0 = colt + wc * 32 + 8 * fq, bcol0 = u.pn * BM + wc * 32 + 8 * fq;
        f32x4 bv[2][2];
#pragma unroll
        for (int bj = 0; bj < 2; ++bj)
#pragma unroll
            for (int n = 0; n < 2; ++n) bv[bj][n] = bias ? *(const f32x4*)(bias + bcol0 + bj * HALF + 4 * n) : (f32x4){0.f, 0.f, 0.f, 0.f};
#pragma unroll
        for (int ai = 0; ai < 2; ++ai)
#pragma unroll
            for (int m = 0; m < 4; ++m) { bf16_t* rowp = base + (size_t)(row0 + ai * HALF + m * 16) * ldc + col0;
#pragma unroll
                for (int bj = 0; bj < 2; ++bj) { f32x4 v0 = acc[ai][bj][m][0] + bv[bj][0], v1 = acc[ai][bj][m][1] + bv[bj][1];
                    if (ACT == 1) { f32x2 a = gelu_pk((f32x2){v0[0], v0[1]}), b = gelu_pk((f32x2){v0[2], v0[3]}), c = gelu_pk((f32x2){v1[0], v1[1]}), d = gelu_pk((f32x2){v1[2], v1[3]});
                        v0 = (f32x4){a.x, a.y, b.x, b.y}; v1 = (f32x4){c.x, c.y, d.x, d.y}; }
                    v0 = v0 * sc; v1 = v1 * sc; u32x4 w; w.x = cvt_pk_bf16(v0[0], v0[1]); w.y = cvt_pk_bf16(v0[2], v0[3]); w.z = cvt_pk_bf16(v1[0], v1[1]); w.w = cvt_pk_bf16(v1[2], v1[3]);
                    *(u32x4*)(rowp + bj * HALF) = w; } }
    }
};

struct PanelStats {
    unsigned* xbuf;
    unsigned* cnt;
    unsigned* tmo;
    int ntn; float eps;
    unsigned code;
    __device__ __forceinline__ bool run(const f32x4 (&v)[2][2][4][2], const Unit& u, int wr, int wc, int fr, int fq, PG8_LAS unsigned char* lds, int wid, int lane) const {
        typedef float f32x2v __attribute__((ext_vector_type(2)));
        PG8_LAS f32x2v* P = (PG8_LAS f32x2v*)lds;
        PG8_LAS f32x2v* S = (PG8_LAS f32x2v*)(lds + 8192);
        PG8_LAS unsigned* flag = (PG8_LAS unsigned*)(lds + 8192 + 2048);
#pragma unroll
        for (int ai = 0; ai < 2; ++ai)
#pragma unroll
            for (int m = 0; m < 4; ++m) {
                float s = 0.f;
#pragma unroll
                for (int bj = 0; bj < 2; ++bj)
#pragma unroll
                    for (int n = 0; n < 2; ++n) { const f32x4 x = v[ai][bj][m][n]; s += (x[0] + x[1]) + (x[2] + x[3]); }
                s += __shfl_xor(s, 16); s += __shfl_xor(s, 32);
                const float mw = s * (1.0f / 64.0f); float q = 0.f;
#pragma unroll
                for (int bj = 0; bj < 2; ++bj)
#pragma unroll
                    for (int n = 0; n < 2; ++n) { const f32x4 d = v[ai][bj][m][n] - mw; q += (d[0] * d[0] + d[1] * d[1]) + (d[2] * d[2] + d[3] * d[3]); }
                q += __shfl_xor(q, 16); q += __shfl_xor(q, 32);
                if (fq == 0) P[(ai * HALF + wr * 64 + m * 16 + fr) * 4 + wc] = (f32x2v){mw, q};
            }
        asm volatile("s_waitcnt lgkmcnt(0)" ::: "memory"); __builtin_amdgcn_s_barrier(); asm volatile("" ::: "memory");
#if defined(BROKEN_EXCHANGE_NO_WAIT)
#warning BROKEN CONTROL BUILD: the row-statistics exchange does not wait; results are wrong by design
        if (blockIdx.x >= 64) { const long long t0_ = clock64(); while (clock64() - t0_ < 60000) __builtin_amdgcn_s_sleep(8); }
#endif
        const int row = wid * 32 + (lane & 31);
        if (lane < 32) {
            const f32x2v a = P[row * 4 + 0], b = P[row * 4 + 1], c = P[row * 4 + 2], d = P[row * 4 + 3];
            const float mt = (a.x + b.x + c.x + d.x) * 0.25f;
            const float da = a.x - mt, db = b.x - mt, dc = c.x - mt, dd = d.x - mt;
            const float m2 = (a.y + b.y) + (c.y + d.y) + 64.0f * ((da * da + db * db) + (dc * dc + dd * dd));
            unsigned long long* slot = (unsigned long long*)xbuf + ((size_t)(u.pm * BM + row) * 4 + u.pn);
            __hip_atomic_store(slot, ((unsigned long long)__float_as_uint(m2) << 32) | __float_as_uint(mt), __ATOMIC_RELAXED, __HIP_MEMORY_SCOPE_AGENT);
        }
        asm volatile("s_waitcnt vmcnt(0)" ::: "memory");
        if (lane == 0) __hip_atomic_fetch_add(cnt + 64 * u.pm, 1u, __ATOMIC_RELAXED, __HIP_MEMORY_SCOPE_AGENT);
        if (wid == 0) {
            bool dead = false; const unsigned long long t0 = __builtin_amdgcn_s_memrealtime(); const unsigned want = 8u * (unsigned)ntn;
            for (;;) {
#if defined(BROKEN_EXCHANGE_NO_WAIT)
                break;
#endif
                if ((unsigned)__builtin_amdgcn_readfirstlane(__hip_atomic_load(cnt + 64 * u.pm, __ATOMIC_RELAXED, __HIP_MEMORY_SCOPE_AGENT)) >= want) break;
                if (__builtin_amdgcn_s_memrealtime() - t0 > 2000000ull) {
                    if (lane == 0) { unsigned expect = 0u; __hip_atomic_compare_exchange_strong(tmo + 1, &expect, code | (unsigned)(u.pm & 0xff), __ATOMIC_RELAXED, __ATOMIC_RELAXED, __HIP_MEMORY_SCOPE_AGENT);
                                     __hip_atomic_store(tmo, 1u, __ATOMIC_RELAXED, __HIP_MEMORY_SCOPE_AGENT); }
                    dead = true; break; }
                __builtin_amdgcn_s_sleep(2);
            }
            __builtin_amdgcn_fence(__ATOMIC_ACQUIRE, "agent");
            if (lane == 0) flag[0] = dead ? 1u : 0u;
        }
        asm volatile("s_waitcnt vmcnt(0) lgkmcnt(0)" ::: "memory"); __builtin_amdgcn_s_barrier(); asm volatile("" ::: "memory");
        const bool bad = flag[0] != 0u;
        if (lane < 32) {
            const unsigned long long* slot = (const unsigned long long*)xbuf + (size_t)(u.pm * BM + row) * 4; float mt[4], m2[4]; float ms = 0.f;
#pragma unroll
            for (int t = 0; t < 4; ++t) { if (t < ntn) { const unsigned long long w = __hip_atomic_load(slot + t, __ATOMIC_RELAXED, __HIP_MEMORY_SCOPE_AGENT); mt[t] = __uint_as_float((unsigned)w); m2[t] = __uint_as_float((unsigned)(w >> 32)); } else { mt[t] = 0.f; m2[t] = 0.f; } ms += mt[t]; }
            const float mean = ms / (float)ntn; float q = 0.f;
#pragma unroll
            for (int t = 0; t < 4; ++t) if (t < ntn) { const float dm = mt[t] - mean; q += m2[t] + 256.0f * dm * dm; }
            S[row] = (f32x2v){mean, 1.0f / sqrtf(q / (256.0f * (float)ntn) + eps)};
        }
        asm volatile("s_waitcnt lgkmcnt(0)" ::: "memory"); __builtin_amdgcn_s_barrier(); asm volatile("" ::: "memory");
        return bad;
    }
};
struct EpiLnRes {
    static constexpr bool PERM = false, AFTER_DRAIN = true;
    const float* base; float* out; int ldc; const float* bias; PanelStats st; unsigned poison;
    __device__ __forceinline__ void fused(f32x4 (&acc)[2][2][4][2], const Unit& u, int wr, int wc, int fr, int fq, PG8_LAS unsigned char* lds, int wid, int lane) const {
        typedef float f32x2v __attribute__((ext_vector_type(2)));
        const PG8_LAS f32x2v* S = (const PG8_LAS f32x2v*)(lds + 8192);
        const int col0 = u.pn * BM + wc * 32 + 4 * fq;
#pragma unroll
        for (int bj = 0; bj < 2; ++bj)
#pragma unroll
            for (int n = 0; n < 2; ++n) { const f32x4 bv = bias ? *(const f32x4*)(bias + col0 + bj * HALF + n * 16) : (f32x4){0.f, 0.f, 0.f, 0.f};
#pragma unroll
                for (int ai = 0; ai < 2; ++ai)
#pragma unroll
                    for (int m = 0; m < 4; ++m) acc[ai][bj][m][n] += bv; }
        f32x4 pre[4][2][2];
#pragma unroll
        for (int m = 0; m < 4; ++m) { const size_t off = (size_t)(u.pm * BM + wr * 64 + m * 16 + fr) * ldc + col0;
#pragma unroll
            for (int bj = 0; bj < 2; ++bj)
#pragma unroll
                for (int n = 0; n < 2; ++n) pre[m][bj][n] = *(const f32x4*)(base + off + bj * HALF + n * 16); }
        const bool bad = st.run(acc, u, wr, wc, fr, fq, lds, wid, lane) || poison != 0u;
        const float qnan = __builtin_nanf("");
#pragma unroll
        for (int ai = 0; ai < 2; ++ai)
#pragma unroll
            for (int m = 0; m < 4; ++m) { const int r = ai * HALF + wr * 64 + m * 16 + fr; const f32x2v sr = S[r]; const size_t off = (size_t)(u.pm * BM + r) * ldc + col0;
#pragma unroll
                for (int bj = 0; bj < 2; ++bj)
#pragma unroll
                    for (int n = 0; n < 2; ++n) { const f32x4 bs = ai == 0 ? pre[m][bj][n] : *(const f32x4*)(base + off + bj * HALF + n * 16); f32x4 o = bs + (acc[ai][bj][m][n] - sr.x) * sr.y;
                        if (bad) o = (f32x4){qnan, qnan, qnan, qnan}; *(f32x4*)(out + off + bj * HALF + n * 16) = o; }
                if (m & 1) asm volatile("" ::: "memory"); }
    }
};
struct EpiLnResLn {
    static constexpr bool PERM = false, AFTER_DRAIN = true;
    const float* base; float* out; bf16_t* xn; int ldc; const float* bias; PanelStats st1, st2; unsigned poison;
    __device__ __forceinline__ void fused(f32x4 (&acc)[2][2][4][2], const Unit& u, int wr, int wc, int fr, int fq, PG8_LAS unsigned char* lds, int wid, int lane) const {
        typedef float f32x2v __attribute__((ext_vector_type(2))); typedef unsigned u32x2v __attribute__((ext_vector_type(2)));
        const PG8_LAS f32x2v* S = (const PG8_LAS f32x2v*)(lds + 8192);
        const int col0 = u.pn * BM + wc * 32 + 4 * fq;
#pragma unroll
        for (int bj = 0; bj < 2; ++bj)
#pragma unroll
            for (int n = 0; n < 2; ++n) { const f32x4 bv = bias ? *(const f32x4*)(bias + col0 + bj * HALF + n * 16) : (f32x4){0.f, 0.f, 0.f, 0.f};
#pragma unroll
                for (int ai = 0; ai < 2; ++ai)
#pragma unroll
                    for (int m = 0; m < 4; ++m) acc[ai][bj][m][n] += bv; }
        bool bad = st1.run(acc, u, wr, wc, fr, fq, lds, wid, lane) || poison != 0u;
        const float qnan = __builtin_nanf("");
#pragma unroll
        for (int ai = 0; ai < 2; ++ai)
#pragma unroll
            for (int m = 0; m < 4; ++m) { const int r = ai * HALF + wr * 64 + m * 16 + fr; const f32x2v sr = S[r]; const size_t off = (size_t)(u.pm * BM + r) * ldc + col0;
#pragma unroll
                for (int bj = 0; bj < 2; ++bj)
#pragma unroll
                    for (int n = 0; n < 2; ++n) { const f32x4 bs = *(const f32x4*)(base + off + bj * HALF + n * 16); acc[ai][bj][m][n] = bs + (acc[ai][bj][m][n] - sr.x) * sr.y; }
                asm volatile("" : "+v"(acc[ai][0][m][0]), "+v"(acc[ai][0][m][1]), "+v"(acc[ai][1][m][0]), "+v"(acc[ai][1][m][1]));
                if (m & 1) asm volatile("" ::: "memory"); }
        const bool bad1 = bad;
        bad = st2.run(acc, u, wr, wc, fr, fq, lds, wid, lane) || bad;
#pragma unroll
        for (int ai = 0; ai < 2; ++ai)
#pragma unroll
            for (int m = 0; m < 4; ++m) { const int r = ai * HALF + wr * 64 + m * 16 + fr; const f32x2v sr = S[r]; const size_t off = (size_t)(u.pm * BM + r) * ldc + col0;
#pragma unroll
                for (int bj = 0; bj < 2; ++bj)
#pragma unroll
                    for (int n = 0; n < 2; ++n) { const f32x4 x1 = acc[ai][bj][m][n]; *(f32x4*)(out + off + bj * HALF + n * 16) = bad1 ? (f32x4){qnan, qnan, qnan, qnan} : x1;
                        const f32x4 o = (x1 - sr.x) * sr.y; u32x2v w; w.x = cvt_pk_bf16(o[0], o[1]); w.y = cvt_pk_bf16(o[2], o[3]);
                        if (bad) { w.x = 0x7fc07fc0u; w.y = 0x7fc07fc0u; } *(u32x2v*)(xn + off + bj * HALF + n * 16) = w; }
                asm volatile("" ::: "memory"); }
    }
};

template <class Epi, class Sched, bool ALIGN_EPI = false, bool SP2 = false>
__device__ __forceinline__ void gemm_phase(PG8_LAS unsigned char* lds, const Gemm g, const Sched& S, const Epi& E, int tid_arg) {
    const int tid = tid_arg, wid = __builtin_amdgcn_readfirstlane(tid >> 6), lane = tid & 63, wr = wid >> 2, wc = wid & 3, fr = lane & 15, fq = lane >> 4;
    const int K = g.K, nt = K / BK;
    unsigned voffA[2], voffB[2];
#pragma unroll
    for (int i = 0; i < 2; ++i) { int R, C; stage_rc(tid * 16 + i * 8192, R, C); const int Rb = Epi::PERM ? ((R & ~31) + perm32(R & 31)) : R;
        voffA[i] = (unsigned)(R * K + C) * 2u; voffB[i] = (unsigned)(Rb * K + C) * 2u; }
    const size_t kstep = (size_t)(BK * 2);
    const size_t hstep = (size_t)HALF * K * 2;
    const size_t tstep = 2 * hstep;
    const unsigned ldsw = (unsigned)wid * 1024u;
    const int aoff = lds_byte(wr * 64 + fr, fq * 8), boff = lds_byte(wc * 32 + fr, fq * 8);
#define PG8_SA(b, h) (((b) * 2 + (h)) * HTB)
#define PG8_SB(b, h) ((4 + (b) * 2 + (h)) * HTB)
#define PG8_STAGE(bufoff, gbase, voff) do { _Pragma("unroll") for (int _i = 0; _i < 2; ++_i) \
        __builtin_amdgcn_global_load_lds((const unsigned*)((const char*)(gbase) + (voff)[_i]), (PG8_LAS unsigned*)(lds + (bufoff) + ldsw + _i * 8192), 16, 0, 0); } while (0)
#define PG8_LDA(dst, b, h) do { _Pragma("unroll") for (int m = 0; m < 4; ++m) _Pragma("unroll") for (int k = 0; k < 2; ++k) dst[m][k] = *(const PG8_LAS bf16x8*)(lds + PG8_SA(b, h) + aoff + m * 2048 + k * 1024); } while (0)
#define PG8_LDB(dst, b, h) do { _Pragma("unroll") for (int n = 0; n < 2; ++n) _Pragma("unroll") for (int k = 0; k < 2; ++k) dst[n][k] = *(const PG8_LAS bf16x8*)(lds + PG8_SB(b, h) + boff + n * 2048 + k * 1024); } while (0)
#define PG8_MMA(ai, bj, At, Bt) do { __builtin_amdgcn_s_setprio(1); _Pragma("unroll") for (int m = 0; m < 4; ++m) _Pragma("unroll") for (int n = 0; n < 2; ++n) _Pragma("unroll") for (int k = 0; k < 2; ++k) \
        acc[ai][bj][m][n] = __builtin_amdgcn_mfma_f32_16x16x32_bf16(Bt[n][k], At[m][k], acc[ai][bj][m][n], 0, 0, 0); __builtin_amdgcn_s_setprio(0); } while (0)
#define PG8_WAIT_V(n) asm volatile("s_waitcnt vmcnt(" #n ")" ::: "memory")
#define PG8_WAIT_L(n) asm volatile("s_waitcnt lgkmcnt(" #n ")" ::: "memory")
#define PG8_BAR __builtin_amdgcn_s_barrier()
#define PG8_SCHED __builtin_amdgcn_sched_barrier(0)
    Unit cur, nxt; int ui = 0;
    if (!S.next(0, cur)) return;
    f32x4 acc[2][2][4][2];
#pragma unroll
    for (int a = 0; a < 2; ++a)
#pragma unroll
        for (int b = 0; b < 2; ++b)
#pragma unroll
            for (int m = 0; m < 4; ++m)
#pragma unroll
                for (int n = 0; n < 2; ++n) acc[a][b][m][n] = (f32x4){0.f, 0.f, 0.f, 0.f};
    bf16x8 At[4][2], B0[2][2], B1[2][2];
    const char* cA = (const char*)g.A + (size_t)cur.pm * tstep; const char* cB = (const char*)g.Bt + (size_t)cur.pn * tstep;
    S.a_ready(cur);
    if constexpr (SP2) {
        PG8_STAGE(PG8_SB(0, 0), cB, voffB); PG8_STAGE(PG8_SB(0, 1), cB + hstep, voffB); PG8_STAGE(PG8_SA(0, 0), cA, voffA); PG8_STAGE(PG8_SA(0, 1), cA + hstep, voffA);
        if (wr == 1) PG8_BAR;
        PG8_WAIT_V(2); PG8_BAR;
        PG8_STAGE(PG8_SB(1, 0), cB + kstep, voffB); PG8_STAGE(PG8_SA(1, 0), cA + kstep, voffA); PG8_STAGE(PG8_SB(1, 1), cB + hstep + kstep, voffB);
        PG8_WAIT_V(6); PG8_BAR;
    } else {
        PG8_STAGE(PG8_SB(0, 0), cB, voffB); PG8_STAGE(PG8_SA(0, 0), cA, voffA); PG8_STAGE(PG8_SB(0, 1), cB + hstep, voffB); PG8_STAGE(PG8_SA(0, 1), cA + hstep, voffA);
        if (wr == 1) PG8_BAR;
        PG8_WAIT_V(4); PG8_BAR;
        PG8_STAGE(PG8_SB(1, 0), cB + kstep, voffB); PG8_STAGE(PG8_SA(1, 0), cA + kstep, voffA); PG8_STAGE(PG8_SB(1, 1), cB + hstep + kstep, voffB);
        PG8_WAIT_V(6); PG8_BAR;
    }
    for (;;) {
        const bool has_next = S.next(ui + 1, nxt);
        const char* nA = has_next ? (const char*)g.A + (size_t)nxt.pm * tstep : cA; const char* nB = has_next ? (const char*)g.Bt + (size_t)nxt.pn * tstep : cB;
        for (int t = 0; t < nt; t += 2) {
            const bool last = (t == nt - 2);
            const char* a1 = cA + (size_t)(t + 1) * kstep;
            const char* a2 = last ? nA : cA + (size_t)(t + 2) * kstep; const char* b2 = last ? nB : cB + (size_t)(t + 2) * kstep;
            const char* a3 = a2 + kstep; const char* b3 = b2 + kstep;
            if (last && has_next) S.a_ready(nxt);
            if constexpr (SP2) {
            PG8_LDB(B0, 0, 0); PG8_LDB(B1, 0, 1); PG8_SCHED; PG8_LDA(At, 0, 0); PG8_STAGE(PG8_SA(1, 1), a1 + hstep, voffA);
            PG8_WAIT_V(8); PG8_WAIT_L(0); PG8_BAR; PG8_MMA(0, 0, At, B0); PG8_MMA(0, 1, At, B1); PG8_BAR; PG8_SCHED;
            PG8_LDA(At, 0, 1); PG8_STAGE(PG8_SB(0, 0), b2, voffB); PG8_STAGE(PG8_SB(0, 1), b2 + hstep, voffB); PG8_STAGE(PG8_SA(0, 0), a2, voffA);
            PG8_WAIT_V(8); PG8_WAIT_L(0); PG8_BAR; PG8_MMA(1, 0, At, B0); PG8_MMA(1, 1, At, B1); PG8_BAR; PG8_SCHED;
            PG8_LDB(B0, 1, 0); PG8_LDB(B1, 1, 1); PG8_SCHED; PG8_LDA(At, 1, 0); PG8_STAGE(PG8_SA(0, 1), a2 + hstep, voffA);
            PG8_WAIT_V(8); PG8_WAIT_L(0); PG8_BAR; PG8_MMA(0, 0, At, B0); PG8_MMA(0, 1, At, B1); PG8_BAR; PG8_SCHED;
            PG8_LDA(At, 1, 1); PG8_STAGE(PG8_SB(1, 0), b3, voffB); PG8_STAGE(PG8_SB(1, 1), b3 + hstep, voffB); PG8_STAGE(PG8_SA(1, 0), a3, voffA);
            PG8_WAIT_V(8); PG8_WAIT_L(0); PG8_BAR; PG8_MMA(1, 0, At, B0); PG8_MMA(1, 1, At, B1); PG8_BAR; PG8_SCHED;
            } else {
            PG8_LDB(B0, 0, 0); PG8_SCHED; PG8_LDA(At, 0, 0); PG8_STAGE(PG8_SA(1, 1), a1 + hstep, voffA);
            PG8_WAIT_L(8); PG8_BAR; PG8_WAIT_L(0); PG8_MMA(0, 0, At, B0); PG8_BAR; PG8_SCHED;
            PG8_LDB(B1, 0, 1); PG8_STAGE(PG8_SB(0, 0), b2, voffB);
            PG8_BAR; PG8_WAIT_L(0); PG8_MMA(0, 1, At, B1); PG8_BAR;
            PG8_LDA(At, 0, 1); PG8_STAGE(PG8_SA(0, 0), a2, voffA);
            PG8_BAR; PG8_WAIT_L(0); PG8_MMA(1, 0, At, B0); PG8_BAR; PG8_SCHED;
            PG8_STAGE(PG8_SB(0, 1), b2 + hstep, voffB);
            PG8_WAIT_V(6); PG8_BAR; PG8_MMA(1, 1, At, B1); PG8_BAR;
            PG8_LDB(B0, 1, 0); PG8_SCHED; PG8_LDA(At, 1, 0); PG8_STAGE(PG8_SA(0, 1), a2 + hstep, voffA);
            PG8_WAIT_L(8); PG8_BAR; PG8_WAIT_L(0); PG8_MMA(0, 0, At, B0); PG8_BAR; PG8_SCHED;
            PG8_LDB(B1, 1, 1); PG8_STAGE(PG8_SB(1, 0), b3, voffB);
            PG8_BAR; PG8_WAIT_L(0); PG8_MMA(0, 1, At, B1); PG8_BAR;
            PG8_LDA(At, 1, 1); PG8_STAGE(PG8_SA(1, 0), a3, voffA);
            PG8_BAR; PG8_WAIT_L(0); PG8_MMA(1, 0, At, B0); PG8_BAR; PG8_SCHED;
            PG8_STAGE(PG8_SB(1, 1), b3 + hstep, voffB);
            PG8_WAIT_V(6); PG8_BAR; PG8_MMA(1, 1, At, B1); PG8_BAR;
            }
        }
        if constexpr (ALIGN_EPI) { if (wr == 0) PG8_BAR; }
        if constexpr (!Epi::AFTER_DRAIN) { E(acc, cur, wr, wc, fr, fq); S.done(cur); }
        if (!has_next) break;
#pragma unroll
        for (int a = 0; a < 2; ++a)
#pragma unroll
            for (int b = 0; b < 2; ++b)
#pragma unroll
                for (int m = 0; m < 4; ++m)
#pragma unroll
                    for (int n = 0; n < 2; ++n) acc[a][b][m][n] = (f32x4){0.f, 0.f, 0.f, 0.f};
        cur = nxt; cA = nA; cB = nB; ++ui;
        if constexpr (ALIGN_EPI) { if (wr == 1) PG8_BAR; }
    }
    PG8_WAIT_V(0);
    if constexpr (!ALIGN_EPI) { if (wr == 0) PG8_BAR; }
    PG8_BAR;
    if constexpr (Epi::AFTER_DRAIN) { E.fused(acc, cur, wr, wc, fr, fq, lds, wid, lane); S.done(cur); }
#undef PG8_SA
#undef PG8_SB
#undef PG8_STAGE
#undef PG8_LDA
#undef PG8_LDB
#undef PG8_MMA
#undef PG8_WAIT_V
#undef PG8_WAIT_L
#undef PG8_BAR
#undef PG8_SCHED
}
}
#define GAS __attribute__((address_space(1)))
#define LAS __attribute__((address_space(3)))
typedef unsigned short bf16;
typedef unsigned v4u __attribute__((ext_vector_type(4)));
typedef float f32x4 __attribute__((ext_vector_type(4)));
typedef short bf16x8 __attribute__((ext_vector_type(8)));
typedef GAS unsigned gu32;
typedef GAS unsigned long long gu64;
#define RLX_AGENT __ATOMIC_RELAXED, __HIP_MEMORY_SCOPE_AGENT
#define LDS_WAIT() asm volatile("s_waitcnt lgkmcnt(0)" ::: "memory")
#define VM_WAIT() asm volatile("s_waitcnt vmcnt(0)" ::: "memory")
__device__ __forceinline__ unsigned long long rt() { return __builtin_amdgcn_s_memrealtime(); }
__device__ __forceinline__ unsigned f2bf(float f) { unsigned u = __builtin_bit_cast(unsigned, f); return (u + 0x7fffu + ((u >> 16) & 1u)) >> 16; }
typedef float f32x2_cv __attribute__((ext_vector_type(2))); typedef __bf16 bf16x2_cv __attribute__((ext_vector_type(2)));
__device__ __forceinline__ unsigned pk2(float lo, float hi) { f32x2_cv v = {lo, hi}; bf16x2_cv b = __builtin_convertvector(v, bf16x2_cv); return __builtin_bit_cast(unsigned, b); }

#define XB_TMO      128
#define XB_XCNT(j)  (256  + 64 * (j))
#define XB_XSUB(j)  (1280 + 64 * (j))
#define XB_XGEN(j)  (2304 + 64 * (j))
#define XB_TOP      3328
#define XB_TOPGEN   3392
#define XCD_BAR_WORDS 3456
#define XB_SPIN_CAP (1u << 18)

__device__ __forceinline__ unsigned xb_ld(unsigned* p)              { return __hip_atomic_load(p, __ATOMIC_RELAXED, __HIP_MEMORY_SCOPE_AGENT); }
__device__ __forceinline__ unsigned xb_add(unsigned* p, unsigned v) { return __hip_atomic_fetch_add(p, v, __ATOMIC_RELAXED, __HIP_MEMORY_SCOPE_AGENT); }
__device__ __forceinline__ unsigned xb_xcc_id() { return (unsigned)__builtin_amdgcn_s_getreg((3 << 11) | 20) & 0xFu; }
#define XB_SPIN(cond, bar) do { unsigned _sp = 0; while (cond) { __builtin_amdgcn_s_sleep(1); \
    if ((++_sp & 255u) == 0u) { if (xb_ld(&(bar)[XB_TMO])) break; if (_sp > XB_SPIN_CAP) { atomicAdd(&(bar)[XB_TMO], 1u); break; } } } } while (0)

struct XcdBarrier {
    unsigned* bar; unsigned x;
    volatile LAS unsigned* st;
};

__device__ __forceinline__ XcdBarrier xcd_barrier_post(unsigned* bar, volatile LAS unsigned* st, int tid_arg) {
    XcdBarrier b; b.bar = bar; b.x = xb_xcc_id(); b.st = st;
    if (tid_arg == 0) (void)xb_add(&bar[XB_XCNT(b.x)], 1u);
    return b;
}
__device__ __forceinline__ void xcd_barrier_complete(unsigned* bar, unsigned x, unsigned& nloc, unsigned& nx) {
    const unsigned G = gridDim.x * gridDim.y * gridDim.z;
    unsigned sum, cnt, mine, sp = 0u;
    for (;;) {
        sum = 0u; cnt = 0u; mine = 0u;
#pragma unroll
        for (unsigned j = 0; j < 16; ++j) { const unsigned c = xb_ld(&bar[XB_XCNT(j)]); sum += c; cnt += (c > 0u) ? 1u : 0u; mine = (j == x) ? c : mine; }
        if (sum == G) break;
        __builtin_amdgcn_s_sleep(1);
        if ((++sp & 255u) == 0u) { if (xb_ld(&bar[XB_TMO])) break; if (sp > XB_SPIN_CAP) { atomicAdd(&bar[XB_TMO], 1u); break; } }
    }
    nloc = mine > 0u ? mine : 1u; nx = cnt > 0u ? cnt : 1u;
}

__device__ __forceinline__ void xcd_barrier(const XcdBarrier& b, int tid_arg) {
    asm volatile("s_waitcnt vmcnt(0)" ::: "memory");
    __syncthreads();
    if (tid_arg == 0) {
        unsigned* bar = b.bar;
        __builtin_amdgcn_s_waitcnt(0);
        unsigned nloc = b.st[0], nx = b.st[1];
        if (nloc == 0u) { xcd_barrier_complete(bar, b.x, nloc, nx); b.st[0] = nloc; b.st[1] = nx; }
        const unsigned old = xb_add(&bar[XB_XSUB(b.x)], 1u);
        const unsigned gen = old / nloc;
        if (old + 1u == (gen + 1u) * nloc) {
            __builtin_amdgcn_fence(__ATOMIC_RELEASE, "agent");
            asm volatile("s_waitcnt vmcnt(0)" ::: "memory");
            const unsigned og = xb_add(&bar[XB_TOP], 1u);
            const unsigned tg = og / nx;
            if (og + 1u == (tg + 1u) * nx) xb_add(&bar[XB_TOPGEN], 1u);
            else XB_SPIN(xb_ld(&bar[XB_TOPGEN]) == tg, bar);
            __builtin_amdgcn_fence(__ATOMIC_ACQUIRE, "agent");
            xb_add(&bar[XB_XGEN(b.x)], 1u);
            asm volatile("s_waitcnt vmcnt(0)" ::: "memory");
        } else {
            XB_SPIN(xb_ld(&bar[XB_XGEN(b.x)]) == gen, bar);
            __builtin_amdgcn_fence(__ATOMIC_ACQUIRE, "agent");
            asm volatile("s_waitcnt vmcnt(0)" ::: "memory");
        }
    }
    __syncthreads();
}
constexpr int NWAVES = 8, NTHR = 512;
constexpr int MP = 16384, MS = 256, MT = MP + MS, DM = 1024, SEQ = 8192;
constexpr int AINW = 4112, CONVD = 3072, NPROJ = 4096;
constexpr int FF = 2816, NGU = 5632, NQKV = 1536;
constexpr int NITEM = 2048;
constexpr float ALPHA = 1.4142135623730951f;
constexpr size_t O_Y = 0, O_PCONV = (size_t)MT * DM, O_PDELTA = O_PCONV + 18432, O_PK = O_PDELTA + 262144, O_PV = O_PK + 4194304,
                 O_SCONV = O_PV + 4194304, O_SDELTA = O_SCONV + 294912, O_SK = O_SDELTA + 4194304, O_SV = O_SK + 65536, O_END = O_SV + 65536;
constexpr size_t MiB = 1u << 20;
constexpr size_t WS_CTL = 0, CTL_ZERO_BYTES = 1 * MiB;
constexpr size_t WS_WIN = 2 * MiB, WS_WOUT = 10 * MiB, WS_WGU0 = 12 * MiB, WS_WD0 = 23 * MiB, WS_WQKV = 29 * MiB, WS_WO = 32 * MiB, WS_WGU1 = 34 * MiB, WS_WD1 = 45 * MiB;
constexpr size_t WS_ROPE = 51 * MiB, WS_AB = 54 * MiB, WS_CMEANS = 56 * MiB, WS_PMEANS = 58 * MiB, WS_GLB = 59 * MiB;
constexpr size_t WS_XB = 64 * MiB, WS_PROJ = 100 * MiB, WS_DEL = 232 * MiB, WS_VN = 376 * MiB, WS_O = 408 * MiB, WS_OG = 474 * MiB, WS_MIX = 508 * MiB,
                 WS_H = 574 * MiB, WS_HB = 640 * MiB, WS_FF = 674 * MiB, WS_X1 = 764 * MiB, WS_X1B = 830 * MiB, WS_Q = 864 * MiB, WS_KB = 897 * MiB, WS_VB = 906 * MiB,
                 WS_VTP = 915 * MiB, WS_LIST = 924 * MiB, WS_OPART = 956 * MiB, WS_ML = 1052 * MiB, WS_SLIST = 1058 * MiB, WS_SPART = 1059 * MiB, WS_END = 1064 * MiB;
constexpr int DEL_ITEM = 73728, DEL_QP = 16384, DEL_KTP = 32768, DEL_QKP = 49152, DEL_U = 57344;
constexpr int CW_BAR = 4096, CW_PCNT = 16384  , CW_SCNT = 20480  ;
constexpr int LDS_BYTES = 147456, MISC_OFF = 147456 - 256;
typedef unsigned v2u __attribute__((ext_vector_type(2)));
typedef float f32x2 __attribute__((ext_vector_type(2)));
#define DI __device__ __forceinline__
#define LDS_BARRIER() do { asm volatile("s_waitcnt lgkmcnt(0)" ::: "memory"); __builtin_amdgcn_s_barrier(); asm volatile("" ::: "memory"); } while (0)
DI int lane_id() { int l; asm volatile("v_mbcnt_lo_u32_b32 %0, -1, 0\n\tv_mbcnt_hi_u32_b32 %0, -1, %0" : "=v"(l)); return l; }
DI float bflo(unsigned u) { return __uint_as_float(u << 16); }
DI float bfhi(unsigned u) { return __uint_as_float(u & 0xffff0000u); }
DI float bf2f(unsigned short u) { return __uint_as_float((unsigned)u << 16); }
DI float silu_f(float x) { return x * __builtin_amdgcn_rcpf(1.f + __expf(-x)); }
DI float sigmoid_f(float x) { return __builtin_amdgcn_rcpf(1.f + __expf(-x)); }
DI float rowsum16(float v) {
    v += __builtin_bit_cast(float, __builtin_amdgcn_update_dpp(0, __builtin_bit_cast(int, v), 0x128, 0xf, 0xf, false));
    v += __builtin_bit_cast(float, __builtin_amdgcn_update_dpp(0, __builtin_bit_cast(int, v), 0x124, 0xf, 0xf, false));
    v += __builtin_bit_cast(float, __builtin_amdgcn_update_dpp(0, __builtin_bit_cast(int, v), 0x122, 0xf, 0xf, false));
    v += __builtin_bit_cast(float, __builtin_amdgcn_update_dpp(0, __builtin_bit_cast(int, v), 0x121, 0xf, 0xf, false));
    return v; }
DI float wsum(float v) {
#pragma unroll
    for (int o = 1; o < 64; o <<= 1) v += __shfl_xor(v, o);
    return v;
}
DI f32x4 mfma16(bf16x8 a, bf16x8 b, f32x4 c) { return __builtin_amdgcn_mfma_f32_16x16x32_bf16(a, b, c, 0, 0, 0); }
DI bf16x8 pack8(const float* v) { v4u r; r.x = pk2(v[0], v[1]); r.y = pk2(v[2], v[3]); r.z = pk2(v[4], v[5]); r.w = pk2(v[6], v[7]); return __builtin_bit_cast(bf16x8, r); }
DI bf16x8 pack44(f32x4 a, f32x4 b) { v4u r; r.x = pk2(a[0], a[1]); r.y = pk2(a[2], a[3]); r.z = pk2(b[0], b[1]); r.w = pk2(b[2], b[3]); return __builtin_bit_cast(bf16x8, r); }

struct Ctx {
    LAS unsigned char* lds; int tid, lane, wave, G, vcu, rr;
    const float *x_prompt, *x_sample, *state_conv, *state_delta, *cache_k, *cache_v; const int* page_table;
    const float *ln_g, *ln_b, *a_w_in, *a_conv, *a_log, *a_dtb, *a_norm, *a_w_out, *kv_w_k, *kv_w_v, *b_w_q, *b_w_o, *w_gate, *w_up, *w_down;
    float* out; unsigned char* ws; gu32* ctl;
};
#define WSP(T, off) ((T*)(C.ws + (off)))

DI void tr_item(const float* Wsrc, int ldsrc, int col, int k0, bf16* WT, int Kd, int rowdst0, LAS float* scr, int lane) {
    float tv[32];
#pragma unroll
    for (int i = 0; i < 32; ++i) tv[i] = Wsrc[(size_t)(k0 + 2 * i + (lane >> 5)) * ldsrc + col];
#pragma unroll
    for (int i = 0; i < 32; ++i) scr[(2 * i + (lane >> 5)) * 33 + (lane & 31)] = tv[i];
    LDS_WAIT(); asm volatile("" ::: "memory");
    const int c = lane & 7;
#pragma unroll
    for (int j = 0; j < 4; ++j) { const int n = (lane >> 3) + 8 * j; const LAS float* s = scr + (8 * c) * 33 + n;
        v4u o; o.x = pk2(s[0 * 33], s[1 * 33]); o.y = pk2(s[2 * 33], s[3 * 33]); o.z = pk2(s[4 * 33], s[5 * 33]); o.w = pk2(s[6 * 33], s[7 * 33]);
        *(GAS v4u*)(WT + (size_t)(rowdst0 + n) * Kd + k0 + 8 * c) = o; }
    LDS_WAIT(); asm volatile("" ::: "memory");
}
DI int rope_dmap(int cc) { return 4 * (cc >> 3) + (cc & 3) + 32 * ((cc >> 2) & 1); }

DI void p0_weights(const Ctx& C, int it_lo, int it_hi, int gw, int NGW) {
    LAS float* scr = (LAS float*)(C.lds + C.wave * 16384);
    const int lane = C.lane, nl = lane & 31;
    constexpr int I_IN = 16 * 128, I_SQ = 16 * 32, I_GU = 16 * 176, I_DN = 44 * 32, I_QKV = 16 * 48;
    constexpr int NIT = I_IN + I_SQ + I_GU + I_DN + I_QKV + I_SQ + I_GU + I_DN;
    if (it_hi > NIT) it_hi = NIT;
    for (int it = it_lo + gw; it < it_hi; it += NGW) {
        int r = it;
        if (r < I_IN) { const int kb = r / 128, nb = r % 128; tr_item(C.a_w_in, AINW, nb * 32 + nl, kb * 64, WSP(bf16, WS_WIN), DM, nb * 32, scr, lane); continue; } r -= I_IN;
        if (r < I_SQ) { const int kb = r / 32, nb = r % 32; tr_item(C.a_w_out, DM, nb * 32 + nl, kb * 64, WSP(bf16, WS_WOUT), DM, nb * 32, scr, lane); continue; } r -= I_SQ;
        if (r < I_GU) { const int kb = r / 176, nb = r % 176, n0 = nb * 32, tile = n0 >> 8, w = n0 & 255;
            tr_item(w < 128 ? C.w_gate : C.w_up, FF, tile * 128 + (w & 127) + nl, kb * 64, WSP(bf16, WS_WGU0), DM, n0, scr, lane); continue; } r -= I_GU;
        if (r < I_DN) { const int kb = r / 32, nb = r % 32; tr_item(C.w_down, DM, nb * 32 + nl, kb * 64, WSP(bf16, WS_WD0), FF, nb * 32, scr, lane); continue; } r -= I_DN;
        if (r < I_QKV) { const int kb = r / 48, nb = r % 48, n0 = nb * 32; const float* src; int ld, col;
            if (n0 < 1024) { src = C.b_w_q; ld = 1024; col = (n0 & ~63) + rope_dmap((n0 & 63) + nl); }
            else if (n0 < 1280) { src = C.kv_w_k; ld = 256; col = ((n0 - 1024) & ~63) + rope_dmap((n0 & 63) + nl); }
            else { src = C.kv_w_v; ld = 256; col = n0 - 1280 + nl; }
            tr_item(src, ld, col, kb * 64, WSP(bf16, WS_WQKV), DM, n0, scr, lane); continue; } r -= I_QKV;
        if (r < I_SQ) { const int kb = r / 32, nb = r % 32; tr_item(C.b_w_o, DM, nb * 32 + nl, kb * 64, WSP(bf16, WS_WO), DM, nb * 32, scr, lane); continue; } r -= I_SQ;
        if (r < I_GU) { const int kb = r / 176, nb = r % 176, n0 = nb * 32, tile = n0 >> 8, w = n0 & 255;
            tr_item((w < 128 ? C.w_gate : C.w_up) + (size_t)DM * FF, FF, tile * 128 + (w & 127) + nl, kb * 64, WSP(bf16, WS_WGU1), DM, n0, scr, lane); continue; } r -= I_GU;
        { const int kb = r / 32, nb = r % 32; tr_item(C.w_down + (size_t)FF * DM, DM, nb * 32 + nl, kb * 64, WSP(bf16, WS_WD1), FF, nb * 32, scr, lane); }
    }
}
DI void p0_rope(const Ctx& C, int gt, int NGT) {
    f32x2* tab = WSP(f32x2, WS_ROPE);
    for (int idx = gt; idx < 8200 * 32; idx += NGT) {
        const int pi = idx >> 5, f = idx & 31; const double pos = (double)(pi < 8192 ? pi : 16384 + (pi - 8192));
        double inv = 1.0; const double r = 0.74989420933245582730;
        for (int i = 0; i < 31; ++i) inv = (i < f) ? inv * r : inv;
        const double ang = pos * inv;
        const double n = __builtin_rint(ang * 0.63661977236758134308);
        double x = __builtin_fma(-n, 1.5707963267948965580, ang); x = __builtin_fma(-n, 6.1232339957367660e-17, x);
        const double x2 = x * x;
        double s = -1.0 / 1307674368000.0; s = s * x2 + 1.0 / 6227020800.0; s = s * x2 - 1.0 / 39916800.0; s = s * x2 + 1.0 / 362880.0; s = s * x2 - 1.0 / 5040.0; s = s * x2 + 1.0 / 120.0; s = s * x2 - 1.0 / 6.0; s = s * x2 * x + x;
        double c = 1.0 / 20922789888000.0; c = c * x2 - 1.0 / 87178291200.0; c = c * x2 + 1.0 / 479001600.0; c = c * x2 - 1.0 / 3628800.0; c = c * x2 + 1.0 / 40320.0; c = c * x2 - 1.0 / 720.0; c = c * x2 + 1.0 / 24.0; c = c * x2 - 0.5; c = c * x2 + 1.0;
        const int q = ((int)n) & 3;
        const double cs = (q == 0) ? c : (q == 1) ? -s : (q == 2) ? -c : s, sn = (q == 0) ? s : (q == 1) ? c : (q == 2) ? -s : -c;
        tab[idx] = (f32x2){(float)cs, (float)sn};
    }
}
DI void p0_x(const Ctx& C) {
    LAS unsigned char* wf = C.lds;
    { float wv[4][8];
#pragma unroll
      for (int q = 0; q < 4; ++q) { const int slot = C.tid + q * NTHR, ks = slot >> 6, l = slot & 63, n = l & 15, k0 = 32 * ks + 8 * (l >> 4);
#pragma unroll
          for (int e = 0; e < 8; ++e) wv[q][e] = C.a_w_in[(size_t)(k0 + e) * AINW + NPROJ + n]; }
#pragma unroll
      for (int q = 0; q < 4; ++q) { const int slot = C.tid + q * NTHR; *(LAS bf16x8*)(wf + slot * 16) = pack8(wv[q]); } }
    LDS_WAIT(); __syncthreads();
    const int gw = C.vcu * NWAVES + C.wave, NGW = C.G * NWAVES;
    bf16* XB = WSP(bf16, WS_XB); float* AB = WSP(float, WS_AB);
    for (int task = gw; task < MT / 16; task += NGW) {
        int lane = C.lane; asm volatile("" : "+v"(lane)); const int il = lane & 15, g4 = lane >> 4;
        const int row = task * 16 + il; const float* xr = (row < MP ? C.x_prompt + (size_t)row * DM : C.x_sample + (size_t)(row - MP) * DM) + 8 * g4;
        f32x4 acc = {0.f, 0.f, 0.f, 0.f};
#pragma unroll 1
        for (int kb = 0; kb < 4; ++kb) {
            f32x4 xv[8][2];
#pragma unroll
            for (int s = 0; s < 8; ++s) { xv[s][0] = *(const GAS f32x4*)(xr + 32 * (8 * kb + s)); xv[s][1] = *(const GAS f32x4*)(xr + 32 * (8 * kb + s) + 4); }
#pragma unroll
            for (int s = 0; s < 8; ++s) { const int ks = 8 * kb + s; const bf16x8 a = pack44(xv[s][0], xv[s][1]);
                *(GAS bf16x8*)(XB + (size_t)row * DM + 32 * ks + 8 * g4) = a;
                acc = mfma16(a, *(const LAS bf16x8*)(wf + (ks * 64 + lane) * 16), acc); }
        }
#pragma unroll
        for (int r = 0; r < 4; ++r) AB[(size_t)(task * 16 + 4 * g4 + r) * 16 + il] = acc[r];
    }
}
DI void p0_cmeans(const Ctx& C, int gw, int NGW) {
    float* cm = WSP(float, WS_CMEANS);
    for (int it = gw; it < 32 * 64; it += NGW) { const int seq = it >> 6, blk = it & 63; f32x4 a0 = {0, 0, 0, 0}, a1 = a0, a2 = a0, a3 = a0;
#pragma unroll
        for (int pg = 0; pg < 2; ++pg) { const int page = C.page_table[seq * 128 + 2 * blk + pg]; const GAS f32x4* base = (const GAS f32x4*)(C.cache_k + (size_t)page * 32768) + C.lane;
#pragma unroll 1
            for (int t = 0; t < 128; t += 16) { f32x4 v[16];
#pragma unroll
                for (int q = 0; q < 16; ++q) v[q] = __builtin_nontemporal_load(base + (t + q) * 64);
#pragma unroll
                for (int q = 0; q < 16; q += 4) { a0 += v[q]; a1 += v[q + 1]; a2 += v[q + 2]; a3 += v[q + 3]; } } }
        const f32x4 m = ((a0 + a1) + (a2 + a3)) * (1.f / 256.f);
        *(GAS f32x4*)(cm + (size_t)it * 256 + 4 * C.lane) = m; }
}
struct EpiF32 {
    static constexpr bool PERM = false, AFTER_DRAIN = false; float* O; int ldc;
    DI void operator()(const f32x4 (&acc)[2][2][4][2], const pg8::Unit& u, int wr, int wc, int fr, int fq) const {
        const int row0 = u.pm * 256 + wr * 64 + fr, col0 = u.pn * 256 + wc * 32 + 4 * fq;
#pragma unroll
        for (int ai = 0; ai < 2; ++ai)
#pragma unroll
            for (int m = 0; m < 4; ++m) { float* rp = O + (size_t)(row0 + ai * 128 + m * 16) * ldc + col0;
#pragma unroll
                for (int bj = 0; bj < 2; ++bj)
#pragma unroll
                    for (int n = 0; n < 2; ++n) *(GAS f32x4*)(rp + bj * 128 + n * 16) = acc[ai][bj][m][n]; }
    }
};
struct EpiSwiglu {
    static constexpr bool PERM = true, AFTER_DRAIN = false; bf16* O;
    DI void operator()(const f32x4 (&acc)[2][2][4][2], const pg8::Unit& u, int wr, int wc, int fr, int fq) const {
        const int row0 = u.pm * 256 + wr * 64 + fr, col0 = u.pn * 128 + wc * 32 + 8 * fq;
#pragma unroll
        for (int ai = 0; ai < 2; ++ai)
#pragma unroll
            for (int m = 0; m < 4; ++m) { bf16* rp = O + (size_t)(row0 + ai * 128 + m * 16) * FF + col0; float v[8];
#pragma unroll
                for (int n = 0; n < 2; ++n)
#pragma unroll
                    for (int e = 0; e < 4; ++e) { const float g = acc[ai][0][m][n][e], uu = acc[ai][1][m][n][e]; v[4 * n + e] = silu_f(g) * uu; }
                *(GAS bf16x8*)rp = pack8(v); }
    }
};
constexpr float QSCALE = 0.125f * 1.4426950408889634f;
struct EpiQkvRope {
    static constexpr bool PERM = true, AFTER_DRAIN = false; bf16 *Q, *KB, *VB; float* out; const f32x2* tab;
    DI void operator()(const f32x4 (&acc)[2][2][4][2], const pg8::Unit& u, int wr, int wc, int fr, int fq) const {
        const int row0 = u.pm * 256 + wr * 64 + fr;
#pragma unroll
        for (int ai = 0; ai < 2; ++ai)
#pragma unroll
            for (int m = 0; m < 4; ++m) { const int row = row0 + ai * 128 + m * 16;
                if (u.pn < 5) {
                    const int pi = row < MP ? (row & 8191) : 8192 + (row & 7), q8 = 4 * (wc & 1) + fq;
                    const f32x4 t0 = *(const GAS f32x4*)(tab + pi * 32 + 4 * q8), t1 = *(const GAS f32x4*)(tab + pi * 32 + 4 * q8 + 2);
                    const float cs[4] = {t0[0], t0[2], t1[0], t1[2]}, sn[4] = {t0[1], t0[3], t1[1], t1[3]};
#pragma unroll
                    for (int bj = 0; bj < 2; ++bj) { const f32x4 x1 = acc[ai][bj][m][0], x2 = acc[ai][bj][m][1]; float o1[4], o2[4];
#pragma unroll
                        for (int e = 0; e < 4; ++e) { o1[e] = x1[e] * cs[e] - x2[e] * sn[e]; o2[e] = x2[e] * cs[e] + x1[e] * sn[e]; }
                        const int hl = 2 * bj + (wc >> 1);
                        v2u w1, w2; w1.x = pk2(o1[0], o1[1]); w1.y = pk2(o1[2], o1[3]); w2.x = pk2(o2[0], o2[1]); w2.y = pk2(o2[2], o2[3]);
                        if (u.pn < 4) { bf16* p = Q + (size_t)row * DM + (4 * u.pn + hl) * 64 + 4 * q8;
                            v2u s1, s2; s1.x = pk2(o1[0] * QSCALE, o1[1] * QSCALE); s1.y = pk2(o1[2] * QSCALE, o1[3] * QSCALE); s2.x = pk2(o2[0] * QSCALE, o2[1] * QSCALE); s2.y = pk2(o2[2] * QSCALE, o2[3] * QSCALE);
                            *(GAS v2u*)p = s1; *(GAS v2u*)(p + 32) = s2; }
                        else { bf16* p = KB + (size_t)row * 256 + hl * 64 + 4 * q8; *(GAS v2u*)p = w1; *(GAS v2u*)(p + 32) = w2;
                            float* f = (row < MP ? out + O_PK + (size_t)row * 256 : out + O_SK + (size_t)(row - MP) * 256) + hl * 64 + 4 * q8;
                            *(GAS f32x4*)f = (f32x4){o1[0], o1[1], o1[2], o1[3]}; *(GAS f32x4*)(f + 32) = (f32x4){o2[0], o2[1], o2[2], o2[3]}; } }
                } else {
#pragma unroll
                    for (int bj = 0; bj < 2; ++bj) { const int col = bj * 128 + wc * 32 + 8 * fq; const f32x4 a = acc[ai][bj][m][0], b = acc[ai][bj][m][1];
                        *(GAS bf16x8*)(VB + (size_t)row * 256 + col) = pack44(a, b);
                        float* f = (row < MP ? out + O_PV + (size_t)row * 256 : out + O_SV + (size_t)(row - MP) * 256) + col;
                        *(GAS f32x4*)f = a; *(GAS f32x4*)(f + 4) = b; }
                }
            }
    }
};
DI void conv_state_out(const Ctx& C) {
    const bf16* PROJ = WSP(bf16, WS_PROJ);
    for (int idx = C.vcu * NTHR + C.tid; idx < (2 + 32) * 3 * CONVD; idx += C.G * NTHR) {
        const int col = idx % CONVD, r = (idx / CONVD) % 3, s = idx / (3 * CONVD);
        const int row = s < 2 ? s * SEQ + SEQ - 3 + r : MP + (s - 2) * 8 + 5 + r;
        const float v = bf2f(PROJ[(size_t)row * NPROJ + col]);
        if (s < 2) C.out[O_PCONV + (size_t)idx] = v; else C.out[O_SCONV + (size_t)(idx - 2 * 3 * CONVD)] = v; }
}
constexpr int PAIR_BYTES = 16384 + 17408 + 2048;
DI float shx(float v, int m, int lane) { return __int_as_float(__builtin_amdgcn_ds_bpermute((lane ^ m) << 2, __float_as_int(v))); }
DI float shfrom(float v, int src) { return __int_as_float(__builtin_amdgcn_ds_bpermute(src << 2, __float_as_int(v))); }
DI float softplus_f(float x) { return fmaxf(x, 0.f) + log1pf(__expf(-fabsf(x))); }

#define TS_LD(slot, i, m4) tb##slot = *(const LAS f32x4*)(AM + (i) * 64 + 4 * (m4)); asm volatile("" ::: "memory");
#define TS_F(slot, i, m, e) x[i] -= x[m] * tb##slot[e];
template <int NROW> DI void tri_solve(f32x2 (&x)[64], const LAS float* AM) {
    f32x4 tb0, tb1, tb2, tb3, tb4, tb5, tb6, tb7;
    TS_LD(0, 1, 0)
    TS_LD(1, 2, 0)
    TS_LD(2, 3, 0)
    TS_LD(3, 4, 0)
    TS_LD(4, 5, 0)
    TS_LD(5, 5, 1)
    TS_LD(6, 6, 0)
    TS_LD(7, 6, 1)
    { const f32x4 ta = tb0; TS_LD(0, 7, 0) x[1] -= x[0] * ta[0]; }
    { const f32x4 ta = tb1; TS_LD(1, 7, 1) x[2] -= x[0] * ta[0]; x[2] -= x[1] * ta[1]; }
    { const f32x4 ta = tb2; TS_LD(2, 8, 0) x[3] -= x[0] * ta[0]; x[3] -= x[1] * ta[1]; x[3] -= x[2] * ta[2]; }
    { const f32x4 ta = tb3; TS_LD(3, 8, 1) x[4] -= x[0] * ta[0]; x[4] -= x[1] * ta[1]; x[4] -= x[2] * ta[2]; x[4] -= x[3] * ta[3]; }
    { const f32x4 ta = tb4; TS_LD(4, 9, 0) x[5] -= x[0] * ta[0]; x[5] -= x[1] * ta[1]; x[5] -= x[2] * ta[2]; x[5] -= x[3] * ta[3]; }
    { const f32x4 ta = tb5; TS_LD(5, 9, 1) x[5] -= x[4] * ta[0]; }
    { const f32x4 ta = tb6; TS_LD(6, 9, 2) x[6] -= x[0] * ta[0]; x[6] -= x[1] * ta[1]; x[6] -= x[2] * ta[2]; x[6] -= x[3] * ta[3]; }
    { const f32x4 ta = tb7; TS_LD(7, 10, 0) x[6] -= x[4] * ta[0]; x[6] -= x[5] * ta[1]; }
    { const f32x4 ta = tb0; TS_LD(0, 10, 1) x[7] -= x[0] * ta[0]; x[7] -= x[1] * ta[1]; x[7] -= x[2] * ta[2]; x[7] -= x[3] * ta[3]; }
    { const f32x4 ta = tb1; TS_LD(1, 10, 2) x[7] -= x[4] * ta[0]; x[7] -= x[5] * ta[1]; x[7] -= x[6] * ta[2]; }
    { const f32x4 ta = tb2; TS_LD(2, 11, 0) x[8] -= x[0] * ta[0]; x[8] -= x[1] * ta[1]; x[8] -= x[2] * ta[2]; x[8] -= x[3] * ta[3]; }
    { const f32x4 ta = tb3; TS_LD(3, 11, 1) x[8] -= x[4] * ta[0]; x[8] -= x[5] * ta[1]; x[8] -= x[6] * ta[2]; x[8] -= x[7] * ta[3]; }
    { const f32x4 ta = tb4; TS_LD(4, 11, 2) x[9] -= x[0] * ta[0]; x[9] -= x[1] * ta[1]; x[9] -= x[2] * ta[2]; x[9] -= x[3] * ta[3]; }
    { const f32x4 ta = tb5; TS_LD(5, 12, 0) x[9] -= x[4] * ta[0]; x[9] -= x[5] * ta[1]; x[9] -= x[6] * ta[2]; x[9] -= x[7] * ta[3]; }
    { const f32x4 ta = tb6; TS_LD(6, 12, 1) x[9] -= x[8] * ta[0]; }
    { const f32x4 ta = tb7; TS_LD(7, 12, 2) x[10] -= x[0] * ta[0]; x[10] -= x[1] * ta[1]; x[10] -= x[2] * ta[2]; x[10] -= x[3] * ta[3]; }
    { const f32x4 ta = tb0; TS_LD(0, 13, 0) x[10] -= x[4] * ta[0]; x[10] -= x[5] * ta[1]; x[10] -= x[6] * ta[2]; x[10] -= x[7] * ta[3]; }
    { const f32x4 ta = tb1; TS_LD(1, 13, 1) x[10] -= x[8] * ta[0]; x[10] -= x[9] * ta[1]; }
    { const f32x4 ta = tb2; TS_LD(2, 13, 2) x[11] -= x[0] * ta[0]; x[11] -= x[1] * ta[1]; x[11] -= x[2] * ta[2]; x[11] -= x[3] * ta[3]; }
    { const f32x4 ta = tb3; TS_LD(3, 13, 3) x[11] -= x[4] * ta[0]; x[11] -= x[5] * ta[1]; x[11] -= x[6] * ta[2]; x[11] -= x[7] * ta[3]; }
    { const f32x4 ta = tb4; TS_LD(4, 14, 0) x[11] -= x[8] * ta[0]; x[11] -= x[9] * ta[1]; x[11] -= x[10] * ta[2]; }
    { const f32x4 ta = tb5; TS_LD(5, 14, 1) x[12] -= x[0] * ta[0]; x[12] -= x[1] * ta[1]; x[12] -= x[2] * ta[2]; x[12] -= x[3] * ta[3]; }
    { const f32x4 ta = tb6; TS_LD(6, 14, 2) x[12] -= x[4] * ta[0]; x[12] -= x[5] * ta[1]; x[12] -= x[6] * ta[2]; x[12] -= x[7] * ta[3]; }
    { const f32x4 ta = tb7; TS_LD(7, 14, 3) x[12] -= x[8] * ta[0]; x[12] -= x[9] * ta[1]; x[12] -= x[10] * ta[2]; x[12] -= x[11] * ta[3]; }
    { const f32x4 ta = tb0; TS_LD(0, 15, 0) x[13] -= x[0] * ta[0]; x[13] -= x[1] * ta[1]; x[13] -= x[2] * ta[2]; x[13] -= x[3] * ta[3]; }
    { const f32x4 ta = tb1; TS_LD(1, 15, 1) x[13] -= x[4] * ta[0]; x[13] -= x[5] * ta[1]; x[13] -= x[6] * ta[2]; x[13] -= x[7] * ta[3]; }
    { const f32x4 ta = tb2; TS_LD(2, 15, 2) x[13] -= x[8] * ta[0]; x[13] -= x[9] * ta[1]; x[13] -= x[10] * ta[2]; x[13] -= x[11] * ta[3]; }
    { const f32x4 ta = tb3; TS_LD(3, 15, 3) x[13] -= x[12] * ta[0]; }
    { const f32x4 ta = tb4; TS_LD(4, 16, 0) x[14] -= x[0] * ta[0]; x[14] -= x[1] * ta[1]; x[14] -= x[2] * ta[2]; x[14] -= x[3] * ta[3]; }
    { const f32x4 ta = tb5; TS_LD(5, 16, 1) x[14] -= x[4] * ta[0]; x[14] -= x[5] * ta[1]; x[14] -= x[6] * ta[2]; x[14] -= x[7] * ta[3]; }
    { const f32x4 ta = tb6; TS_LD(6, 16, 2) x[14] -= x[8] * ta[0]; x[14] -= x[9] * ta[1]; x[14] -= x[10] * ta[2]; x[14] -= x[11] * ta[3]; }
    { const f32x4 ta = tb7; TS_LD(7, 16, 3) x[14] -= x[12] * ta[0]; x[14] -= x[13] * ta[1]; }
    { const f32x4 ta = tb0; TS_LD(0, 17, 0) x[15] -= x[0] * ta[0]; x[15] -= x[1] * ta[1]; x[15] -= x[2] * ta[2]; x[15] -= x[3] * ta[3]; }
    { const f32x4 ta = tb1; TS_LD(1, 17, 1) x[15] -= x[4] * ta[0]; x[15] -= x[5] * ta[1]; x[15] -= x[6] * ta[2]; x[15] -= x[7] * ta[3]; }
    { const f32x4 ta = tb2; TS_LD(2, 17, 2) x[15] -= x[8] * ta[0]; x[15] -= x[9] * ta[1]; x[15] -= x[10] * ta[2]; x[15] -= x[11] * ta[3]; }
    { const f32x4 ta = tb3; TS_LD(3, 17, 3) x[15] -= x[12] * ta[0]; x[15] -= x[13] * ta[1]; x[15] -= x[14] * ta[2]; }
    { const f32x4 ta = tb4; TS_LD(4, 17, 4) x[16] -= x[0] * ta[0]; x[16] -= x[1] * ta[1]; x[16] -= x[2] * ta[2]; x[16] -= x[3] * ta[3]; }
    { const f32x4 ta = tb5; TS_LD(5, 18, 0) x[16] -= x[4] * ta[0]; x[16] -= x[5] * ta[1]; x[16] -= x[6] * ta[2]; x[16] -= x[7] * ta[3]; }
    { const f32x4 ta = tb6; TS_LD(6, 18, 1) x[16] -= x[8] * ta[0]; x[16] -= x[9] * ta[1]; x[16] -= x[10] * ta[2]; x[16] -= x[11] * ta[3]; }
    { const f32x4 ta = tb7; TS_LD(7, 18, 2) x[16] -= x[12] * ta[0]; x[16] -= x[13] * ta[1]; x[16] -= x[14] * ta[2]; x[16] -= x[15] * ta[3]; }
    { const f32x4 ta = tb0; TS_LD(0, 18, 3) x[17] -= x[0] * ta[0]; x[17] -= x[1] * ta[1]; x[17] -= x[2] * ta[2]; x[17] -= x[3] * ta[3]; }
    { const f32x4 ta = tb1; TS_LD(1, 18, 4) x[17] -= x[4] * ta[0]; x[17] -= x[5] * ta[1]; x[17] -= x[6] * ta[2]; x[17] -= x[7] * ta[3]; }
    { const f32x4 ta = tb2; TS_LD(2, 19, 0) x[17] -= x[8] * ta[0]; x[17] -= x[9] * ta[1]; x[17] -= x[10] * ta[2]; x[17] -= x[11] * ta[3]; }
    { const f32x4 ta = tb3; TS_LD(3, 19, 1) x[17] -= x[12] * ta[0]; x[17] -= x[13] * ta[1]; x[17] -= x[14] * ta[2]; x[17] -= x[15] * ta[3]; }
    { const f32x4 ta = tb4; TS_LD(4, 19, 2) x[17] -= x[16] * ta[0]; }
    { const f32x4 ta = tb5; TS_LD(5, 19, 3) x[18] -= x[0] * ta[0]; x[18] -= x[1] * ta[1]; x[18] -= x[2] * ta[2]; x[18] -= x[3] * ta[3]; }
    { const f32x4 ta = tb6; TS_LD(6, 19, 4) x[18] -= x[4] * ta[0]; x[18] -= x[5] * ta[1]; x[18] -= x[6] * ta[2]; x[18] -= x[7] * ta[3]; }
    { const f32x4 ta = tb7; TS_LD(7, 20, 0) x[18] -= x[8] * ta[0]; x[18] -= x[9] * ta[1]; x[18] -= x[10] * ta[2]; x[18] -= x[11] * ta[3]; }
    { const f32x4 ta = tb0; TS_LD(0, 20, 1) x[18] -= x[12] * ta[0]; x[18] -= x[13] * ta[1]; x[18] -= x[14] * ta[2]; x[18] -= x[15] * ta[3]; }
    { const f32x4 ta = tb1; TS_LD(1, 20, 2) x[18] -= x[16] * ta[0]; x[18] -= x[17] * ta[1]; }
    { const f32x4 ta = tb2; TS_LD(2, 20, 3) x[19] -= x[0] * ta[0]; x[19] -= x[1] * ta[1]; x[19] -= x[2] * ta[2]; x[19] -= x[3] * ta[3]; }
    { const f32x4 ta = tb3; TS_LD(3, 20, 4) x[19] -= x[4] * ta[0]; x[19] -= x[5] * ta[1]; x[19] -= x[6] * ta[2]; x[19] -= x[7] * ta[3]; }
    { const f32x4 ta = tb4; TS_LD(4, 21, 0) x[19] -= x[8] * ta[0]; x[19] -= x[9] * ta[1]; x[19] -= x[10] * ta[2]; x[19] -= x[11] * ta[3]; }
    { const f32x4 ta = tb5; TS_LD(5, 21, 1) x[19] -= x[12] * ta[0]; x[19] -= x[13] * ta[1]; x[19] -= x[14] * ta[2]; x[19] -= x[15] * ta[3]; }
    { const f32x4 ta = tb6; TS_LD(6, 21, 2) x[19] -= x[16] * ta[0]; x[19] -= x[17] * ta[1]; x[19] -= x[18] * ta[2]; }
    { const f32x4 ta = tb7; TS_LD(7, 21, 3) x[20] -= x[0] * ta[0]; x[20] -= x[1] * ta[1]; x[20] -= x[2] * ta[2]; x[20] -= x[3] * ta[3]; }
    { const f32x4 ta = tb0; TS_LD(0, 21, 4) x[20] -= x[4] * ta[0]; x[20] -= x[5] * ta[1]; x[20] -= x[6] * ta[2]; x[20] -= x[7] * ta[3]; }
    { const f32x4 ta = tb1; TS_LD(1, 21, 5) x[20] -= x[8] * ta[0]; x[20] -= x[9] * ta[1]; x[20] -= x[10] * ta[2]; x[20] -= x[11] * ta[3]; }
    { const f32x4 ta = tb2; TS_LD(2, 22, 0) x[20] -= x[12] * ta[0]; x[20] -= x[13] * ta[1]; x[20] -= x[14] * ta[2]; x[20] -= x[15] * ta[3]; }
    { const f32x4 ta = tb3; TS_LD(3, 22, 1) x[20] -= x[16] * ta[0]; x[20] -= x[17] * ta[1]; x[20] -= x[18] * ta[2]; x[20] -= x[19] * ta[3]; }
    { const f32x4 ta = tb4; TS_LD(4, 22, 2) x[21] -= x[0] * ta[0]; x[21] -= x[1] * ta[1]; x[21] -= x[2] * ta[2]; x[21] -= x[3] * ta[3]; }
    { const f32x4 ta = tb5; TS_LD(5, 22, 3) x[21] -= x[4] * ta[0]; x[21] -= x[5] * ta[1]; x[21] -= x[6] * ta[2]; x[21] -= x[7] * ta[3]; }
    { const f32x4 ta = tb6; TS_LD(6, 22, 4) x[21] -= x[8] * ta[0]; x[21] -= x[9] * ta[1]; x[21] -= x[10] * ta[2]; x[21] -= x[11] * ta[3]; }
    { const f32x4 ta = tb7; TS_LD(7, 22, 5) x[21] -= x[12] * ta[0]; x[21] -= x[13] * ta[1]; x[21] -= x[14] * ta[2]; x[21] -= x[15] * ta[3]; }
    { const f32x4 ta = tb0; TS_LD(0, 23, 0) x[21] -= x[16] * ta[0]; x[21] -= x[17] * ta[1]; x[21] -= x[18] * ta[2]; x[21] -= x[19] * ta[3]; }
    { const f32x4 ta = tb1; TS_LD(1, 23, 1) x[21] -= x[20] * ta[0]; }
    { const f32x4 ta = tb2; TS_LD(2, 23, 2) x[22] -= x[0] * ta[0]; x[22] -= x[1] * ta[1]; x[22] -= x[2] * ta[2]; x[22] -= x[3] * ta[3]; }
    { const f32x4 ta = tb3; TS_LD(3, 23, 3) x[22] -= x[4] * ta[0]; x[22] -= x[5] * ta[1]; x[22] -= x[6] * ta[2]; x[22] -= x[7] * ta[3]; }
    { const f32x4 ta = tb4; TS_LD(4, 23, 4) x[22] -= x[8] * ta[0]; x[22] -= x[9] * ta[1]; x[22] -= x[10] * ta[2]; x[22] -= x[11] * ta[3]; }
    { const f32x4 ta = tb5; TS_LD(5, 23, 5) x[22] -= x[12] * ta[0]; x[22] -= x[13] * ta[1]; x[22] -= x[14] * ta[2]; x[22] -= x[15] * ta[3]; }
    { const f32x4 ta = tb6; TS_LD(6, 24, 0) x[22] -= x[16] * ta[0]; x[22] -= x[17] * ta[1]; x[22] -= x[18] * ta[2]; x[22] -= x[19] * ta[3]; }
    { const f32x4 ta = tb7; TS_LD(7, 24, 1) x[22] -= x[20] * ta[0]; x[22] -= x[21] * ta[1]; }
    { const f32x4 ta = tb0; TS_LD(0, 24, 2) x[23] -= x[0] * ta[0]; x[23] -= x[1] * ta[1]; x[23] -= x[2] * ta[2]; x[23] -= x[3] * ta[3]; }
    { const f32x4 ta = tb1; TS_LD(1, 24, 3) x[23] -= x[4] * ta[0]; x[23] -= x[5] * ta[1]; x[23] -= x[6] * ta[2]; x[23] -= x[7] * ta[3]; }
    { const f32x4 ta = tb2; TS_LD(2, 24, 4) x[23] -= x[8] * ta[0]; x[23] -= x[9] * ta[1]; x[23] -= x[10] * ta[2]; x[23] -= x[11] * ta[3]; }
    { const f32x4 ta = tb3; TS_LD(3, 24, 5) x[23] -= x[12] * ta[0]; x[23] -= x[13] * ta[1]; x[23] -= x[14] * ta[2]; x[23] -= x[15] * ta[3]; }
    { const f32x4 ta = tb4; TS_LD(4, 25, 0) x[23] -= x[16] * ta[0]; x[23] -= x[17] * ta[1]; x[23] -= x[18] * ta[2]; x[23] -= x[19] * ta[3]; }
    { const f32x4 ta = tb5; TS_LD(5, 25, 1) x[23] -= x[20] * ta[0]; x[23] -= x[21] * ta[1]; x[23] -= x[22] * ta[2]; }
    { const f32x4 ta = tb6; TS_LD(6, 25, 2) x[24] -= x[0] * ta[0]; x[24] -= x[1] * ta[1]; x[24] -= x[2] * ta[2]; x[24] -= x[3] * ta[3]; }
    { const f32x4 ta = tb7; TS_LD(7, 25, 3) x[24] -= x[4] * ta[0]; x[24] -= x[5] * ta[1]; x[24] -= x[6] * ta[2]; x[24] -= x[7] * ta[3]; }
    { const f32x4 ta = tb0; TS_LD(0, 25, 4) x[24] -= x[8] * ta[0]; x[24] -= x[9] * ta[1]; x[24] -= x[10] * ta[2]; x[24] -= x[11] * ta[3]; }
    { const f32x4 ta = tb1; TS_LD(1, 25, 5) x[24] -= x[12] * ta[0]; x[24] -= x[13] * ta[1]; x[24] -= x[14] * ta[2]; x[24] -= x[15] * ta[3]; }
    { const f32x4 ta = tb2; TS_LD(2, 25, 6) x[24] -= x[16] * ta[0]; x[24] -= x[17] * ta[1]; x[24] -= x[18] * ta[2]; x[24] -= x[19] * ta[3]; }
    { const f32x4 ta = tb3; TS_LD(3, 26, 0) x[24] -= x[20] * ta[0]; x[24] -= x[21] * ta[1]; x[24] -= x[22] * ta[2]; x[24] -= x[23] * ta[3]; }
    { const f32x4 ta = tb4; TS_LD(4, 26, 1) x[25] -= x[0] * ta[0]; x[25] -= x[1] * ta[1]; x[25] -= x[2] * ta[2]; x[25] -= x[3] * ta[3]; }
    { const f32x4 ta = tb5; TS_LD(5, 26, 2) x[25] -= x[4] * ta[0]; x[25] -= x[5] * ta[1]; x[25] -= x[6] * ta[2]; x[25] -= x[7] * ta[3]; }
    { const f32x4 ta = tb6; TS_LD(6, 26, 3) x[25] -= x[8] * ta[0]; x[25] -= x[9] * ta[1]; x[25] -= x[10] * ta[2]; x[25] -= x[11] * ta[3]; }
    { const f32x4 ta = tb7; TS_LD(7, 26, 4) x[25] -= x[12] * ta[0]; x[25] -= x[13] * ta[1]; x[25] -= x[14] * ta[2]; x[25] -= x[15] * ta[3]; }
    { const f32x4 ta = tb0; TS_LD(0, 26, 5) x[25] -= x[16] * ta[0]; x[25] -= x[17] * ta[1]; x[25] -= x[18] * ta[2]; x[25] -= x[19] * ta[3]; }
    { const f32x4 ta = tb1; TS_LD(1, 26, 6) x[25] -= x[20] * ta[0]; x[25] -= x[21] * ta[1]; x[25] -= x[22] * ta[2]; x[25] -= x[23] * ta[3]; }
    { const f32x4 ta = tb2; TS_LD(2, 27, 0) x[25] -= x[24] * ta[0]; }
    { const f32x4 ta = tb3; TS_LD(3, 27, 1) x[26] -= x[0] * ta[0]; x[26] -= x[1] * ta[1]; x[26] -= x[2] * ta[2]; x[26] -= x[3] * ta[3]; }
    { const f32x4 ta = tb4; TS_LD(4, 27, 2) x[26] -= x[4] * ta[0]; x[26] -= x[5] * ta[1]; x[26] -= x[6] * ta[2]; x[26] -= x[7] * ta[3]; }
    { const f32x4 ta = tb5; TS_LD(5, 27, 3) x[26] -= x[8] * ta[0]; x[26] -= x[9] * ta[1]; x[26] -= x[10] * ta[2]; x[26] -= x[11] * ta[3]; }
    { const f32x4 ta = tb6; TS_LD(6, 27, 4) x[26] -= x[12] * ta[0]; x[26] -= x[13] * ta[1]; x[26] -= x[14] * ta[2]; x[26] -= x[15] * ta[3]; }
    { const f32x4 ta = tb7; TS_LD(7, 27, 5) x[26] -= x[16] * ta[0]; x[26] -= x[17] * ta[1]; x[26] -= x[18] * ta[2]; x[26] -= x[19] * ta[3]; }
    { const f32x4 ta = tb0; TS_LD(0, 27, 6) x[26] -= x[20] * ta[0]; x[26] -= x[21] * ta[1]; x[26] -= x[22] * ta[2]; x[26] -= x[23] * ta[3]; }
    { const f32x4 ta = tb1; TS_LD(1, 28, 0) x[26] -= x[24] * ta[0]; x[26] -= x[25] * ta[1]; }
    { const f32x4 ta = tb2; TS_LD(2, 28, 1) x[27] -= x[0] * ta[0]; x[27] -= x[1] * ta[1]; x[27] -= x[2] * ta[2]; x[27] -= x[3] * ta[3]; }
    { const f32x4 ta = tb3; TS_LD(3, 28, 2) x[27] -= x[4] * ta[0]; x[27] -= x[5] * ta[1]; x[27] -= x[6] * ta[2]; x[27] -= x[7] * ta[3]; }
    { const f32x4 ta = tb4; TS_LD(4, 28, 3) x[27] -= x[8] * ta[0]; x[27] -= x[9] * ta[1]; x[27] -= x[10] * ta[2]; x[27] -= x[11] * ta[3]; }
    { const f32x4 ta = tb5; TS_LD(5, 28, 4) x[27] -= x[12] * ta[0]; x[27] -= x[13] * ta[1]; x[27] -= x[14] * ta[2]; x[27] -= x[15] * ta[3]; }
    { const f32x4 ta = tb6; TS_LD(6, 28, 5) x[27] -= x[16] * ta[0]; x[27] -= x[17] * ta[1]; x[27] -= x[18] * ta[2]; x[27] -= x[19] * ta[3]; }
    { const f32x4 ta = tb7; TS_LD(7, 28, 6) x[27] -= x[20] * ta[0]; x[27] -= x[21] * ta[1]; x[27] -= x[22] * ta[2]; x[27] -= x[23] * ta[3]; }
    { const f32x4 ta = tb0; TS_LD(0, 29, 0) x[27] -= x[24] * ta[0]; x[27] -= x[25] * ta[1]; x[27] -= x[26] * ta[2]; }
    { const f32x4 ta = tb1; TS_LD(1, 29, 1) x[28] -= x[0] * ta[0]; x[28] -= x[1] * ta[1]; x[28] -= x[2] * ta[2]; x[28] -= x[3] * ta[3]; }
    { const f32x4 ta = tb2; TS_LD(2, 29, 2) x[28] -= x[4] * ta[0]; x[28] -= x[5] * ta[1]; x[28] -= x[6] * ta[2]; x[28] -= x[7] * ta[3]; }
    { const f32x4 ta = tb3; TS_LD(3, 29, 3) x[28] -= x[8] * ta[0]; x[28] -= x[9] * ta[1]; x[28] -= x[10] * ta[2]; x[28] -= x[11] * ta[3]; }
    { const f32x4 ta = tb4; TS_LD(4, 29, 4) x[28] -= x[12] * ta[0]; x[28] -= x[13] * ta[1]; x[28] -= x[14] * ta[2]; x[28] -= x[15] * ta[3]; }
    { const f32x4 ta = tb5; TS_LD(5, 29, 5) x[28] -= x[16] * ta[0]; x[28] -= x[17] * ta[1]; x[28] -= x[18] * ta[2]; x[28] -= x[19] * ta[3]; }
    { const f32x4 ta = tb6; TS_LD(6, 29, 6) x[28] -= x[20] * ta[0]; x[28] -= x[21] * ta[1]; x[28] -= x[22] * ta[2]; x[28] -= x[23] * ta[3]; }
    { const f32x4 ta = tb7; TS_LD(7, 29, 7) x[28] -= x[24] * ta[0]; x[28] -= x[25] * ta[1]; x[28] -= x[26] * ta[2]; x[28] -= x[27] * ta[3]; }
    { const f32x4 ta = tb0; TS_LD(0, 30, 0) x[29] -= x[0] * ta[0]; x[29] -= x[1] * ta[1]; x[29] -= x[2] * ta[2]; x[29] -= x[3] * ta[3]; }
    { const f32x4 ta = tb1; TS_LD(1, 30, 1) x[29] -= x[4] * ta[0]; x[29] -= x[5] * ta[1]; x[29] -= x[6] * ta[2]; x[29] -= x[7] * ta[3]; }
    { const f32x4 ta = tb2; TS_LD(2, 30, 2) x[29] -= x[8] * ta[0]; x[29] -= x[9] * ta[1]; x[29] -= x[10] * ta[2]; x[29] -= x[11] * ta[3]; }
    { const f32x4 ta = tb3; TS_LD(3, 30, 3) x[29] -= x[12] * ta[0]; x[29] -= x[13] * ta[1]; x[29] -= x[14] * ta[2]; x[29] -= x[15] * ta[3]; }
    { const f32x4 ta = tb4; TS_LD(4, 30, 4) x[29] -= x[16] * ta[0]; x[29] -= x[17] * ta[1]; x[29] -= x[18] * ta[2]; x[29] -= x[19] * ta[3]; }
    { const f32x4 ta = tb5; TS_LD(5, 30, 5) x[29] -= x[20] * ta[0]; x[29] -= x[21] * ta[1]; x[29] -= x[22] * ta[2]; x[29] -= x[23] * ta[3]; }
    { const f32x4 ta = tb6; TS_LD(6, 30, 6) x[29] -= x[24] * ta[0]; x[29] -= x[25] * ta[1]; x[29] -= x[26] * ta[2]; x[29] -= x[27] * ta[3]; }
    { const f32x4 ta = tb7; TS_LD(7, 30, 7) x[29] -= x[28] * ta[0]; }
    { const f32x4 ta = tb0; TS_LD(0, 31, 0) x[30] -= x[0] * ta[0]; x[30] -= x[1] * ta[1]; x[30] -= x[2] * ta[2]; x[30] -= x[3] * ta[3]; }
    { const f32x4 ta = tb1; TS_LD(1, 31, 1) x[30] -= x[4] * ta[0]; x[30] -= x[5] * ta[1]; x[30] -= x[6] * ta[2]; x[30] -= x[7] * ta[3]; }
    { const f32x4 ta = tb2; TS_LD(2, 31, 2) x[30] -= x[8] * ta[0]; x[30] -= x[9] * ta[1]; x[30] -= x[10] * ta[2]; x[30] -= x[11] * ta[3]; }
    { const f32x4 ta = tb3; TS_LD(3, 31, 3) x[30] -= x[12] * ta[0]; x[30] -= x[13] * ta[1]; x[30] -= x[14] * ta[2]; x[30] -= x[15] * ta[3]; }
    { const f32x4 ta = tb4; TS_LD(4, 31, 4) x[30] -= x[16] * ta[0]; x[30] -= x[17] * ta[1]; x[30] -= x[18] * ta[2]; x[30] -= x[19] * ta[3]; }
    { const f32x4 ta = tb5; TS_LD(5, 31, 5) x[30] -= x[20] * ta[0]; x[30] -= x[21] * ta[1]; x[30] -= x[22] * ta[2]; x[30] -= x[23] * ta[3]; }
    { const f32x4 ta = tb6; TS_LD(6, 31, 6) x[30] -= x[24] * ta[0]; x[30] -= x[25] * ta[1]; x[30] -= x[26] * ta[2]; x[30] -= x[27] * ta[3]; }
    { const f32x4 ta = tb7; TS_LD(7, 31, 7) x[30] -= x[28] * ta[0]; x[30] -= x[29] * ta[1]; }
    { const f32x4 ta = tb0; TS_LD(0, 32, 0) x[31] -= x[0] * ta[0]; x[31] -= x[1] * ta[1]; x[31] -= x[2] * ta[2]; x[31] -= x[3] * ta[3]; }
    { const f32x4 ta = tb1; TS_LD(1, 32, 1) x[31] -= x[4] * ta[0]; x[31] -= x[5] * ta[1]; x[31] -= x[6] * ta[2]; x[31] -= x[7] * ta[3]; }
    { const f32x4 ta = tb2; TS_LD(2, 32, 2) x[31] -= x[8] * ta[0]; x[31] -= x[9] * ta[1]; x[31] -= x[10] * ta[2]; x[31] -= x[11] * ta[3]; }
    { const f32x4 ta = tb3; TS_LD(3, 32, 3) x[31] -= x[12] * ta[0]; x[31] -= x[13] * ta[1]; x[31] -= x[14] * ta[2]; x[31] -= x[15] * ta[3]; }
    { const f32x4 ta = tb4; TS_LD(4, 32, 4) x[31] -= x[16] * ta[0]; x[31] -= x[17] * ta[1]; x[31] -= x[18] * ta[2]; x[31] -= x[19] * ta[3]; }
    { const f32x4 ta = tb5; TS_LD(5, 32, 5) x[31] -= x[20] * ta[0]; x[31] -= x[21] * ta[1]; x[31] -= x[22] * ta[2]; x[31] -= x[23] * ta[3]; }
    { const f32x4 ta = tb6; TS_LD(6, 32, 6) x[31] -= x[24] * ta[0]; x[31] -= x[25] * ta[1]; x[31] -= x[26] * ta[2]; x[31] -= x[27] * ta[3]; }
    { const f32x4 ta = tb7; TS_LD(7, 32, 7) x[31] -= x[28] * ta[0]; x[31] -= x[29] * ta[1]; x[31] -= x[30] * ta[2]; }
    { const f32x4 ta = tb0; TS_LD(0, 33, 0) x[32] -= x[0] * ta[0]; x[32] -= x[1] * ta[1]; x[32] -= x[2] * ta[2]; x[32] -= x[3] * ta[3]; }
    { const f32x4 ta = tb1; TS_LD(1, 33, 1) x[32] -= x[4] * ta[0]; x[32] -= x[5] * ta[1]; x[32] -= x[6] * ta[2]; x[32] -= x[7] * ta[3]; }
    { const f32x4 ta = tb2; TS_LD(2, 33, 2) x[32] -= x[8] * ta[0]; x[32] -= x[9] * ta[1]; x[32] -= x[10] * ta[2]; x[32] -= x[11] * ta[3]; }
    { const f32x4 ta = tb3; TS_LD(3, 33, 3) x[32] -= x[12] * ta[0]; x[32] -= x[13] * ta[1]; x[32] -= x[14] * ta[2]; x[32] -= x[15] * ta[3]; }
    { const f32x4 ta = tb4; TS_LD(4, 33, 4) x[32] -= x[16] * ta[0]; x[32] -= x[17] * ta[1]; x[32] -= x[18] * ta[2]; x[32] -= x[19] * ta[3]; }
    { const f32x4 ta = tb5; TS_LD(5, 33, 5) x[32] -= x[20] * ta[0]; x[32] -= x[21] * ta[1]; x[32] -= x[22] * ta[2]; x[32] -= x[23] * ta[3]; }
    { const f32x4 ta = tb6; TS_LD(6, 33, 6) x[32] -= x[24] * ta[0]; x[32] -= x[25] * ta[1]; x[32] -= x[26] * ta[2]; x[32] -= x[27] * ta[3]; }
    { const f32x4 ta = tb7; TS_LD(7, 33, 7) x[32] -= x[28] * ta[0]; x[32] -= x[29] * ta[1]; x[32] -= x[30] * ta[2]; x[32] -= x[31] * ta[3]; }
    { const f32x4 ta = tb0; TS_LD(0, 33, 8) x[33] -= x[0] * ta[0]; x[33] -= x[1] * ta[1]; x[33] -= x[2] * ta[2]; x[33] -= x[3] * ta[3]; }
    { const f32x4 ta = tb1; TS_LD(1, 34, 0) x[33] -= x[4] * ta[0]; x[33] -= x[5] * ta[1]; x[33] -= x[6] * ta[2]; x[33] -= x[7] * ta[3]; }
    { const f32x4 ta = tb2; TS_LD(2, 34, 1) x[33] -= x[8] * ta[0]; x[33] -= x[9] * ta[1]; x[33] -= x[10] * ta[2]; x[33] -= x[11] * ta[3]; }
    { const f32x4 ta = tb3; TS_LD(3, 34, 2) x[33] -= x[12] * ta[0]; x[33] -= x[13] * ta[1]; x[33] -= x[14] * ta[2]; x[33] -= x[15] * ta[3]; }
    { const f32x4 ta = tb4; TS_LD(4, 34, 3) x[33] -= x[16] * ta[0]; x[33] -= x[17] * ta[1]; x[33] -= x[18] * ta[2]; x[33] -= x[19] * ta[3]; }
    { const f32x4 ta = tb5; TS_LD(5, 34, 4) x[33] -= x[20] * ta[0]; x[33] -= x[21] * ta[1]; x[33] -= x[22] * ta[2]; x[33] -= x[23] * ta[3]; }
    { const f32x4 ta = tb6; TS_LD(6, 34, 5) x[33] -= x[24] * ta[0]; x[33] -= x[25] * ta[1]; x[33] -= x[26] * ta[2]; x[33] -= x[27] * ta[3]; }
    { const f32x4 ta = tb7; TS_LD(7, 34, 6) x[33] -= x[28] * ta[0]; x[33] -= x[29] * ta[1]; x[33] -= x[30] * ta[2]; x[33] -= x[31] * ta[3]; }
    { const f32x4 ta = tb0; TS_LD(0, 34, 7) x[33] -= x[32] * ta[0]; }
    { const f32x4 ta = tb1; TS_LD(1, 34, 8) x[34] -= x[0] * ta[0]; x[34] -= x[1] * ta[1]; x[34] -= x[2] * ta[2]; x[34] -= x[3] * ta[3]; }
    { const f32x4 ta = tb2; TS_LD(2, 35, 0) x[34] -= x[4] * ta[0]; x[34] -= x[5] * ta[1]; x[34] -= x[6] * ta[2]; x[34] -= x[7] * ta[3]; }
    { const f32x4 ta = tb3; TS_LD(3, 35, 1) x[34] -= x[8] * ta[0]; x[34] -= x[9] * ta[1]; x[34] -= x[10] * ta[2]; x[34] -= x[11] * ta[3]; }
    { const f32x4 ta = tb4; TS_LD(4, 35, 2) x[34] -= x[12] * ta[0]; x[34] -= x[13] * ta[1]; x[34] -= x[14] * ta[2]; x[34] -= x[15] * ta[3]; }
    { const f32x4 ta = tb5; TS_LD(5, 35, 3) x[34] -= x[16] * ta[0]; x[34] -= x[17] * ta[1]; x[34] -= x[18] * ta[2]; x[34] -= x[19] * ta[3]; }
    { const f32x4 ta = tb6; TS_LD(6, 35, 4) x[34] -= x[20] * ta[0]; x[34] -= x[21] * ta[1]; x[34] -= x[22] * ta[2]; x[34] -= x[23] * ta[3]; }
    { const f32x4 ta = tb7; TS_LD(7, 35, 5) x[34] -= x[24] * ta[0]; x[34] -= x[25] * ta[1]; x[34] -= x[26] * ta[2]; x[34] -= x[27] * ta[3]; }
    { const f32x4 ta = tb0; TS_LD(0, 35, 6) x[34] -= x[28] * ta[0]; x[34] -= x[29] * ta[1]; x[34] -= x[30] * ta[2]; x[34] -= x[31] * ta[3]; }
    { const f32x4 ta = tb1; TS_LD(1, 35, 7) x[34] -= x[32] * ta[0]; x[34] -= x[33] * ta[1]; }
    { const f32x4 ta = tb2; TS_LD(2, 35, 8) x[35] -= x[0] * ta[0]; x[35] -= x[1] * ta[1]; x[35] -= x[2] * ta[2]; x[35] -= x[3] * ta[3]; }
    { const f32x4 ta = tb3; TS_LD(3, 36, 0) x[35] -= x[4] * ta[0]; x[35] -= x[5] * ta[1]; x[35] -= x[6] * ta[2]; x[35] -= x[7] * ta[3]; }
    { const f32x4 ta = tb4; TS_LD(4, 36, 1) x[35] -= x[8] * ta[0]; x[35] -= x[9] * ta[1]; x[35] -= x[10] * ta[2]; x[35] -= x[11] * ta[3]; }
    { const f32x4 ta = tb5; TS_LD(5, 36, 2) x[35] -= x[12] * ta[0]; x[35] -= x[13] * ta[1]; x[35] -= x[14] * ta[2]; x[35] -= x[15] * ta[3]; }
    { const f32x4 ta = tb6; TS_LD(6, 36, 3) x[35] -= x[16] * ta[0]; x[35] -= x[17] * ta[1]; x[35] -= x[18] * ta[2]; x[35] -= x[19] * ta[3]; }
    { const f32x4 ta = tb7; TS_LD(7, 36, 4) x[35] -= x[20] * ta[0]; x[35] -= x[21] * ta[1]; x[35] -= x[22] * ta[2]; x[35] -= x[23] * ta[3]; }
    { const f32x4 ta = tb0; TS_LD(0, 36, 5) x[35] -= x[24] * ta[0]; x[35] -= x[25] * ta[1]; x[35] -= x[26] * ta[2]; x[35] -= x[27] * ta[3]; }
    { const f32x4 ta = tb1; TS_LD(1, 36, 6) x[35] -= x[28] * ta[0]; x[35] -= x[29] * ta[1]; x[35] -= x[30] * ta[2]; x[35] -= x[31] * ta[3]; }
    { const f32x4 ta = tb2; TS_LD(2, 36, 7) x[35] -= x[32] * ta[0]; x[35] -= x[33] * ta[1]; x[35] -= x[34] * ta[2]; }
    { const f32x4 ta = tb3; TS_LD(3, 36, 8) x[36] -= x[0] * ta[0]; x[36] -= x[1] * ta[1]; x[36] -= x[2] * ta[2]; x[36] -= x[3] * ta[3]; }
    { const f32x4 ta = tb4; TS_LD(4, 37, 0) x[36] -= x[4] * ta[0]; x[36] -= x[5] * ta[1]; x[36] -= x[6] * ta[2]; x[36] -= x[7] * ta[3]; }
    { const f32x4 ta = tb5; TS_LD(5, 37, 1) x[36] -= x[8] * ta[0]; x[36] -= x[9] * ta[1]; x[36] -= x[10] * ta[2]; x[36] -= x[11] * ta[3]; }
    { const f32x4 ta = tb6; TS_LD(6, 37, 2) x[36] -= x[12] * ta[0]; x[36] -= x[13] * ta[1]; x[36] -= x[14] * ta[2]; x[36] -= x[15] * ta[3]; }
    { const f32x4 ta = tb7; TS_LD(7, 37, 3) x[36] -= x[16] * ta[0]; x[36] -= x[17] * ta[1]; x[36] -= x[18] * ta[2]; x[36] -= x[19] * ta[3]; }
    { const f32x4 ta = tb0; TS_LD(0, 37, 4) x[36] -= x[20] * ta[0]; x[36] -= x[21] * ta[1]; x[36] -= x[22] * ta[2]; x[36] -= x[23] * ta[3]; }
    { const f32x4 ta = tb1; TS_LD(1, 37, 5) x[36] -= x[24] * ta[0]; x[36] -= x[25] * ta[1]; x[36] -= x[26] * ta[2]; x[36] -= x[27] * ta[3]; }
    { const f32x4 ta = tb2; TS_LD(2, 37, 6) x[36] -= x[28] * ta[0]; x[36] -= x[29] * ta[1]; x[36] -= x[30] * ta[2]; x[36] -= x[31] * ta[3]; }
    { const f32x4 ta = tb3; TS_LD(3, 37, 7) x[36] -= x[32] * ta[0]; x[36] -= x[33] * ta[1]; x[36] -= x[34] * ta[2]; x[36] -= x[35] * ta[3]; }
    { const f32x4 ta = tb4; TS_LD(4, 37, 8) x[37] -= x[0] * ta[0]; x[37] -= x[1] * ta[1]; x[37] -= x[2] * ta[2]; x[37] -= x[3] * ta[3]; }
    { const f32x4 ta = tb5; TS_LD(5, 37, 9) x[37] -= x[4] * ta[0]; x[37] -= x[5] * ta[1]; x[37] -= x[6] * ta[2]; x[37] -= x[7] * ta[3]; }
    { const f32x4 ta = tb6; TS_LD(6, 38, 0) x[37] -= x[8] * ta[0]; x[37] -= x[9] * ta[1]; x[37] -= x[10] * ta[2]; x[37] -= x[11] * ta[3]; }
    { const f32x4 ta = tb7; TS_LD(7, 38, 1) x[37] -= x[12] * ta[0]; x[37] -= x[13] * ta[1]; x[37] -= x[14] * ta[2]; x[37] -= x[15] * ta[3]; }
    { const f32x4 ta = tb0; TS_LD(0, 38, 2) x[37] -= x[16] * ta[0]; x[37] -= x[17] * ta[1]; x[37] -= x[18] * ta[2]; x[37] -= x[19] * ta[3]; }
    { const f32x4 ta = tb1; TS_LD(1, 38, 3) x[37] -= x[20] * ta[0]; x[37] -= x[21] * ta[1]; x[37] -= x[22] * ta[2]; x[37] -= x[23] * ta[3]; }
    { const f32x4 ta = tb2; TS_LD(2, 38, 4) x[37] -= x[24] * ta[0]; x[37] -= x[25] * ta[1]; x[37] -= x[26] * ta[2]; x[37] -= x[27] * ta[3]; }
    { const f32x4 ta = tb3; TS_LD(3, 38, 5) x[37] -= x[28] * ta[0]; x[37] -= x[29] * ta[1]; x[37] -= x[30] * ta[2]; x[37] -= x[31] * ta[3]; }
    { const f32x4 ta = tb4; TS_LD(4, 38, 6) x[37] -= x[32] * ta[0]; x[37] -= x[33] * ta[1]; x[37] -= x[34] * ta[2]; x[37] -= x[35] * ta[3]; }
    { const f32x4 ta = tb5; TS_LD(5, 38, 7) x[37] -= x[36] * ta[0]; }
    { const f32x4 ta = tb6; TS_LD(6, 38, 8) x[38] -= x[0] * ta[0]; x[38] -= x[1] * ta[1]; x[38] -= x[2] * ta[2]; x[38] -= x[3] * ta[3]; }
    { const f32x4 ta = tb7; TS_LD(7, 38, 9) x[38] -= x[4] * ta[0]; x[38] -= x[5] * ta[1]; x[38] -= x[6] * ta[2]; x[38] -= x[7] * ta[3]; }
    { const f32x4 ta = tb0; TS_LD(0, 39, 0) x[38] -= x[8] * ta[0]; x[38] -= x[9] * ta[1]; x[38] -= x[10] * ta[2]; x[38] -= x[11] * ta[3]; }
    { const f32x4 ta = tb1; TS_LD(1, 39, 1) x[38] -= x[12] * ta[0]; x[38] -= x[13] * ta[1]; x[38] -= x[14] * ta[2]; x[38] -= x[15] * ta[3]; }
    { const f32x4 ta = tb2; TS_LD(2, 39, 2) x[38] -= x[16] * ta[0]; x[38] -= x[17] * ta[1]; x[38] -= x[18] * ta[2]; x[38] -= x[19] * ta[3]; }
    { const f32x4 ta = tb3; TS_LD(3, 39, 3) x[38] -= x[20] * ta[0]; x[38] -= x[21] * ta[1]; x[38] -= x[22] * ta[2]; x[38] -= x[23] * ta[3]; }
    { const f32x4 ta = tb4; TS_LD(4, 39, 4) x[38] -= x[24] * ta[0]; x[38] -= x[25] * ta[1]; x[38] -= x[26] * ta[2]; x[38] -= x[27] * ta[3]; }
    { const f32x4 ta = tb5; TS_LD(5, 39, 5) x[38] -= x[28] * ta[0]; x[38] -= x[29] * ta[1]; x[38] -= x[30] * ta[2]; x[38] -= x[31] * ta[3]; }
    { const f32x4 ta = tb6; TS_LD(6, 39, 6) x[38] -= x[32] * ta[0]; x[38] -= x[33] * ta[1]; x[38] -= x[34] * ta[2]; x[38] -= x[35] * ta[3]; }
    { const f32x4 ta = tb7; TS_LD(7, 39, 7) x[38] -= x[36] * ta[0]; x[38] -= x[37] * ta[1]; }
    { const f32x4 ta = tb0; TS_LD(0, 39, 8) x[39] -= x[0] * ta[0]; x[39] -= x[1] * ta[1]; x[39] -= x[2] * ta[2]; x[39] -= x[3] * ta[3]; }
    { const f32x4 ta = tb1; TS_LD(1, 39, 9) x[39] -= x[4] * ta[0]; x[39] -= x[5] * ta[1]; x[39] -= x[6] * ta[2]; x[39] -= x[7] * ta[3]; }
    { const f32x4 ta = tb2; TS_LD(2, 40, 0) x[39] -= x[8] * ta[0]; x[39] -= x[9] * ta[1]; x[39] -= x[10] * ta[2]; x[39] -= x[11] * ta[3]; }
    { const f32x4 ta = tb3; TS_LD(3, 40, 1) x[39] -= x[12] * ta[0]; x[39] -= x[13] * ta[1]; x[39] -= x[14] * ta[2]; x[39] -= x[15] * ta[3]; }
    { const f32x4 ta = tb4; TS_LD(4, 40, 2) x[39] -= x[16] * ta[0]; x[39] -= x[17] * ta[1]; x[39] -= x[18] * ta[2]; x[39] -= x[19] * ta[3]; }
    { const f32x4 ta = tb5; TS_LD(5, 40, 3) x[39] -= x[20] * ta[0]; x[39] -= x[21] * ta[1]; x[39] -= x[22] * ta[2]; x[39] -= x[23] * ta[3]; }
    { const f32x4 ta = tb6; TS_LD(6, 40, 4) x[39] -= x[24] * ta[0]; x[39] -= x[25] * ta[1]; x[39] -= x[26] * ta[2]; x[39] -= x[27] * ta[3]; }
    { const f32x4 ta = tb7; TS_LD(7, 40, 5) x[39] -= x[28] * ta[0]; x[39] -= x[29] * ta[1]; x[39] -= x[30] * ta[2]; x[39] -= x[31] * ta[3]; }
    { const f32x4 ta = tb0; TS_LD(0, 40, 6) x[39] -= x[32] * ta[0]; x[39] -= x[33] * ta[1]; x[39] -= x[34] * ta[2]; x[39] -= x[35] * ta[3]; }
    { const f32x4 ta = tb1; TS_LD(1, 40, 7) x[39] -= x[36] * ta[0]; x[39] -= x[37] * ta[1]; x[39] -= x[38] * ta[2]; }
    { const f32x4 ta = tb2; TS_LD(2, 40, 8) x[40] -= x[0] * ta[0]; x[40] -= x[1] * ta[1]; x[40] -= x[2] * ta[2]; x[40] -= x[3] * ta[3]; }
    { const f32x4 ta = tb3; TS_LD(3, 40, 9) x[40] -= x[4] * ta[0]; x[40] -= x[5] * ta[1]; x[40] -= x[6] * ta[2]; x[40] -= x[7] * ta[3]; }
    { const f32x4 ta = tb4; TS_LD(4, 41, 0) x[40] -= x[8] * ta[0]; x[40] -= x[9] * ta[1]; x[40] -= x[10] * ta[2]; x[40] -= x[11] * ta[3]; }
    { const f32x4 ta = tb5; TS_LD(5, 41, 1) x[40] -= x[12] * ta[0]; x[40] -= x[13] * ta[1]; x[40] -= x[14] * ta[2]; x[40] -= x[15] * ta[3]; }
    { const f32x4 ta = tb6; TS_LD(6, 41, 2) x[40] -= x[16] * ta[0]; x[40] -= x[17] * ta[1]; x[40] -= x[18] * ta[2]; x[40] -= x[19] * ta[3]; }
    { const f32x4 ta = tb7; TS_LD(7, 41, 3) x[40] -= x[20] * ta[0]; x[40] -= x[21] * ta[1]; x[40] -= x[22] * ta[2]; x[40] -= x[23] * ta[3]; }
    { const f32x4 ta = tb0; TS_LD(0, 41, 4) x[40] -= x[24] * ta[0]; x[40] -= x[25] * ta[1]; x[40] -= x[26] * ta[2]; x[40] -= x[27] * ta[3]; }
    { const f32x4 ta = tb1; TS_LD(1, 41, 5) x[40] -= x[28] * ta[0]; x[40] -= x[29] * ta[1]; x[40] -= x[30] * ta[2]; x[40] -= x[31] * ta[3]; }
    { const f32x4 ta = tb2; TS_LD(2, 41, 6) x[40] -= x[32] * ta[0]; x[40] -= x[33] * ta[1]; x[40] -= x[34] * ta[2]; x[40] -= x[35] * ta[3]; }
    { const f32x4 ta = tb3; TS_LD(3, 41, 7) x[40] -= x[36] * ta[0]; x[40] -= x[37] * ta[1]; x[40] -= x[38] * ta[2]; x[40] -= x[39] * ta[3]; }
    { const f32x4 ta = tb4; TS_LD(4, 41, 8) x[41] -= x[0] * ta[0]; x[41] -= x[1] * ta[1]; x[41] -= x[2] * ta[2]; x[41] -= x[3] * ta[3]; }
    { const f32x4 ta = tb5; TS_LD(5, 41, 9) x[41] -= x[4] * ta[0]; x[41] -= x[5] * ta[1]; x[41] -= x[6] * ta[2]; x[41] -= x[7] * ta[3]; }
    { const f32x4 ta = tb6; TS_LD(6, 41, 10) x[41] -= x[8] * ta[0]; x[41] -= x[9] * ta[1]; x[41] -= x[10] * ta[2]; x[41] -= x[11] * ta[3]; }
    { const f32x4 ta = tb7; TS_LD(7, 42, 0) x[41] -= x[12] * ta[0]; x[41] -= x[13] * ta[1]; x[41] -= x[14] * ta[2]; x[41] -= x[15] * ta[3]; }
    { const f32x4 ta = tb0; TS_LD(0, 42, 1) x[41] -= x[16] * ta[0]; x[41] -= x[17] * ta[1]; x[41] -= x[18] * ta[2]; x[41] -= x[19] * ta[3]; }
    { const f32x4 ta = tb1; TS_LD(1, 42, 2) x[41] -= x[20] * ta[0]; x[41] -= x[21] * ta[1]; x[41] -= x[22] * ta[2]; x[41] -= x[23] * ta[3]; }
    { const f32x4 ta = tb2; TS_LD(2, 42, 3) x[41] -= x[24] * ta[0]; x[41] -= x[25] * ta[1]; x[41] -= x[26] * ta[2]; x[41] -= x[27] * ta[3]; }
    { const f32x4 ta = tb3; TS_LD(3, 42, 4) x[41] -= x[28] * ta[0]; x[41] -= x[29] * ta[1]; x[41] -= x[30] * ta[2]; x[41] -= x[31] * ta[3]; }
    { const f32x4 ta = tb4; TS_LD(4, 42, 5) x[41] -= x[32] * ta[0]; x[41] -= x[33] * ta[1]; x[41] -= x[34] * ta[2]; x[41] -= x[35] * ta[3]; }
    { const f32x4 ta = tb5; TS_LD(5, 42, 6) x[41] -= x[36] * ta[0]; x[41] -= x[37] * ta[1]; x[41] -= x[38] * ta[2]; x[41] -= x[39] * ta[3]; }
    { const f32x4 ta = tb6; TS_LD(6, 42, 7) x[41] -= x[40] * ta[0]; }
    { const f32x4 ta = tb7; TS_LD(7, 42, 8) x[42] -= x[0] * ta[0]; x[42] -= x[1] * ta[1]; x[42] -= x[2] * ta[2]; x[42] -= x[3] * ta[3]; }
    { const f32x4 ta = tb0; TS_LD(0, 42, 9) x[42] -= x[4] * ta[0]; x[42] -= x[5] * ta[1]; x[42] -= x[6] * ta[2]; x[42] -= x[7] * ta[3]; }
    { const f32x4 ta = tb1; TS_LD(1, 42, 10) x[42] -= x[8] * ta[0]; x[42] -= x[9] * ta[1]; x[42] -= x[10] * ta[2]; x[42] -= x[11] * ta[3]; }
    { const f32x4 ta = tb2; TS_LD(2, 43, 0) x[42] -= x[12] * ta[0]; x[42] -= x[13] * ta[1]; x[42] -= x[14] * ta[2]; x[42] -= x[15] * ta[3]; }
    { const f32x4 ta = tb3; TS_LD(3, 43, 1) x[42] -= x[16] * ta[0]; x[42] -= x[17] * ta[1]; x[42] -= x[18] * ta[2]; x[42] -= x[19] * ta[3]; }
    { const f32x4 ta = tb4; TS_LD(4, 43, 2) x[42] -= x[20] * ta[0]; x[42] -= x[21] * ta[1]; x[42] -= x[22] * ta[2]; x[42] -= x[23] * ta[3]; }
    { const f32x4 ta = tb5; TS_LD(5, 43, 3) x[42] -= x[24] * ta[0]; x[42] -= x[25] * ta[1]; x[42] -= x[26] * ta[2]; x[42] -= x[27] * ta[3]; }
    { const f32x4 ta = tb6; TS_LD(6, 43, 4) x[42] -= x[28] * ta[0]; x[42] -= x[29] * ta[1]; x[42] -= x[30] * ta[2]; x[42] -= x[31] * ta[3]; }
    { const f32x4 ta = tb7; TS_LD(7, 43, 5) x[42] -= x[32] * ta[0]; x[42] -= x[33] * ta[1]; x[42] -= x[34] * ta[2]; x[42] -= x[35] * ta[3]; }
    { const f32x4 ta = tb0; TS_LD(0, 43, 6) x[42] -= x[36] * ta[0]; x[42] -= x[37] * ta[1]; x[42] -= x[38] * ta[2]; x[42] -= x[39] * ta[3]; }
    { const f32x4 ta = tb1; TS_LD(1, 43, 7) x[42] -= x[40] * ta[0]; x[42] -= x[41] * ta[1]; }
    { const f32x4 ta = tb2; TS_LD(2, 43, 8) x[43] -= x[0] * ta[0]; x[43] -= x[1] * ta[1]; x[43] -= x[2] * ta[2]; x[43] -= x[3] * ta[3]; }
    { const f32x4 ta = tb3; TS_LD(3, 43, 9) x[43] -= x[4] * ta[0]; x[43] -= x[5] * ta[1]; x[43] -= x[6] * ta[2]; x[43] -= x[7] * ta[3]; }
    { const f32x4 ta = tb4; TS_LD(4, 43, 10) x[43] -= x[8] * ta[0]; x[43] -= x[9] * ta[1]; x[43] -= x[10] * ta[2]; x[43] -= x[11] * ta[3]; }
    { const f32x4 ta = tb5; TS_LD(5, 44, 0) x[43] -= x[12] * ta[0]; x[43] -= x[13] * ta[1]; x[43] -= x[14] * ta[2]; x[43] -= x[15] * ta[3]; }
    { const f32x4 ta = tb6; TS_LD(6, 44, 1) x[43] -= x[16] * ta[0]; x[43] -= x[17] * ta[1]; x[43] -= x[18] * ta[2]; x[43] -= x[19] * ta[3]; }
    { const f32x4 ta = tb7; TS_LD(7, 44, 2) x[43] -= x[20] * ta[0]; x[43] -= x[21] * ta[1]; x[43] -= x[22] * ta[2]; x[43] -= x[23] * ta[3]; }
    { const f32x4 ta = tb0; TS_LD(0, 44, 3) x[43] -= x[24] * ta[0]; x[43] -= x[25] * ta[1]; x[43] -= x[26] * ta[2]; x[43] -= x[27] * ta[3]; }
    { const f32x4 ta = tb1; TS_LD(1, 44, 4) x[43] -= x[28] * ta[0]; x[43] -= x[29] * ta[1]; x[43] -= x[30] * ta[2]; x[43] -= x[31] * ta[3]; }
    { const f32x4 ta = tb2; TS_LD(2, 44, 5) x[43] -= x[32] * ta[0]; x[43] -= x[33] * ta[1]; x[43] -= x[34] * ta[2]; x[43] -= x[35] * ta[3]; }
    { const f32x4 ta = tb3; TS_LD(3, 44, 6) x[43] -= x[36] * ta[0]; x[43] -= x[37] * ta[1]; x[43] -= x[38] * ta[2]; x[43] -= x[39] * ta[3]; }
    { const f32x4 ta = tb4; TS_LD(4, 44, 7) x[43] -= x[40] * ta[0]; x[43] -= x[41] * ta[1]; x[43] -= x[42] * ta[2]; }
    { const f32x4 ta = tb5; TS_LD(5, 44, 8) x[44] -= x[0] * ta[0]; x[44] -= x[1] * ta[1]; x[44] -= x[2] * ta[2]; x[44] -= x[3] * ta[3]; }
    { const f32x4 ta = tb6; TS_LD(6, 44, 9) x[44] -= x[4] * ta[0]; x[44] -= x[5] * ta[1]; x[44] -= x[6] * ta[2]; x[44] -= x[7] * ta[3]; }
    { const f32x4 ta = tb7; TS_LD(7, 44, 10) x[44] -= x[8] * ta[0]; x[44] -= x[9] * ta[1]; x[44] -= x[10] * ta[2]; x[44] -= x[11] * ta[3]; }
    { const f32x4 ta = tb0; TS_LD(0, 45, 0) x[44] -= x[12] * ta[0]; x[44] -= x[13] * ta[1]; x[44] -= x[14] * ta[2]; x[44] -= x[15] * ta[3]; }
    { const f32x4 ta = tb1; TS_LD(1, 45, 1) x[44] -= x[16] * ta[0]; x[44] -= x[17] * ta[1]; x[44] -= x[18] * ta[2]; x[44] -= x[19] * ta[3]; }
    { const f32x4 ta = tb2; TS_LD(2, 45, 2) x[44] -= x[20] * ta[0]; x[44] -= x[21] * ta[1]; x[44] -= x[22] * ta[2]; x[44] -= x[23] * ta[3]; }
    { const f32x4 ta = tb3; TS_LD(3, 45, 3) x[44] -= x[24] * ta[0]; x[44] -= x[25] * ta[1]; x[44] -= x[26] * ta[2]; x[44] -= x[27] * ta[3]; }
    { const f32x4 ta = tb4; TS_LD(4, 45, 4) x[44] -= x[28] * ta[0]; x[44] -= x[29] * ta[1]; x[44] -= x[30] * ta[2]; x[44] -= x[31] * ta[3]; }
    { const f32x4 ta = tb5; TS_LD(5, 45, 5) x[44] -= x[32] * ta[0]; x[44] -= x[33] * ta[1]; x[44] -= x[34] * ta[2]; x[44] -= x[35] * ta[3]; }
    { const f32x4 ta = tb6; TS_LD(6, 45, 6) x[44] -= x[36] * ta[0]; x[44] -= x[37] * ta[1]; x[44] -= x[38] * ta[2]; x[44] -= x[39] * ta[3]; }
    { const f32x4 ta = tb7; TS_LD(7, 45, 7) x[44] -= x[40] * ta[0]; x[44] -= x[41] * ta[1]; x[44] -= x[42] * ta[2]; x[44] -= x[43] * ta[3]; }
    { const f32x4 ta = tb0; TS_LD(0, 45, 8) x[45] -= x[0] * ta[0]; x[45] -= x[1] * ta[1]; x[45] -= x[2] * ta[2]; x[45] -= x[3] * ta[3]; }
    { const f32x4 ta = tb1; TS_LD(1, 45, 9) x[45] -= x[4] * ta[0]; x[45] -= x[5] * ta[1]; x[45] -= x[6] * ta[2]; x[45] -= x[7] * ta[3]; }
    { const f32x4 ta = tb2; TS_LD(2, 45, 10) x[45] -= x[8] * ta[0]; x[45] -= x[9] * ta[1]; x[45] -= x[10] * ta[2]; x[45] -= x[11] * ta[3]; }
    { const f32x4 ta = tb3; TS_LD(3, 45, 11) x[45] -= x[12] * ta[0]; x[45] -= x[13] * ta[1]; x[45] -= x[14] * ta[2]; x[45] -= x[15] * ta[3]; }
    { const f32x4 ta = tb4; TS_LD(4, 46, 0) x[45] -= x[16] * ta[0]; x[45] -= x[17] * ta[1]; x[45] -= x[18] * ta[2]; x[45] -= x[19] * ta[3]; }
    { const f32x4 ta = tb5; TS_LD(5, 46, 1) x[45] -= x[20] * ta[0]; x[45] -= x[21] * ta[1]; x[45] -= x[22] * ta[2]; x[45] -= x[23] * ta[3]; }
    { const f32x4 ta = tb6; TS_LD(6, 46, 2) x[45] -= x[24] * ta[0]; x[45] -= x[25] * ta[1]; x[45] -= x[26] * ta[2]; x[45] -= x[27] * ta[3]; }
    { const f32x4 ta = tb7; TS_LD(7, 46, 3) x[45] -= x[28] * ta[0]; x[45] -= x[29] * ta[1]; x[45] -= x[30] * ta[2]; x[45] -= x[31] * ta[3]; }
    { const f32x4 ta = tb0; TS_LD(0, 46, 4) x[45] -= x[32] * ta[0]; x[45] -= x[33] * ta[1]; x[45] -= x[34] * ta[2]; x[45] -= x[35] * ta[3]; }
    { const f32x4 ta = tb1; TS_LD(1, 46, 5) x[45] -= x[36] * ta[0]; x[45] -= x[37] * ta[1]; x[45] -= x[38] * ta[2]; x[45] -= x[39] * ta[3]; }
    { const f32x4 ta = tb2; TS_LD(2, 46, 6) x[45] -= x[40] * ta[0]; x[45] -= x[41] * ta[1]; x[45] -= x[42] * ta[2]; x[45] -= x[43] * ta[3]; }
    { const f32x4 ta = tb3; TS_LD(3, 46, 7) x[45] -= x[44] * ta[0]; }
    { const f32x4 ta = tb4; TS_LD(4, 46, 8) x[46] -= x[0] * ta[0]; x[46] -= x[1] * ta[1]; x[46] -= x[2] * ta[2]; x[46] -= x[3] * ta[3]; }
    { const f32x4 ta = tb5; TS_LD(5, 46, 9) x[46] -= x[4] * ta[0]; x[46] -= x[5] * ta[1]; x[46] -= x[6] * ta[2]; x[46] -= x[7] * ta[3]; }
    { const f32x4 ta = tb6; TS_LD(6, 46, 10) x[46] -= x[8] * ta[0]; x[46] -= x[9] * ta[1]; x[46] -= x[10] * ta[2]; x[46] -= x[11] * ta[3]; }
    { const f32x4 ta = tb7; TS_LD(7, 46, 11) x[46] -= x[12] * ta[0]; x[46] -= x[13] * ta[1]; x[46] -= x[14] * ta[2]; x[46] -= x[15] * ta[3]; }
    { const f32x4 ta = tb0; TS_LD(0, 47, 0) x[46] -= x[16] * ta[0]; x[46] -= x[17] * ta[1]; x[46] -= x[18] * ta[2]; x[46] -= x[19] * ta[3]; }
    { const f32x4 ta = tb1; TS_LD(1, 47, 1) x[46] -= x[20] * ta[0]; x[46] -= x[21] * ta[1]; x[46] -= x[22] * ta[2]; x[46] -= x[23] * ta[3]; }
    { const f32x4 ta = tb2; TS_LD(2, 47, 2) x[46] -= x[24] * ta[0]; x[46] -= x[25] * ta[1]; x[46] -= x[26] * ta[2]; x[46] -= x[27] * ta[3]; }
    { const f32x4 ta = tb3; TS_LD(3, 47, 3) x[46] -= x[28] * ta[0]; x[46] -= x[29] * ta[1]; x[46] -= x[30] * ta[2]; x[46] -= x[31] * ta[3]; }
    { const f32x4 ta = tb4; TS_LD(4, 47, 4) x[46] -= x[32] * ta[0]; x[46] -= x[33] * ta[1]; x[46] -= x[34] * ta[2]; x[46] -= x[35] * ta[3]; }
    { const f32x4 ta = tb5; TS_LD(5, 47, 5) x[46] -= x[36] * ta[0]; x[46] -= x[37] * ta[1]; x[46] -= x[38] * ta[2]; x[46] -= x[39] * ta[3]; }
    { const f32x4 ta = tb6; TS_LD(6, 47, 6) x[46] -= x[40] * ta[0]; x[46] -= x[41] * ta[1]; x[46] -= x[42] * ta[2]; x[46] -= x[43] * ta[3]; }
    { const f32x4 ta = tb7; TS_LD(7, 47, 7) x[46] -= x[44] * ta[0]; x[46] -= x[45] * ta[1]; }
    { const f32x4 ta = tb0; TS_LD(0, 47, 8) x[47] -= x[0] * ta[0]; x[47] -= x[1] * ta[1]; x[47] -= x[2] * ta[2]; x[47] -= x[3] * ta[3]; }
    { const f32x4 ta = tb1; TS_LD(1, 47, 9) x[47] -= x[4] * ta[0]; x[47] -= x[5] * ta[1]; x[47] -= x[6] * ta[2]; x[47] -= x[7] * ta[3]; }
    { const f32x4 ta = tb2; TS_LD(2, 47, 10) x[47] -= x[8] * ta[0]; x[47] -= x[9] * ta[1]; x[47] -= x[10] * ta[2]; x[47] -= x[11] * ta[3]; }
    { const f32x4 ta = tb3; TS_LD(3, 47, 11) x[47] -= x[12] * ta[0]; x[47] -= x[13] * ta[1]; x[47] -= x[14] * ta[2]; x[47] -= x[15] * ta[3]; }
    { const f32x4 ta = tb4; TS_LD(4, 48, 0) x[47] -= x[16] * ta[0]; x[47] -= x[17] * ta[1]; x[47] -= x[18] * ta[2]; x[47] -= x[19] * ta[3]; }
    { const f32x4 ta = tb5; TS_LD(5, 48, 1) x[47] -= x[20] * ta[0]; x[47] -= x[21] * ta[1]; x[47] -= x[22] * ta[2]; x[47] -= x[23] * ta[3]; }
    { const f32x4 ta = tb6; TS_LD(6, 48, 2) x[47] -= x[24] * ta[0]; x[47] -= x[25] * ta[1]; x[47] -= x[26] * ta[2]; x[47] -= x[27] * ta[3]; }
    { const f32x4 ta = tb7; TS_LD(7, 48, 3) x[47] -= x[28] * ta[0]; x[47] -= x[29] * ta[1]; x[47] -= x[30] * ta[2]; x[47] -= x[31] * ta[3]; }
    { const f32x4 ta = tb0; TS_LD(0, 48, 4) x[47] -= x[32] * ta[0]; x[47] -= x[33] * ta[1]; x[47] -= x[34] * ta[2]; x[47] -= x[35] * ta[3]; }
    { const f32x4 ta = tb1; TS_LD(1, 48, 5) x[47] -= x[36] * ta[0]; x[47] -= x[37] * ta[1]; x[47] -= x[38] * ta[2]; x[47] -= x[39] * ta[3]; }
    { const f32x4 ta = tb2; TS_LD(2, 48, 6) x[47] -= x[40] * ta[0]; x[47] -= x[41] * ta[1]; x[47] -= x[42] * ta[2]; x[47] -= x[43] * ta[3]; }
    { const f32x4 ta = tb3; TS_LD(3, 48, 7) x[47] -= x[44] * ta[0]; x[47] -= x[45] * ta[1]; x[47] -= x[46] * ta[2]; }
    { const f32x4 ta = tb4; TS_LD(4, 48, 8) x[48] -= x[0] * ta[0]; x[48] -= x[1] * ta[1]; x[48] -= x[2] * ta[2]; x[48] -= x[3] * ta[3]; }
    { const f32x4 ta = tb5; TS_LD(5, 48, 9) x[48] -= x[4] * ta[0]; x[48] -= x[5] * ta[1]; x[48] -= x[6] * ta[2]; x[48] -= x[7] * ta[3]; }
    { const f32x4 ta = tb6; TS_LD(6, 48, 10) x[48] -= x[8] * ta[0]; x[48] -= x[9] * ta[1]; x[48] -= x[10] * ta[2]; x[48] -= x[11] * ta[3]; }
    { const f32x4 ta = tb7; TS_LD(7, 48, 11) x[48] -= x[12] * ta[0]; x[48] -= x[13] * ta[1]; x[48] -= x[14] * ta[2]; x[48] -= x[15] * ta[3]; }
    { const f32x4 ta = tb0; TS_LD(0, 49, 0) x[48] -= x[16] * ta[0]; x[48] -= x[17] * ta[1]; x[48] -= x[18] * ta[2]; x[48] -= x[19] * ta[3]; }
    { const f32x4 ta = tb1; TS_LD(1, 49, 1) x[48] -= x[20] * ta[0]; x[48] -= x[21] * ta[1]; x[48] -= x[22] * ta[2]; x[48] -= x[23] * ta[3]; }
    { const f32x4 ta = tb2; TS_LD(2, 49, 2) x[48] -= x[24] * ta[0]; x[48] -= x[25] * ta[1]; x[48] -= x[26] * ta[2]; x[48] -= x[27] * ta[3]; }
    { const f32x4 ta = tb3; TS_LD(3, 49, 3) x[48] -= x[28] * ta[0]; x[48] -= x[29] * ta[1]; x[48] -= x[30] * ta[2]; x[48] -= x[31] * ta[3]; }
    { const f32x4 ta = tb4; TS_LD(4, 49, 4) x[48] -= x[32] * ta[0]; x[48] -= x[33] * ta[1]; x[48] -= x[34] * ta[2]; x[48] -= x[35] * ta[3]; }
    { const f32x4 ta = tb5; TS_LD(5, 49, 5) x[48] -= x[36] * ta[0]; x[48] -= x[37] * ta[1]; x[48] -= x[38] * ta[2]; x[48] -= x[39] * ta[3]; }
    { const f32x4 ta = tb6; TS_LD(6, 49, 6) x[48] -= x[40] * ta[0]; x[48] -= x[41] * ta[1]; x[48] -= x[42] * ta[2]; x[48] -= x[43] * ta[3]; }
    { const f32x4 ta = tb7; TS_LD(7, 49, 7) x[48] -= x[44] * ta[0]; x[48] -= x[45] * ta[1]; x[48] -= x[46] * ta[2]; x[48] -= x[47] * ta[3]; }
    { const f32x4 ta = tb0; TS_LD(0, 49, 8) x[49] -= x[0] * ta[0]; x[49] -= x[1] * ta[1]; x[49] -= x[2] * ta[2]; x[49] -= x[3] * ta[3]; }
    { const f32x4 ta = tb1; TS_LD(1, 49, 9) x[49] -= x[4] * ta[0]; x[49] -= x[5] * ta[1]; x[49] -= x[6] * ta[2]; x[49] -= x[7] * ta[3]; }
    { const f32x4 ta = tb2; TS_LD(2, 49, 10) x[49] -= x[8] * ta[0]; x[49] -= x[9] * ta[1]; x[49] -= x[10] * ta[2]; x[49] -= x[11] * ta[3]; }
    { const f32x4 ta = tb3; TS_LD(3, 49, 11) x[49] -= x[12] * ta[0]; x[49] -= x[13] * ta[1]; x[49] -= x[14] * ta[2]; x[49] -= x[15] * ta[3]; }
    { const f32x4 ta = tb4; TS_LD(4, 49, 12) x[49] -= x[16] * ta[0]; x[49] -= x[17] * ta[1]; x[49] -= x[18] * ta[2]; x[49] -= x[19] * ta[3]; }
    { const f32x4 ta = tb5; TS_LD(5, 50, 0) x[49] -= x[20] * ta[0]; x[49] -= x[21] * ta[1]; x[49] -= x[22] * ta[2]; x[49] -= x[23] * ta[3]; }
    { const f32x4 ta = tb6; TS_LD(6, 50, 1) x[49] -= x[24] * ta[0]; x[49] -= x[25] * ta[1]; x[49] -= x[26] * ta[2]; x[49] -= x[27] * ta[3]; }
    { const f32x4 ta = tb7; TS_LD(7, 50, 2) x[49] -= x[28] * ta[0]; x[49] -= x[29] * ta[1]; x[49] -= x[30] * ta[2]; x[49] -= x[31] * ta[3]; }
    { const f32x4 ta = tb0; TS_LD(0, 50, 3) x[49] -= x[32] * ta[0]; x[49] -= x[33] * ta[1]; x[49] -= x[34] * ta[2]; x[49] -= x[35] * ta[3]; }
    { const f32x4 ta = tb1; TS_LD(1, 50, 4) x[49] -= x[36] * ta[0]; x[49] -= x[37] * ta[1]; x[49] -= x[38] * ta[2]; x[49] -= x[39] * ta[3]; }
    { const f32x4 ta = tb2; TS_LD(2, 50, 5) x[49] -= x[40] * ta[0]; x[49] -= x[41] * ta[1]; x[49] -= x[42] * ta[2]; x[49] -= x[43] * ta[3]; }
    { const f32x4 ta = tb3; TS_LD(3, 50, 6) x[49] -= x[44] * ta[0]; x[49] -= x[45] * ta[1]; x[49] -= x[46] * ta[2]; x[49] -= x[47] * ta[3]; }
    { const f32x4 ta = tb4; TS_LD(4, 50, 7) x[49] -= x[48] * ta[0]; }
    { const f32x4 ta = tb5; TS_LD(5, 50, 8) x[50] -= x[0] * ta[0]; x[50] -= x[1] * ta[1]; x[50] -= x[2] * ta[2]; x[50] -= x[3] * ta[3]; }
    { const f32x4 ta = tb6; TS_LD(6, 50, 9) x[50] -= x[4] * ta[0]; x[50] -= x[5] * ta[1]; x[50] -= x[6] * ta[2]; x[50] -= x[7] * ta[3]; }
    { const f32x4 ta = tb7; TS_LD(7, 50, 10) x[50] -= x[8] * ta[0]; x[50] -= x[9] * ta[1]; x[50] -= x[10] * ta[2]; x[50] -= x[11] * ta[3]; }
    { const f32x4 ta = tb0; TS_LD(0, 50, 11) x[50] -= x[12] * ta[0]; x[50] -= x[13] * ta[1]; x[50] -= x[14] * ta[2]; x[50] -= x[15] * ta[3]; }
    { const f32x4 ta = tb1; TS_LD(1, 50, 12) x[50] -= x[16] * ta[0]; x[50] -= x[17] * ta[1]; x[50] -= x[18] * ta[2]; x[50] -= x[19] * ta[3]; }
    { const f32x4 ta = tb2; TS_LD(2, 51, 0) x[50] -= x[20] * ta[0]; x[50] -= x[21] * ta[1]; x[50] -= x[22] * ta[2]; x[50] -= x[23] * ta[3]; }
    { const f32x4 ta = tb3; TS_LD(3, 51, 1) x[50] -= x[24] * ta[0]; x[50] -= x[25] * ta[1]; x[50] -= x[26] * ta[2]; x[50] -= x[27] * ta[3]; }
    { const f32x4 ta = tb4; TS_LD(4, 51, 2) x[50] -= x[28] * ta[0]; x[50] -= x[29] * ta[1]; x[50] -= x[30] * ta[2]; x[50] -= x[31] * ta[3]; }
    { const f32x4 ta = tb5; TS_LD(5, 51, 3) x[50] -= x[32] * ta[0]; x[50] -= x[33] * ta[1]; x[50] -= x[34] * ta[2]; x[50] -= x[35] * ta[3]; }
    { const f32x4 ta = tb6; TS_LD(6, 51, 4) x[50] -= x[36] * ta[0]; x[50] -= x[37] * ta[1]; x[50] -= x[38] * ta[2]; x[50] -= x[39] * ta[3]; }
    { const f32x4 ta = tb7; TS_LD(7, 51, 5) x[50] -= x[40] * ta[0]; x[50] -= x[41] * ta[1]; x[50] -= x[42] * ta[2]; x[50] -= x[43] * ta[3]; }
    { const f32x4 ta = tb0; TS_LD(0, 51, 6) x[50] -= x[44] * ta[0]; x[50] -= x[45] * ta[1]; x[50] -= x[46] * ta[2]; x[50] -= x[47] * ta[3]; }
    { const f32x4 ta = tb1; TS_LD(1, 51, 7) x[50] -= x[48] * ta[0]; x[50] -= x[49] * ta[1]; }
    { const f32x4 ta = tb2; TS_LD(2, 51, 8) x[51] -= x[0] * ta[0]; x[51] -= x[1] * ta[1]; x[51] -= x[2] * ta[2]; x[51] -= x[3] * ta[3]; }
    { const f32x4 ta = tb3; TS_LD(3, 51, 9) x[51] -= x[4] * ta[0]; x[51] -= x[5] * ta[1]; x[51] -= x[6] * ta[2]; x[51] -= x[7] * ta[3]; }
    { const f32x4 ta = tb4; TS_LD(4, 51, 10) x[51] -= x[8] * ta[0]; x[51] -= x[9] * ta[1]; x[51] -= x[10] * ta[2]; x[51] -= x[11] * ta[3]; }
    { const f32x4 ta = tb5; TS_LD(5, 51, 11) x[51] -= x[12] * ta[0]; x[51] -= x[13] * ta[1]; x[51] -= x[14] * ta[2]; x[51] -= x[15] * ta[3]; }
    { const f32x4 ta = tb6; TS_LD(6, 51, 12) x[51] -= x[16] * ta[0]; x[51] -= x[17] * ta[1]; x[51] -= x[18] * ta[2]; x[51] -= x[19] * ta[3]; }
    { const f32x4 ta = tb7; TS_LD(7, 52, 0) x[51] -= x[20] * ta[0]; x[51] -= x[21] * ta[1]; x[51] -= x[22] * ta[2]; x[51] -= x[23] * ta[3]; }
    { const f32x4 ta = tb0; TS_LD(0, 52, 1) x[51] -= x[24] * ta[0]; x[51] -= x[25] * ta[1]; x[51] -= x[26] * ta[2]; x[51] -= x[27] * ta[3]; }
    { const f32x4 ta = tb1; TS_LD(1, 52, 2) x[51] -= x[28] * ta[0]; x[51] -= x[29] * ta[1]; x[51] -= x[30] * ta[2]; x[51] -= x[31] * ta[3]; }
    { const f32x4 ta = tb2; TS_LD(2, 52, 3) x[51] -= x[32] * ta[0]; x[51] -= x[33] * ta[1]; x[51] -= x[34] * ta[2]; x[51] -= x[35] * ta[3]; }
    { const f32x4 ta = tb3; TS_LD(3, 52, 4) x[51] -= x[36] * ta[0]; x[51] -= x[37] * ta[1]; x[51] -= x[38] * ta[2]; x[51] -= x[39] * ta[3]; }
    { const f32x4 ta = tb4; TS_LD(4, 52, 5) x[51] -= x[40] * ta[0]; x[51] -= x[41] * ta[1]; x[51] -= x[42] * ta[2]; x[51] -= x[43] * ta[3]; }
    { const f32x4 ta = tb5; TS_LD(5, 52, 6) x[51] -= x[44] * ta[0]; x[51] -= x[45] * ta[1]; x[51] -= x[46] * ta[2]; x[51] -= x[47] * ta[3]; }
    { const f32x4 ta = tb6; TS_LD(6, 52, 7) x[51] -= x[48] * ta[0]; x[51] -= x[49] * ta[1]; x[51] -= x[50] * ta[2]; }
    { const f32x4 ta = tb7; TS_LD(7, 52, 8) x[52] -= x[0] * ta[0]; x[52] -= x[1] * ta[1]; x[52] -= x[2] * ta[2]; x[52] -= x[3] * ta[3]; }
    { const f32x4 ta = tb0; TS_LD(0, 52, 9) x[52] -= x[4] * ta[0]; x[52] -= x[5] * ta[1]; x[52] -= x[6] * ta[2]; x[52] -= x[7] * ta[3]; }
    { const f32x4 ta = tb1; TS_LD(1, 52, 10) x[52] -= x[8] * ta[0]; x[52] -= x[9] * ta[1]; x[52] -= x[10] * ta[2]; x[52] -= x[11] * ta[3]; }
    { const f32x4 ta = tb2; TS_LD(2, 52, 11) x[52] -= x[12] * ta[0]; x[52] -= x[13] * ta[1]; x[52] -= x[14] * ta[2]; x[52] -= x[15] * ta[3]; }
    { const f32x4 ta = tb3; TS_LD(3, 52, 12) x[52] -= x[16] * ta[0]; x[52] -= x[17] * ta[1]; x[52] -= x[18] * ta[2]; x[52] -= x[19] * ta[3]; }
    { const f32x4 ta = tb4; TS_LD(4, 53, 0) x[52] -= x[20] * ta[0]; x[52] -= x[21] * ta[1]; x[52] -= x[22] * ta[2]; x[52] -= x[23] * ta[3]; }
    { const f32x4 ta = tb5; TS_LD(5, 53, 1) x[52] -= x[24] * ta[0]; x[52] -= x[25] * ta[1]; x[52] -= x[26] * ta[2]; x[52] -= x[27] * ta[3]; }
    { const f32x4 ta = tb6; TS_LD(6, 53, 2) x[52] -= x[28] * ta[0]; x[52] -= x[29] * ta[1]; x[52] -= x[30] * ta[2]; x[52] -= x[31] * ta[3]; }
    { const f32x4 ta = tb7; TS_LD(7, 53, 3) x[52] -= x[32] * ta[0]; x[52] -= x[33] * ta[1]; x[52] -= x[34] * ta[2]; x[52] -= x[35] * ta[3]; }
    { const f32x4 ta = tb0; TS_LD(0, 53, 4) x[52] -= x[36] * ta[0]; x[52] -= x[37] * ta[1]; x[52] -= x[38] * ta[2]; x[52] -= x[39] * ta[3]; }
    { const f32x4 ta = tb1; TS_LD(1, 53, 5) x[52] -= x[40] * ta[0]; x[52] -= x[41] * ta[1]; x[52] -= x[42] * ta[2]; x[52] -= x[43] * ta[3]; }
    { const f32x4 ta = tb2; TS_LD(2, 53, 6) x[52] -= x[44] * ta[0]; x[52] -= x[45] * ta[1]; x[52] -= x[46] * ta[2]; x[52] -= x[47] * ta[3]; }
    { const f32x4 ta = tb3; TS_LD(3, 53, 7) x[52] -= x[48] * ta[0]; x[52] -= x[49] * ta[1]; x[52] -= x[50] * ta[2]; x[52] -= x[51] * ta[3]; }
    { const f32x4 ta = tb4; TS_LD(4, 53, 8) x[53] -= x[0] * ta[0]; x[53] -= x[1] * ta[1]; x[53] -= x[2] * ta[2]; x[53] -= x[3] * ta[3]; }
    { const f32x4 ta = tb5; TS_LD(5, 53, 9) x[53] -= x[4] * ta[0]; x[53] -= x[5] * ta[1]; x[53] -= x[6] * ta[2]; x[53] -= x[7] * ta[3]; }
    { const f32x4 ta = tb6; TS_LD(6, 53, 10) x[53] -= x[8] * ta[0]; x[53] -= x[9] * ta[1]; x[53] -= x[10] * ta[2]; x[53] -= x[11] * ta[3]; }
    { const f32x4 ta = tb7; TS_LD(7, 53, 11) x[53] -= x[12] * ta[0]; x[53] -= x[13] * ta[1]; x[53] -= x[14] * ta[2]; x[53] -= x[15] * ta[3]; }
    { const f32x4 ta = tb0; TS_LD(0, 53, 12) x[53] -= x[16] * ta[0]; x[53] -= x[17] * ta[1]; x[53] -= x[18] * ta[2]; x[53] -= x[19] * ta[3]; }
    { const f32x4 ta = tb1; TS_LD(1, 53, 13) x[53] -= x[20] * ta[0]; x[53] -= x[21] * ta[1]; x[53] -= x[22] * ta[2]; x[53] -= x[23] * ta[3]; }
    { const f32x4 ta = tb2; TS_LD(2, 54, 0) x[53] -= x[24] * ta[0]; x[53] -= x[25] * ta[1]; x[53] -= x[26] * ta[2]; x[53] -= x[27] * ta[3]; }
    { const f32x4 ta = tb3; TS_LD(3, 54, 1) x[53] -= x[28] * ta[0]; x[53] -= x[29] * ta[1]; x[53] -= x[30] * ta[2]; x[53] -= x[31] * ta[3]; }
    { const f32x4 ta = tb4; TS_LD(4, 54, 2) x[53] -= x[32] * ta[0]; x[53] -= x[33] * ta[1]; x[53] -= x[34] * ta[2]; x[53] -= x[35] * ta[3]; }
    { const f32x4 ta = tb5; TS_LD(5, 54, 3) x[53] -= x[36] * ta[0]; x[53] -= x[37] * ta[1]; x[53] -= x[38] * ta[2]; x[53] -= x[39] * ta[3]; }
    { const f32x4 ta = tb6; TS_LD(6, 54, 4) x[53] -= x[40] * ta[0]; x[53] -= x[41] * ta[1]; x[53] -= x[42] * ta[2]; x[53] -= x[43] * ta[3]; }
    { const f32x4 ta = tb7; TS_LD(7, 54, 5) x[53] -= x[44] * ta[0]; x[53] -= x[45] * ta[1]; x[53] -= x[46] * ta[2]; x[53] -= x[47] * ta[3]; }
    { const f32x4 ta = tb0; TS_LD(0, 54, 6) x[53] -= x[48] * ta[0]; x[53] -= x[49] * ta[1]; x[53] -= x[50] * ta[2]; x[53] -= x[51] * ta[3]; }
    { const f32x4 ta = tb1; TS_LD(1, 54, 7) x[53] -= x[52] * ta[0]; }
    { const f32x4 ta = tb2; TS_LD(2, 54, 8) x[54] -= x[0] * ta[0]; x[54] -= x[1] * ta[1]; x[54] -= x[2] * ta[2]; x[54] -= x[3] * ta[3]; }
    { const f32x4 ta = tb3; TS_LD(3, 54, 9) x[54] -= x[4] * ta[0]; x[54] -= x[5] * ta[1]; x[54] -= x[6] * ta[2]; x[54] -= x[7] * ta[3]; }
    { const f32x4 ta = tb4; TS_LD(4, 54, 10) x[54] -= x[8] * ta[0]; x[54] -= x[9] * ta[1]; x[54] -= x[10] * ta[2]; x[54] -= x[11] * ta[3]; }
    { const f32x4 ta = tb5; TS_LD(5, 54, 11) x[54] -= x[12] * ta[0]; x[54] -= x[13] * ta[1]; x[54] -= x[14] * ta[2]; x[54] -= x[15] * ta[3]; }
    { const f32x4 ta = tb6; TS_LD(6, 54, 12) x[54] -= x[16] * ta[0]; x[54] -= x[17] * ta[1]; x[54] -= x[18] * ta[2]; x[54] -= x[19] * ta[3]; }
    { const f32x4 ta = tb7; TS_LD(7, 54, 13) x[54] -= x[20] * ta[0]; x[54] -= x[21] * ta[1]; x[54] -= x[22] * ta[2]; x[54] -= x[23] * ta[3]; }
    { const f32x4 ta = tb0; TS_LD(0, 55, 0) x[54] -= x[24] * ta[0]; x[54] -= x[25] * ta[1]; x[54] -= x[26] * ta[2]; x[54] -= x[27] * ta[3]; }
    { const f32x4 ta = tb1; TS_LD(1, 55, 1) x[54] -= x[28] * ta[0]; x[54] -= x[29] * ta[1]; x[54] -= x[30] * ta[2]; x[54] -= x[31] * ta[3]; }
    { const f32x4 ta = tb2; TS_LD(2, 55, 2) x[54] -= x[32] * ta[0]; x[54] -= x[33] * ta[1]; x[54] -= x[34] * ta[2]; x[54] -= x[35] * ta[3]; }
    { const f32x4 ta = tb3; TS_LD(3, 55, 3) x[54] -= x[36] * ta[0]; x[54] -= x[37] * ta[1]; x[54] -= x[38] * ta[2]; x[54] -= x[39] * ta[3]; }
    { const f32x4 ta = tb4; TS_LD(4, 55, 4) x[54] -= x[40] * ta[0]; x[54] -= x[41] * ta[1]; x[54] -= x[42] * ta[2]; x[54] -= x[43] * ta[3]; }
    { const f32x4 ta = tb5; TS_LD(5, 55, 5) x[54] -= x[44] * ta[0]; x[54] -= x[45] * ta[1]; x[54] -= x[46] * ta[2]; x[54] -= x[47] * ta[3]; }
    { const f32x4 ta = tb6; TS_LD(6, 55, 6) x[54] -= x[48] * ta[0]; x[54] -= x[49] * ta[1]; x[54] -= x[50] * ta[2]; x[54] -= x[51] * ta[3]; }
    { const f32x4 ta = tb7; TS_LD(7, 55, 7) x[54] -= x[52] * ta[0]; x[54] -= x[53] * ta[1]; }
    { const f32x4 ta = tb0; TS_LD(0, 55, 8) x[55] -= x[0] * ta[0]; x[55] -= x[1] * ta[1]; x[55] -= x[2] * ta[2]; x[55] -= x[3] * ta[3]; }
    { const f32x4 ta = tb1; TS_LD(1, 55, 9) x[55] -= x[4] * ta[0]; x[55] -= x[5] * ta[1]; x[55] -= x[6] * ta[2]; x[55] -= x[7] * ta[3]; }
    { const f32x4 ta = tb2; TS_LD(2, 55, 10) x[55] -= x[8] * ta[0]; x[55] -= x[9] * ta[1]; x[55] -= x[10] * ta[2]; x[55] -= x[11] * ta[3]; }
    { const f32x4 ta = tb3; TS_LD(3, 55, 11) x[55] -= x[12] * ta[0]; x[55] -= x[13] * ta[1]; x[55] -= x[14] * ta[2]; x[55] -= x[15] * ta[3]; }
    { const f32x4 ta = tb4; TS_LD(4, 55, 12) x[55] -= x[16] * ta[0]; x[55] -= x[17] * ta[1]; x[55] -= x[18] * ta[2]; x[55] -= x[19] * ta[3]; }
    { const f32x4 ta = tb5; TS_LD(5, 55, 13) x[55] -= x[20] * ta[0]; x[55] -= x[21] * ta[1]; x[55] -= x[22] * ta[2]; x[55] -= x[23] * ta[3]; }
    { const f32x4 ta = tb6; TS_LD(6, 56, 0) x[55] -= x[24] * ta[0]; x[55] -= x[25] * ta[1]; x[55] -= x[26] * ta[2]; x[55] -= x[27] * ta[3]; }
    { const f32x4 ta = tb7; TS_LD(7, 56, 1) x[55] -= x[28] * ta[0]; x[55] -= x[29] * ta[1]; x[55] -= x[30] * ta[2]; x[55] -= x[31] * ta[3]; }
    { const f32x4 ta = tb0; TS_LD(0, 56, 2) x[55] -= x[32] * ta[0]; x[55] -= x[33] * ta[1]; x[55] -= x[34] * ta[2]; x[55] -= x[35] * ta[3]; }
    { const f32x4 ta = tb1; TS_LD(1, 56, 3) x[55] -= x[36] * ta[0]; x[55] -= x[37] * ta[1]; x[55] -= x[38] * ta[2]; x[55] -= x[39] * ta[3]; }
    { const f32x4 ta = tb2; TS_LD(2, 56, 4) x[55] -= x[40] * ta[0]; x[55] -= x[41] * ta[1]; x[55] -= x[42] * ta[2]; x[55] -= x[43] * ta[3]; }
    { const f32x4 ta = tb3; TS_LD(3, 56, 5) x[55] -= x[44] * ta[0]; x[55] -= x[45] * ta[1]; x[55] -= x[46] * ta[2]; x[55] -= x[47] * ta[3]; }
    { const f32x4 ta = tb4; TS_LD(4, 56, 6) x[55] -= x[48] * ta[0]; x[55] -= x[49] * ta[1]; x[55] -= x[50] * ta[2]; x[55] -= x[51] * ta[3]; }
    { const f32x4 ta = tb5; TS_LD(5, 56, 7) x[55] -= x[52] * ta[0]; x[55] -= x[53] * ta[1]; x[55] -= x[54] * ta[2]; }
    { const f32x4 ta = tb6; TS_LD(6, 56, 8) x[56] -= x[0] * ta[0]; x[56] -= x[1] * ta[1]; x[56] -= x[2] * ta[2]; x[56] -= x[3] * ta[3]; }
    { const f32x4 ta = tb7; TS_LD(7, 56, 9) x[56] -= x[4] * ta[0]; x[56] -= x[5] * ta[1]; x[56] -= x[6] * ta[2]; x[56] -= x[7] * ta[3]; }
    { const f32x4 ta = tb0; TS_LD(0, 56, 10) x[56] -= x[8] * ta[0]; x[56] -= x[9] * ta[1]; x[56] -= x[10] * ta[2]; x[56] -= x[11] * ta[3]; }
    { const f32x4 ta = tb1; TS_LD(1, 56, 11) x[56] -= x[12] * ta[0]; x[56] -= x[13] * ta[1]; x[56] -= x[14] * ta[2]; x[56] -= x[15] * ta[3]; }
    { const f32x4 ta = tb2; TS_LD(2, 56, 12) x[56] -= x[16] * ta[0]; x[56] -= x[17] * ta[1]; x[56] -= x[18] * ta[2]; x[56] -= x[19] * ta[3]; }
    { const f32x4 ta = tb3; TS_LD(3, 56, 13) x[56] -= x[20] * ta[0]; x[56] -= x[21] * ta[1]; x[56] -= x[22] * ta[2]; x[56] -= x[23] * ta[3]; }
    { const f32x4 ta = tb4; TS_LD(4, 57, 0) x[56] -= x[24] * ta[0]; x[56] -= x[25] * ta[1]; x[56] -= x[26] * ta[2]; x[56] -= x[27] * ta[3]; }
    { const f32x4 ta = tb5; TS_LD(5, 57, 1) x[56] -= x[28] * ta[0]; x[56] -= x[29] * ta[1]; x[56] -= x[30] * ta[2]; x[56] -= x[31] * ta[3]; }
    { const f32x4 ta = tb6; TS_LD(6, 57, 2) x[56] -= x[32] * ta[0]; x[56] -= x[33] * ta[1]; x[56] -= x[34] * ta[2]; x[56] -= x[35] * ta[3]; }
    { const f32x4 ta = tb7; TS_LD(7, 57, 3) x[56] -= x[36] * ta[0]; x[56] -= x[37] * ta[1]; x[56] -= x[38] * ta[2]; x[56] -= x[39] * ta[3]; }
    { const f32x4 ta = tb0; TS_LD(0, 57, 4) x[56] -= x[40] * ta[0]; x[56] -= x[41] * ta[1]; x[56] -= x[42] * ta[2]; x[56] -= x[43] * ta[3]; }
    { const f32x4 ta = tb1; TS_LD(1, 57, 5) x[56] -= x[44] * ta[0]; x[56] -= x[45] * ta[1]; x[56] -= x[46] * ta[2]; x[56] -= x[47] * ta[3]; }
    { const f32x4 ta = tb2; TS_LD(2, 57, 6) x[56] -= x[48] * ta[0]; x[56] -= x[49] * ta[1]; x[56] -= x[50] * ta[2]; x[56] -= x[51] * ta[3]; }
    { const f32x4 ta = tb3; TS_LD(3, 57, 7) x[56] -= x[52] * ta[0]; x[56] -= x[53] * ta[1]; x[56] -= x[54] * ta[2]; x[56] -= x[55] * ta[3]; }
    { const f32x4 ta = tb4; TS_LD(4, 57, 8) x[57] -= x[0] * ta[0]; x[57] -= x[1] * ta[1]; x[57] -= x[2] * ta[2]; x[57] -= x[3] * ta[3]; }
    { const f32x4 ta = tb5; TS_LD(5, 57, 9) x[57] -= x[4] * ta[0]; x[57] -= x[5] * ta[1]; x[57] -= x[6] * ta[2]; x[57] -= x[7] * ta[3]; }
    { const f32x4 ta = tb6; TS_LD(6, 57, 10) x[57] -= x[8] * ta[0]; x[57] -= x[9] * ta[1]; x[57] -= x[10] * ta[2]; x[57] -= x[11] * ta[3]; }
    { const f32x4 ta = tb7; TS_LD(7, 57, 11) x[57] -= x[12] * ta[0]; x[57] -= x[13] * ta[1]; x[57] -= x[14] * ta[2]; x[57] -= x[15] * ta[3]; }
    { const f32x4 ta = tb0; TS_LD(0, 57, 12) x[57] -= x[16] * ta[0]; x[57] -= x[17] * ta[1]; x[57] -= x[18] * ta[2]; x[57] -= x[19] * ta[3]; }
    { const f32x4 ta = tb1; TS_LD(1, 57, 13) x[57] -= x[20] * ta[0]; x[57] -= x[21] * ta[1]; x[57] -= x[22] * ta[2]; x[57] -= x[23] * ta[3]; }
    { const f32x4 ta = tb2; TS_LD(2, 57, 14) x[57] -= x[24] * ta[0]; x[57] -= x[25] * ta[1]; x[57] -= x[26] * ta[2]; x[57] -= x[27] * ta[3]; }
    { const f32x4 ta = tb3; TS_LD(3, 58, 0) x[57] -= x[28] * ta[0]; x[57] -= x[29] * ta[1]; x[57] -= x[30] * ta[2]; x[57] -= x[31] * ta[3]; }
    { const f32x4 ta = tb4; TS_LD(4, 58, 1) x[57] -= x[32] * ta[0]; x[57] -= x[33] * ta[1]; x[57] -= x[34] * ta[2]; x[57] -= x[35] * ta[3]; }
    { const f32x4 ta = tb5; TS_LD(5, 58, 2) x[57] -= x[36] * ta[0]; x[57] -= x[37] * ta[1]; x[57] -= x[38] * ta[2]; x[57] -= x[39] * ta[3]; }
    { const f32x4 ta = tb6; TS_LD(6, 58, 3) x[57] -= x[40] * ta[0]; x[57] -= x[41] * ta[1]; x[57] -= x[42] * ta[2]; x[57] -= x[43] * ta[3]; }
    { const f32x4 ta = tb7; TS_LD(7, 58, 4) x[57] -= x[44] * ta[0]; x[57] -= x[45] * ta[1]; x[57] -= x[46] * ta[2]; x[57] -= x[47] * ta[3]; }
    { const f32x4 ta = tb0; TS_LD(0, 58, 5) x[57] -= x[48] * ta[0]; x[57] -= x[49] * ta[1]; x[57] -= x[50] * ta[2]; x[57] -= x[51] * ta[3]; }
    { const f32x4 ta = tb1; TS_LD(1, 58, 6) x[57] -= x[52] * ta[0]; x[57] -= x[53] * ta[1]; x[57] -= x[54] * ta[2]; x[57] -= x[55] * ta[3]; }
    { const f32x4 ta = tb2; TS_LD(2, 58, 7) x[57] -= x[56] * ta[0]; }
    { const f32x4 ta = tb3; TS_LD(3, 58, 8) x[58] -= x[0] * ta[0]; x[58] -= x[1] * ta[1]; x[58] -= x[2] * ta[2]; x[58] -= x[3] * ta[3]; }
    { const f32x4 ta = tb4; TS_LD(4, 58, 9) x[58] -= x[4] * ta[0]; x[58] -= x[5] * ta[1]; x[58] -= x[6] * ta[2]; x[58] -= x[7] * ta[3]; }
    { const f32x4 ta = tb5; TS_LD(5, 58, 10) x[58] -= x[8] * ta[0]; x[58] -= x[9] * ta[1]; x[58] -= x[10] * ta[2]; x[58] -= x[11] * ta[3]; }
    { const f32x4 ta = tb6; TS_LD(6, 58, 11) x[58] -= x[12] * ta[0]; x[58] -= x[13] * ta[1]; x[58] -= x[14] * ta[2]; x[58] -= x[15] * ta[3]; }
    { const f32x4 ta = tb7; TS_LD(7, 58, 12) x[58] -= x[16] * ta[0]; x[58] -= x[17] * ta[1]; x[58] -= x[18] * ta[2]; x[58] -= x[19] * ta[3]; }
    { const f32x4 ta = tb0; TS_LD(0, 58, 13) x[58] -= x[20] * ta[0]; x[58] -= x[21] * ta[1]; x[58] -= x[22] * ta[2]; x[58] -= x[23] * ta[3]; }
    { const f32x4 ta = tb1; TS_LD(1, 58, 14) x[58] -= x[24] * ta[0]; x[58] -= x[25] * ta[1]; x[58] -= x[26] * ta[2]; x[58] -= x[27] * ta[3]; }
    { const f32x4 ta = tb2; TS_LD(2, 59, 0) x[58] -= x[28] * ta[0]; x[58] -= x[29] * ta[1]; x[58] -= x[30] * ta[2]; x[58] -= x[31] * ta[3]; }
    { const f32x4 ta = tb3; TS_LD(3, 59, 1) x[58] -= x[32] * ta[0]; x[58] -= x[33] * ta[1]; x[58] -= x[34] * ta[2]; x[58] -= x[35] * ta[3]; }
    { const f32x4 ta = tb4; TS_LD(4, 59, 2) x[58] -= x[36] * ta[0]; x[58] -= x[37] * ta[1]; x[58] -= x[38] * ta[2]; x[58] -= x[39] * ta[3]; }
    { const f32x4 ta = tb5; TS_LD(5, 59, 3) x[58] -= x[40] * ta[0]; x[58] -= x[41] * ta[1]; x[58] -= x[42] * ta[2]; x[58] -= x[43] * ta[3]; }
    { const f32x4 ta = tb6; TS_LD(6, 59, 4) x[58] -= x[44] * ta[0]; x[58] -= x[45] * ta[1]; x[58] -= x[46] * ta[2]; x[58] -= x[47] * ta[3]; }
    { const f32x4 ta = tb7; TS_LD(7, 59, 5) x[58] -= x[48] * ta[0]; x[58] -= x[49] * ta[1]; x[58] -= x[50] * ta[2]; x[58] -= x[51] * ta[3]; }
    { const f32x4 ta = tb0; TS_LD(0, 59, 6) x[58] -= x[52] * ta[0]; x[58] -= x[53] * ta[1]; x[58] -= x[54] * ta[2]; x[58] -= x[55] * ta[3]; }
    { const f32x4 ta = tb1; TS_LD(1, 59, 7) x[58] -= x[56] * ta[0]; x[58] -= x[57] * ta[1]; }
    { const f32x4 ta = tb2; TS_LD(2, 59, 8) x[59] -= x[0] * ta[0]; x[59] -= x[1] * ta[1]; x[59] -= x[2] * ta[2]; x[59] -= x[3] * ta[3]; }
    { const f32x4 ta = tb3; TS_LD(3, 59, 9) x[59] -= x[4] * ta[0]; x[59] -= x[5] * ta[1]; x[59] -= x[6] * ta[2]; x[59] -= x[7] * ta[3]; }
    { const f32x4 ta = tb4; TS_LD(4, 59, 10) x[59] -= x[8] * ta[0]; x[59] -= x[9] * ta[1]; x[59] -= x[10] * ta[2]; x[59] -= x[11] * ta[3]; }
    { const f32x4 ta = tb5; TS_LD(5, 59, 11) x[59] -= x[12] * ta[0]; x[59] -= x[13] * ta[1]; x[59] -= x[14] * ta[2]; x[59] -= x[15] * ta[3]; }
    { const f32x4 ta = tb6; TS_LD(6, 59, 12) x[59] -= x[16] * ta[0]; x[59] -= x[17] * ta[1]; x[59] -= x[18] * ta[2]; x[59] -= x[19] * ta[3]; }
    { const f32x4 ta = tb7; TS_LD(7, 59, 13) x[59] -= x[20] * ta[0]; x[59] -= x[21] * ta[1]; x[59] -= x[22] * ta[2]; x[59] -= x[23] * ta[3]; }
    { const f32x4 ta = tb0; TS_LD(0, 59, 14) x[59] -= x[24] * ta[0]; x[59] -= x[25] * ta[1]; x[59] -= x[26] * ta[2]; x[59] -= x[27] * ta[3]; }
    { const f32x4 ta = tb1; TS_LD(1, 60, 0) x[59] -= x[28] * ta[0]; x[59] -= x[29] * ta[1]; x[59] -= x[30] * ta[2]; x[59] -= x[31] * ta[3]; }
    { const f32x4 ta = tb2; TS_LD(2, 60, 1) x[59] -= x[32] * ta[0]; x[59] -= x[33] * ta[1]; x[59] -= x[34] * ta[2]; x[59] -= x[35] * ta[3]; }
    { const f32x4 ta = tb3; TS_LD(3, 60, 2) x[59] -= x[36] * ta[0]; x[59] -= x[37] * ta[1]; x[59] -= x[38] * ta[2]; x[59] -= x[39] * ta[3]; }
    { const f32x4 ta = tb4; TS_LD(4, 60, 3) x[59] -= x[40] * ta[0]; x[59] -= x[41] * ta[1]; x[59] -= x[42] * ta[2]; x[59] -= x[43] * ta[3]; }
    { const f32x4 ta = tb5; TS_LD(5, 60, 4) x[59] -= x[44] * ta[0]; x[59] -= x[45] * ta[1]; x[59] -= x[46] * ta[2]; x[59] -= x[47] * ta[3]; }
    { const f32x4 ta = tb6; TS_LD(6, 60, 5) x[59] -= x[48] * ta[0]; x[59] -= x[49] * ta[1]; x[59] -= x[50] * ta[2]; x[59] -= x[51] * ta[3]; }
    { const f32x4 ta = tb7; TS_LD(7, 60, 6) x[59] -= x[52] * ta[0]; x[59] -= x[53] * ta[1]; x[59] -= x[54] * ta[2]; x[59] -= x[55] * ta[3]; }
    { const f32x4 ta = tb0; TS_LD(0, 60, 7) x[59] -= x[56] * ta[0]; x[59] -= x[57] * ta[1]; x[59] -= x[58] * ta[2]; }
    { const f32x4 ta = tb1; TS_LD(1, 60, 8) x[60] -= x[0] * ta[0]; x[60] -= x[1] * ta[1]; x[60] -= x[2] * ta[2]; x[60] -= x[3] * ta[3]; }
    { const f32x4 ta = tb2; TS_LD(2, 60, 9) x[60] -= x[4] * ta[0]; x[60] -= x[5] * ta[1]; x[60] -= x[6] * ta[2]; x[60] -= x[7] * ta[3]; }
    { const f32x4 ta = tb3; TS_LD(3, 60, 10) x[60] -= x[8] * ta[0]; x[60] -= x[9] * ta[1]; x[60] -= x[10] * ta[2]; x[60] -= x[11] * ta[3]; }
    { const f32x4 ta = tb4; TS_LD(4, 60, 11) x[60] -= x[12] * ta[0]; x[60] -= x[13] * ta[1]; x[60] -= x[14] * ta[2]; x[60] -= x[15] * ta[3]; }
    { const f32x4 ta = tb5; TS_LD(5, 60, 12) x[60] -= x[16] * ta[0]; x[60] -= x[17] * ta[1]; x[60] -= x[18] * ta[2]; x[60] -= x[19] * ta[3]; }
    { const f32x4 ta = tb6; TS_LD(6, 60, 13) x[60] -= x[20] * ta[0]; x[60] -= x[21] * ta[1]; x[60] -= x[22] * ta[2]; x[60] -= x[23] * ta[3]; }
    { const f32x4 ta = tb7; TS_LD(7, 60, 14) x[60] -= x[24] * ta[0]; x[60] -= x[25] * ta[1]; x[60] -= x[26] * ta[2]; x[60] -= x[27] * ta[3]; }
    { const f32x4 ta = tb0; TS_LD(0, 61, 0) x[60] -= x[28] * ta[0]; x[60] -= x[29] * ta[1]; x[60] -= x[30] * ta[2]; x[60] -= x[31] * ta[3]; }
    { const f32x4 ta = tb1; TS_LD(1, 61, 1) x[60] -= x[32] * ta[0]; x[60] -= x[33] * ta[1]; x[60] -= x[34] * ta[2]; x[60] -= x[35] * ta[3]; }
    { const f32x4 ta = tb2; TS_LD(2, 61, 2) x[60] -= x[36] * ta[0]; x[60] -= x[37] * ta[1]; x[60] -= x[38] * ta[2]; x[60] -= x[39] * ta[3]; }
    { const f32x4 ta = tb3; TS_LD(3, 61, 3) x[60] -= x[40] * ta[0]; x[60] -= x[41] * ta[1]; x[60] -= x[42] * ta[2]; x[60] -= x[43] * ta[3]; }
    { const f32x4 ta = tb4; TS_LD(4, 61, 4) x[60] -= x[44] * ta[0]; x[60] -= x[45] * ta[1]; x[60] -= x[46] * ta[2]; x[60] -= x[47] * ta[3]; }
    { const f32x4 ta = tb5; TS_LD(5, 61, 5) x[60] -= x[48] * ta[0]; x[60] -= x[49] * ta[1]; x[60] -= x[50] * ta[2]; x[60] -= x[51] * ta[3]; }
    { const f32x4 ta = tb6; TS_LD(6, 61, 6) x[60] -= x[52] * ta[0]; x[60] -= x[53] * ta[1]; x[60] -= x[54] * ta[2]; x[60] -= x[55] * ta[3]; }
    { const f32x4 ta = tb7; TS_LD(7, 61, 7) x[60] -= x[56] * ta[0]; x[60] -= x[57] * ta[1]; x[60] -= x[58] * ta[2]; x[60] -= x[59] * ta[3]; }
    { const f32x4 ta = tb0; TS_LD(0, 61, 8) x[61] -= x[0] * ta[0]; x[61] -= x[1] * ta[1]; x[61] -= x[2] * ta[2]; x[61] -= x[3] * ta[3]; }
    { const f32x4 ta = tb1; TS_LD(1, 61, 9) x[61] -= x[4] * ta[0]; x[61] -= x[5] * ta[1]; x[61] -= x[6] * ta[2]; x[61] -= x[7] * ta[3]; }
    { const f32x4 ta = tb2; TS_LD(2, 61, 10) x[61] -= x[8] * ta[0]; x[61] -= x[9] * ta[1]; x[61] -= x[10] * ta[2]; x[61] -= x[11] * ta[3]; }
    { const f32x4 ta = tb3; TS_LD(3, 61, 11) x[61] -= x[12] * ta[0]; x[61] -= x[13] * ta[1]; x[61] -= x[14] * ta[2]; x[61] -= x[15] * ta[3]; }
    { const f32x4 ta = tb4; TS_LD(4, 61, 12) x[61] -= x[16] * ta[0]; x[61] -= x[17] * ta[1]; x[61] -= x[18] * ta[2]; x[61] -= x[19] * ta[3]; }
    { const f32x4 ta = tb5; TS_LD(5, 61, 13) x[61] -= x[20] * ta[0]; x[61] -= x[21] * ta[1]; x[61] -= x[22] * ta[2]; x[61] -= x[23] * ta[3]; }
    { const f32x4 ta = tb6; TS_LD(6, 61, 14) x[61] -= x[24] * ta[0]; x[61] -= x[25] * ta[1]; x[61] -= x[26] * ta[2]; x[61] -= x[27] * ta[3]; }
    { const f32x4 ta = tb7; TS_LD(7, 61, 15) x[61] -= x[28] * ta[0]; x[61] -= x[29] * ta[1]; x[61] -= x[30] * ta[2]; x[61] -= x[31] * ta[3]; }
    { const f32x4 ta = tb0; TS_LD(0, 62, 0) x[61] -= x[32] * ta[0]; x[61] -= x[33] * ta[1]; x[61] -= x[34] * ta[2]; x[61] -= x[35] * ta[3]; }
    { const f32x4 ta = tb1; TS_LD(1, 62, 1) x[61] -= x[36] * ta[0]; x[61] -= x[37] * ta[1]; x[61] -= x[38] * ta[2]; x[61] -= x[39] * ta[3]; }
    { const f32x4 ta = tb2; TS_LD(2, 62, 2) x[61] -= x[40] * ta[0]; x[61] -= x[41] * ta[1]; x[61] -= x[42] * ta[2]; x[61] -= x[43] * ta[3]; }
    { const f32x4 ta = tb3; TS_LD(3, 62, 3) x[61] -= x[44] * ta[0]; x[61] -= x[45] * ta[1]; x[61] -= x[46] * ta[2]; x[61] -= x[47] * ta[3]; }
    { const f32x4 ta = tb4; TS_LD(4, 62, 4) x[61] -= x[48] * ta[0]; x[61] -= x[49] * ta[1]; x[61] -= x[50] * ta[2]; x[61] -= x[51] * ta[3]; }
    { const f32x4 ta = tb5; TS_LD(5, 62, 5) x[61] -= x[52] * ta[0]; x[61] -= x[53] * ta[1]; x[61] -= x[54] * ta[2]; x[61] -= x[55] * ta[3]; }
    { const f32x4 ta = tb6; TS_LD(6, 62, 6) x[61] -= x[56] * ta[0]; x[61] -= x[57] * ta[1]; x[61] -= x[58] * ta[2]; x[61] -= x[59] * ta[3]; }
    { const f32x4 ta = tb7; TS_LD(7, 62, 7) x[61] -= x[60] * ta[0]; }
    { const f32x4 ta = tb0; TS_LD(0, 62, 8) x[62] -= x[0] * ta[0]; x[62] -= x[1] * ta[1]; x[62] -= x[2] * ta[2]; x[62] -= x[3] * ta[3]; }
    { const f32x4 ta = tb1; TS_LD(1, 62, 9) x[62] -= x[4] * ta[0]; x[62] -= x[5] * ta[1]; x[62] -= x[6] * ta[2]; x[62] -= x[7] * ta[3]; }
    { const f32x4 ta = tb2; TS_LD(2, 62, 10) x[62] -= x[8] * ta[0]; x[62] -= x[9] * ta[1]; x[62] -= x[10] * ta[2]; x[62] -= x[11] * ta[3]; }
    { const f32x4 ta = tb3; TS_LD(3, 62, 11) x[62] -= x[12] * ta[0]; x[62] -= x[13] * ta[1]; x[62] -= x[14] * ta[2]; x[62] -= x[15] * ta[3]; }
    { const f32x4 ta = tb4; TS_LD(4, 62, 12) x[62] -= x[16] * ta[0]; x[62] -= x[17] * ta[1]; x[62] -= x[18] * ta[2]; x[62] -= x[19] * ta[3]; }
    { const f32x4 ta = tb5; TS_LD(5, 62, 13) x[62] -= x[20] * ta[0]; x[62] -= x[21] * ta[1]; x[62] -= x[22] * ta[2]; x[62] -= x[23] * ta[3]; }
    { const f32x4 ta = tb6; TS_LD(6, 62, 14) x[62] -= x[24] * ta[0]; x[62] -= x[25] * ta[1]; x[62] -= x[26] * ta[2]; x[62] -= x[27] * ta[3]; }
    { const f32x4 ta = tb7; TS_LD(7, 62, 15) x[62] -= x[28] * ta[0]; x[62] -= x[29] * ta[1]; x[62] -= x[30] * ta[2]; x[62] -= x[31] * ta[3]; }
    { const f32x4 ta = tb0; TS_LD(0, 63, 0) x[62] -= x[32] * ta[0]; x[62] -= x[33] * ta[1]; x[62] -= x[34] * ta[2]; x[62] -= x[35] * ta[3]; }
    { const f32x4 ta = tb1; TS_LD(1, 63, 1) x[62] -= x[36] * ta[0]; x[62] -= x[37] * ta[1]; x[62] -= x[38] * ta[2]; x[62] -= x[39] * ta[3]; }
    { const f32x4 ta = tb2; TS_LD(2, 63, 2) x[62] -= x[40] * ta[0]; x[62] -= x[41] * ta[1]; x[62] -= x[42] * ta[2]; x[62] -= x[43] * ta[3]; }
    { const f32x4 ta = tb3; TS_LD(3, 63, 3) x[62] -= x[44] * ta[0]; x[62] -= x[45] * ta[1]; x[62] -= x[46] * ta[2]; x[62] -= x[47] * ta[3]; }
    { const f32x4 ta = tb4; TS_LD(4, 63, 4) x[62] -= x[48] * ta[0]; x[62] -= x[49] * ta[1]; x[62] -= x[50] * ta[2]; x[62] -= x[51] * ta[3]; }
    { const f32x4 ta = tb5; TS_LD(5, 63, 5) x[62] -= x[52] * ta[0]; x[62] -= x[53] * ta[1]; x[62] -= x[54] * ta[2]; x[62] -= x[55] * ta[3]; }
    { const f32x4 ta = tb6; TS_LD(6, 63, 6) x[62] -= x[56] * ta[0]; x[62] -= x[57] * ta[1]; x[62] -= x[58] * ta[2]; x[62] -= x[59] * ta[3]; }
    { const f32x4 ta = tb7; TS_LD(7, 63, 7) x[62] -= x[60] * ta[0]; x[62] -= x[61] * ta[1]; }
    { const f32x4 ta = tb0; TS_LD(0, 63, 8) x[63] -= x[0] * ta[0]; x[63] -= x[1] * ta[1]; x[63] -= x[2] * ta[2]; x[63] -= x[3] * ta[3]; }
    { const f32x4 ta = tb1; TS_LD(1, 63, 9) x[63] -= x[4] * ta[0]; x[63] -= x[5] * ta[1]; x[63] -= x[6] * ta[2]; x[63] -= x[7] * ta[3]; }
    { const f32x4 ta = tb2; TS_LD(2, 63, 10) x[63] -= x[8] * ta[0]; x[63] -= x[9] * ta[1]; x[63] -= x[10] * ta[2]; x[63] -= x[11] * ta[3]; }
    { const f32x4 ta = tb3; TS_LD(3, 63, 11) x[63] -= x[12] * ta[0]; x[63] -= x[13] * ta[1]; x[63] -= x[14] * ta[2]; x[63] -= x[15] * ta[3]; }
    { const f32x4 ta = tb4; TS_LD(4, 63, 12) x[63] -= x[16] * ta[0]; x[63] -= x[17] * ta[1]; x[63] -= x[18] * ta[2]; x[63] -= x[19] * ta[3]; }
    { const f32x4 ta = tb5; TS_LD(5, 63, 13) x[63] -= x[20] * ta[0]; x[63] -= x[21] * ta[1]; x[63] -= x[22] * ta[2]; x[63] -= x[23] * ta[3]; }
    { const f32x4 ta = tb6; TS_LD(6, 63, 14) x[63] -= x[24] * ta[0]; x[63] -= x[25] * ta[1]; x[63] -= x[26] * ta[2]; x[63] -= x[27] * ta[3]; }
    { const f32x4 ta = tb7; TS_LD(7, 63, 15) x[63] -= x[28] * ta[0]; x[63] -= x[29] * ta[1]; x[63] -= x[30] * ta[2]; x[63] -= x[31] * ta[3]; }
    { const f32x4 ta = tb0; x[63] -= x[32] * ta[0]; x[63] -= x[33] * ta[1]; x[63] -= x[34] * ta[2]; x[63] -= x[35] * ta[3]; }
    { const f32x4 ta = tb1; x[63] -= x[36] * ta[0]; x[63] -= x[37] * ta[1]; x[63] -= x[38] * ta[2]; x[63] -= x[39] * ta[3]; }
    { const f32x4 ta = tb2; x[63] -= x[40] * ta[0]; x[63] -= x[41] * ta[1]; x[63] -= x[42] * ta[2]; x[63] -= x[43] * ta[3]; }
    { const f32x4 ta = tb3; x[63] -= x[44] * ta[0]; x[63] -= x[45] * ta[1]; x[63] -= x[46] * ta[2]; x[63] -= x[47] * ta[3]; }
    { const f32x4 ta = tb4; x[63] -= x[48] * ta[0]; x[63] -= x[49] * ta[1]; x[63] -= x[50] * ta[2]; x[63] -= x[51] * ta[3]; }
    { const f32x4 ta = tb5; x[63] -= x[52] * ta[0]; x[63] -= x[53] * ta[1]; x[63] -= x[54] * ta[2]; x[63] -= x[55] * ta[3]; }
    { const f32x4 ta = tb6; x[63] -= x[56] * ta[0]; x[63] -= x[57] * ta[1]; x[63] -= x[58] * ta[2]; x[63] -= x[59] * ta[3]; }
    { const f32x4 ta = tb7; x[63] -= x[60] * ta[0]; x[63] -= x[61] * ta[1]; x[63] -= x[62] * ta[2]; }
}
#undef TS_LD
#undef TS_F

DI void prep_item(const Ctx& C, LAS unsigned char* pl, int item, int half) {
    int lane_ = C.lane; asm volatile("" : "+v"(lane_));
    const int lane = lane_, h = item & 7, c = (item >> 3) & 127, b = item >> 10, R0 = b * SEQ + c * 64;
    LAS float* AM = (LAS float*)pl; LAS unsigned char* KIMG = pl + 16384;
    LAS float* Gs = (LAS float*)(pl + 16384 + 17408 + half * 1024); LAS float* Bs = Gs + 64; LAS float* Es = Gs + 128; LAS float* Cs = Gs + 192;
    const bf16* PROJ = WSP(bf16, WS_PROJ); const float* AB = WSP(float, WS_AB);
    unsigned char* blk = C.ws + WS_DEL + (size_t)item * DEL_ITEM;
    float Glast;
    { const float a = AB[(size_t)(R0 + lane) * 16 + h], bb = AB[(size_t)(R0 + lane) * 16 + 8 + h];
      const float g = -__expf(C.a_log[h]) * softplus_f(a + C.a_dtb[h]), beta = sigmoid_f(bb);
      float G = g;
#pragma unroll
      for (int o = 1; o < 64; o <<= 1) { const float t = shfrom(G, (lane - o) & 63); if (lane >= o) G += t; }
      Glast = shfrom(G, 63 + (lane & 0));
      Gs[lane] = G; Bs[lane] = beta; Es[lane] = __expf(Glast - G); Cs[lane] = beta * __expf(G);
      if (half == 1 && lane == 0) WSP(float, WS_GLB)[item] = __expf(Glast);
      LDS_WAIT(); }
    const int il = lane & 15, g4 = lane >> 4;
    if (half == 1) {
        const int rg = lane >> 4, ch = lane & 15, t0 = c * 64 + 16 * rg;
        LAS unsigned char* QIMG = pl;
#pragma unroll
        for (int part = 1; part >= 0; --part) {
            const int col = part * 1024 + h * 128 + 8 * ch;
            float cw[4][8];
#pragma unroll
            for (int w = 0; w < 4; ++w) { const f32x4 w0 = *(const GAS f32x4*)(C.a_conv + w * CONVD + col), w1 = *(const GAS f32x4*)(C.a_conv + w * CONVD + col + 4);
#pragma unroll
                for (int e = 0; e < 4; ++e) { cw[w][e] = w0[e]; cw[w][4 + e] = w1[e]; } }
            v4u xr[19];
#pragma unroll
            for (int r = 0; r < 19; ++r) { const int tr = t0 - 3 + r; const v4u ld = *(const GAS v4u*)(PROJ + (size_t)(b * SEQ + (tr < 0 ? 0 : tr)) * NPROJ + col); xr[r] = tr < 0 ? (v4u){0u, 0u, 0u, 0u} : ld; }
#pragma unroll
            for (int rr = 0; rr < 16; ++rr) { float y[8]; float ss = 0.f;
#pragma unroll
                for (int e = 0; e < 8; ++e) { float a_ = 0.f;
#pragma unroll
                    for (int w = 0; w < 4; ++w) { const unsigned u = (e < 2) ? xr[rr + w].x : (e < 4) ? xr[rr + w].y : (e < 6) ? xr[rr + w].z : xr[rr + w].w; a_ += cw[w][e] * ((e & 1) ? bfhi(u) : bflo(u)); }
                    y[e] = silu_f(a_); ss += y[e] * y[e]; }
                ss = rowsum16(ss);
                const float inv = rsqrtf(ss + 1e-6f) * (part == 0 ? 0.08838834764831845f : 1.f);
                const int i = 16 * rg + rr;
#pragma unroll
                for (int e = 0; e < 8; ++e) y[e] *= inv;
                const bf16x8 fr = pack8(y);
                if (part == 1) *(LAS bf16x8*)(KIMG + i * 272 + 16 * ch) = fr;
                else { *(LAS bf16x8*)(QIMG + i * 256 + 16 * ch) = fr;
                    const float eG = __expf(Gs[i]);
                    bf16* qp = (bf16*)(blk + DEL_QP) + (size_t)(((i >> 4) * 4 + (ch >> 2)) * 64) * 8;
#pragma unroll
                    for (int eh = 0; eh < 2; ++eh) { v2u o; o.x = pk2(y[4 * eh] * eG, y[4 * eh + 1] * eG); o.y = pk2(y[4 * eh + 2] * eG, y[4 * eh + 3] * eG);
                        *(GAS v2u*)(qp + (16 * (2 * (ch & 1) + eh) + (i & 15)) * 8 + 4 * ((ch >> 1) & 1)) = o; } }
            }
        }
        LDS_WAIT();
#pragma unroll 1
        for (int ni = 0; ni < 4; ++ni) {
            bf16x8 qf[4];
#pragma unroll
            for (int ks = 0; ks < 4; ++ks) qf[ks] = *(const LAS bf16x8*)(QIMG + (16 * ni + il) * 256 + (32 * ks + 8 * g4) * 2);
            const int i = 16 * ni + il; const float Gi = Gs[i];
#pragma unroll
            for (int mj = 0; mj < 4; ++mj) {
                const bool need_qk = (ni >= mj) || (ni == 0 && mj == 1) || (ni == 2 && mj == 3);
                if (need_qk) {
                    f32x4 acc = {0.f, 0.f, 0.f, 0.f};
                    if (ni >= mj) {
#pragma unroll
                        for (int ks = 0; ks < 4; ++ks) acc = mfma16(*(const LAS bf16x8*)(KIMG + (16 * mj + il) * 272 + (32 * ks + 8 * g4) * 2), qf[ks], acc);
                    }
                    float v[4];
#pragma unroll
                    for (int r = 0; r < 4; ++r) { const int j = 16 * mj + 4 * g4 + r; v[r] = (i >= j) ? acc[r] * __expf(Gi - Gs[j]) : 0.f; }
                    v2u o; o.x = pk2(v[0], v[1]); o.y = pk2(v[2], v[3]);
                    *(GAS v2u*)((bf16*)(blk + DEL_QKP) + (size_t)(((ni * 2 + (mj >> 1)) * 64 + lane) * 8 + 4 * (mj & 1))) = o;
                }
            }
        }
        LDS_WAIT(); asm volatile("" ::: "memory");
#pragma unroll 1
        for (int mi = 0; mi < 4; ++mi) {
            bf16x8 ka[4];
#pragma unroll
            for (int ks = 0; ks < 4; ++ks) ka[ks] = *(const LAS bf16x8*)(KIMG + (16 * mi + il) * 272 + (32 * ks + 8 * g4) * 2);
            float Gr[4], Br[4];
#pragma unroll
            for (int r = 0; r < 4; ++r) { Gr[r] = Gs[16 * mi + 4 * g4 + r]; Br[r] = Bs[16 * mi + 4 * g4 + r]; }
#pragma unroll 1
            for (int nj = 0; nj <= mi; ++nj) {
                f32x4 acc = {0.f, 0.f, 0.f, 0.f};
#pragma unroll
                for (int ks = 0; ks < 4; ++ks) acc = mfma16(ka[ks], *(const LAS bf16x8*)(KIMG + (16 * nj + il) * 272 + (32 * ks + 8 * g4) * 2), acc);
                const float Gc = Gs[16 * nj + il];
#pragma unroll
                for (int r = 0; r < 4; ++r) { const int i2 = 16 * mi + 4 * g4 + r, j = 16 * nj + il;
                    AM[i2 * 64 + j] = (i2 > j) ? Br[r] * acc[r] * __expf(Gr[r] - Gc) : 0.f; }
            }
        }
    }
}
DI void prep_item2(const Ctx& C, LAS unsigned char* pl, int item, int half) {
    int lane_ = C.lane; asm volatile("" : "+v"(lane_));
    const int lane = lane_, h = item & 7, c = (item >> 3) & 127, b = item >> 10, R0 = b * SEQ + c * 64;
    const LAS float* AM = (const LAS float*)pl; const LAS unsigned char* KIMG = pl + 16384;
    const LAS float* Gs = (const LAS float*)(pl + 16384 + 17408 + half * 1024); const LAS float* Bs = Gs + 64; const LAS float* Es = Gs + 128; const LAS float* Cs = Gs + 192;
    unsigned char* blk = C.ws + WS_DEL + (size_t)item * DEL_ITEM;
    const int il = lane & 15, g4 = lane >> 4;
    f32x2 x[64];
    if (half == 1) {
#pragma unroll
        for (int f = 0; f < 16; ++f) { const int dt = f >> 1, ks = f & 1, d = 16 * dt + il; float v[8];
#pragma unroll
            for (int e = 0; e < 8; ++e) { const int j = 32 * ks + 16 * (e >> 2) + 4 * g4 + (e & 3); v[e] = bf2f(*(const LAS unsigned short*)(KIMG + j * 272 + d * 2)) * Es[j]; }
            *(GAS bf16x8*)((bf16*)(blk + DEL_KTP) + (size_t)(f * 64 + lane) * 8) = pack8(v); }
#pragma unroll
        for (int j = 0; j < 64; ++j) { const unsigned u = *(const LAS unsigned*)(KIMG + j * 272 + lane * 4); const float cj = Cs[j]; x[j] = (f32x2){bflo(u) * cj, bfhi(u) * cj}; if ((j & 15) == 15) asm volatile("" ::: "memory"); }
    } else {
        const bf16* PROJ = WSP(bf16, WS_PROJ); const int col = 2048 + h * 128 + 2 * lane, t0 = c * 64;
        f32x2 cw[4];
#pragma unroll
        for (int w = 0; w < 4; ++w) cw[w] = *(const GAS f32x2*)(C.a_conv + w * CONVD + col);
        unsigned xr[67];
#pragma unroll
        for (int r = 0; r < 67; ++r) { const int tr = t0 - 3 + r; const unsigned ld = *(const GAS unsigned*)(PROJ + (size_t)(b * SEQ + (tr < 0 ? 0 : tr)) * NPROJ + col); xr[r] = tr < 0 ? 0u : ld; }
#pragma unroll
        for (int j = 0; j < 64; ++j) { float a0 = 0.f, a1 = 0.f;
#pragma unroll
            for (int w = 0; w < 4; ++w) { a0 += cw[w][0] * bflo(xr[j + w]); a1 += cw[w][1] * bfhi(xr[j + w]); }
            const float bj = Bs[j]; x[j] = (f32x2){silu_f(a0) * bj, silu_f(a1) * bj}; }
    }
    tri_solve<64>(x, AM);
    if (half == 1) {
        const int d = 2 * lane, ks = d >> 5, ap = d & 31, p = 8 * ((ap >> 2) & 3) + 4 * (ap >> 4) + (ap & 3);
        bf16* wp = (bf16*)blk;
#pragma unroll
        for (int i = 0; i < 64; ++i) *(GAS unsigned*)(wp + (size_t)((((i >> 4) * 4 + ks) * 64 + 16 * (p >> 3) + (i & 15)) * 8 + (p & 7))) = pk2(x[i][0], x[i][1]);
    } else {
        bf16* up = (bf16*)(blk + DEL_U);
#pragma unroll
        for (int cc = 0; cc < 2; ++cc) { const int dv = 2 * lane + cc, dvs = dv >> 4;
#pragma unroll
            for (int mt = 0; mt < 4; ++mt)
#pragma unroll
                for (int q4 = 0; q4 < 4; ++q4) { const int i0 = 16 * mt + 4 * q4; v2u o; o.x = pk2(x[i0][cc], x[i0 + 1][cc]); o.y = pk2(x[i0 + 2][cc], x[i0 + 3][cc]);
                    *(GAS v2u*)(up + (size_t)((dvs * 64 + 16 * q4 + (dv & 15)) * 16 + 4 * mt)) = o; } }
    }
}
#if defined(PROBE_DLY)
#define P2_T(n) do { if ((n) == PROBE_DLY && (int)blockIdx.x == PROBE_BLK) p2_t0_ = __builtin_amdgcn_s_memrealtime(); } while (0)
#define P2_TE(n) do { if ((n) == PROBE_DLY && (int)blockIdx.x == PROBE_BLK) *dacc += __builtin_amdgcn_s_memrealtime() - p2_t0_; } while (0)
#else
#define P2_T(n) do { } while (0)
#define P2_TE(n) do { } while (0)
#endif
DI void prep_phase(const Ctx& C, unsigned long long* dacc) {
    unsigned long long p2_t0_ = 0ull; (void)p2_t0_; (void)dacc;
    const int pair = C.wave & 3, half = C.wave >> 2; LAS unsigned char* pl = C.lds + pair * PAIR_BYTES;
    for (int base = C.vcu * 4; base < NITEM; base += C.G * 4) { const int item = base + pair;
        P2_T(21); prep_item(C, pl, item, half); P2_TE(21);
        P2_T(23); LDS_BARRIER(); P2_TE(23);
        P2_T(22); prep_item2(C, pl, item, half); P2_TE(22);
        P2_T(23); LDS_BARRIER(); P2_TE(23);
    }
}

constexpr int NSL = 1, NSCAN = 128 / NSL;
constexpr int SX_SB = 0, SX_VN = 2 * NSL * 4096;
#if defined(PROBE_DLY)
#define SCAN_T(n) do { if ((n) == PROBE_DLY && (int)blockIdx.x == PROBE_BLK && C.wave == 0) scan_t0_ = __builtin_amdgcn_s_memrealtime(); } while (0)
#define SCAN_TE(n) do { if ((n) == PROBE_DLY && (int)blockIdx.x == PROBE_BLK && C.wave == 0) *dly_acc += __builtin_amdgcn_s_memrealtime() - scan_t0_; } while (0)
#else
#define SCAN_T(n) do { } while (0)
#define SCAN_TE(n) do { } while (0)
#endif
DI void scan_phase(const Ctx& C, int bx, unsigned long long* dly_acc) {
    unsigned long long scan_t0_ = 0ull; (void)scan_t0_; (void)dly_acc;
    const int lane = C.lane, il = lane & 15, g4 = lane >> 4;
    static_assert(NSL == 1, "stream mapping below is written for one slice per workgroup");
    const int xcd = bx & 7, kk = bx >> 3, bh = xcd * 2 + (kk >> 3), dvs0 = kk & 7, b = bh >> 3, h = bh & 7;
    const unsigned char* blk0 = C.ws + WS_DEL + (size_t)((b * 128) * 8 + h) * DEL_ITEM + lane * 16;
    LAS unsigned char* X = C.lds;
    for (int i = C.tid; i < 2 * NSL * 256; i += NTHR) *(LAS v4u*)(X + SX_SB + i * 16) = (v4u){0u, 0u, 0u, 0u};
    LDS_BARRIER();
#define ITEM(c) (blk0 + (size_t)((c) < 128 ? (c) : 127) * 8 * DEL_ITEM)
    if (C.wave < 4) {
        const int w = C.wave;
        struct Set { bf16x8 wp[4], kt[4]; v2u u[NSL]; };
        Set S0, S1, S2, S3;
        auto issue = [&](int c, Set& s) { const unsigned char* p = ITEM(c);
#pragma unroll
            for (int ks = 0; ks < 4; ++ks) s.wp[ks] = *(const GAS bf16x8*)(p + (w * 4 + ks) * 1024);
#pragma unroll
            for (int f = 0; f < 4; ++f) s.kt[f] = *(const GAS bf16x8*)(p + DEL_KTP + (w * 4 + f) * 1024);
#pragma unroll
            for (int sl = 0; sl < NSL; ++sl) s.u[sl] = *(const GAS v2u*)(p - lane * 16 + DEL_U + (dvs0 + sl) * 2048 + lane * 32 + 8 * w); };
        const float* GLB = WSP(float, WS_GLB);
        const float gl_lo = GLB[(b * 128 + lane) * 8 + h], gl_hi = GLB[(b * 128 + 64 + lane) * 8 + h];
        f32x4 sd0[NSL], sd1[NSL];
#pragma unroll
        for (int sl = 0; sl < NSL; ++sl) { sd0[sl] = (f32x4){0.f, 0.f, 0.f, 0.f}; sd1[sl] = sd0[sl]; }
        issue(0, S0); issue(1, S1); issue(2, S2); issue(3, S3);
        auto step = [&](int c, Set& s) {
            const float gl = __shfl(c < 64 ? gl_lo : gl_hi, c & 63);
#pragma unroll
            for (int sl = 0; sl < NSL; ++sl) {
                const LAS unsigned char* sb = X + SX_SB + ((c & 1) * NSL + sl) * 4096 + lane * 16;
                f32x4 acc = {0.f, 0.f, 0.f, 0.f};
#pragma unroll
                for (int ks = 0; ks < 4; ++ks) acc = mfma16(s.wp[ks], *(const LAS bf16x8*)(sb + ks * 1024), acc);
                const f32x4 vn = {bflo(s.u[sl].x) - acc[0], bfhi(s.u[sl].x) - acc[1], bflo(s.u[sl].y) - acc[2], bfhi(s.u[sl].y) - acc[3]};
                v2u o; o.x = pk2(vn[0], vn[1]); o.y = pk2(vn[2], vn[3]); *(LAS v2u*)(X + SX_VN + ((c & 1) * NSL + sl) * 2048 + w * 512 + lane * 8) = o; }
            SCAN_TE(14); SCAN_T(11); LDS_BARRIER(); SCAN_TE(11); SCAN_T(13);
#pragma unroll
            for (int sl = 0; sl < NSL; ++sl) {
                const LAS unsigned char* vp = X + SX_VN + ((c & 1) * NSL + sl) * 2048 + lane * 8;
                const v2u t0 = *(const LAS v2u*)(vp), t1 = *(const LAS v2u*)(vp + 512), t2 = *(const LAS v2u*)(vp + 1024), t3 = *(const LAS v2u*)(vp + 1536);
                const bf16x8 vb0 = __builtin_bit_cast(bf16x8, (v4u){t0.x, t0.y, t1.x, t1.y}), vb1 = __builtin_bit_cast(bf16x8, (v4u){t2.x, t2.y, t3.x, t3.y});
                f32x4 a0 = sd0[sl] * gl, a1 = sd1[sl] * gl;
                a0 = mfma16(s.kt[0], vb0, a0); a1 = mfma16(s.kt[2], vb0, a1); a0 = mfma16(s.kt[1], vb1, a0); a1 = mfma16(s.kt[3], vb1, a1);
                sd0[sl] = a0; sd1[sl] = a1;
                *(LAS bf16x8*)(X + SX_SB + (((c + 1) & 1) * NSL + sl) * 4096 + w * 1024 + lane * 16) = pack44(a0, a1); }
            issue(c + 4, s);
            SCAN_TE(13); SCAN_T(12); LDS_BARRIER(); SCAN_TE(12); SCAN_T(14);
        };
#pragma unroll 1
        for (int c = 0; c < 128; c += 16) {
            step(c + 0, S0); step(c + 1, S1); step(c + 2, S2); step(c + 3, S3); step(c + 4, S0); step(c + 5, S1); step(c + 6, S2); step(c + 7, S3);
            step(c + 8, S0); step(c + 9, S1); step(c + 10, S2); step(c + 11, S3); step(c + 12, S0); step(c + 13, S1); step(c + 14, S2); step(c + 15, S3);
        }
#pragma unroll
        for (int sl = 0; sl < NSL; ++sl) { float* pd = C.out + O_PDELTA + (size_t)((b * 8 + h) * 128) * 128 + 16 * (dvs0 + sl) + il;
#pragma unroll
            for (int r = 0; r < 4; ++r) { pd[(size_t)(32 * w + 4 * g4 + r) * 128] = sd0[sl][r]; pd[(size_t)(32 * w + 16 + 4 * g4 + r) * 128] = sd1[sl][r]; } }
    } else {
        const int w = C.wave - 4;
        struct SetO { bf16x8 qp[4], qk[2]; };
        SetO S0, S1, S2, S3;
        auto issue = [&](int c, SetO& s) { const unsigned char* p = ITEM(c);
#pragma unroll
            for (int ks = 0; ks < 4; ++ks) s.qp[ks] = *(const GAS bf16x8*)(p + DEL_QP + (w * 4 + ks) * 1024);
            s.qk[0] = *(const GAS bf16x8*)(p + DEL_QKP + (w * 2) * 1024); s.qk[1] = *(const GAS bf16x8*)(p + DEL_QKP + (w * 2 + (w >> 1)) * 1024); };
        bf16* O = WSP(bf16, WS_O);
        issue(0, S0); issue(1, S1); issue(2, S2); issue(3, S3);
        auto step = [&](int c, SetO& s) {
            LDS_BARRIER();
#pragma unroll
            for (int sl = 0; sl < NSL; ++sl) {
                const LAS unsigned char* sb = X + SX_SB + ((c & 1) * NSL + sl) * 4096 + lane * 16;
                f32x4 acc = {0.f, 0.f, 0.f, 0.f};
#pragma unroll
                for (int ks = 0; ks < 4; ++ks) acc = mfma16(s.qp[ks], *(const LAS bf16x8*)(sb + ks * 1024), acc);
                const LAS unsigned char* vp = X + SX_VN + ((c & 1) * NSL + sl) * 2048 + lane * 8;
                const v2u t0 = *(const LAS v2u*)(vp), t1 = *(const LAS v2u*)(vp + 512), t2 = *(const LAS v2u*)(vp + 1024), t3 = *(const LAS v2u*)(vp + 1536);
                const bf16x8 vb0 = __builtin_bit_cast(bf16x8, (v4u){t0.x, t0.y, t1.x, t1.y}), vb1 = __builtin_bit_cast(bf16x8, (v4u){t2.x, t2.y, t3.x, t3.y});
                acc = mfma16(s.qk[0], vb0, acc);
                if (w >= 2) acc = mfma16(s.qk[1], vb1, acc);
                bf16* orow = O + (size_t)(b * SEQ + c * 64 + 16 * w + 4 * g4) * DM + h * 128 + 16 * (dvs0 + sl) + il;
#pragma unroll
                for (int r = 0; r < 4; ++r) orow[(size_t)r * DM] = (bf16)(pk2(acc[r], 0.f) & 0xffffu); }
            issue(c + 4, s);
            LDS_BARRIER();
        };
#pragma unroll 1
        for (int c = 0; c < 128; c += 16) {
            step(c + 0, S0); step(c + 1, S1); step(c + 2, S2); step(c + 3, S3); step(c + 4, S0); step(c + 5, S1); step(c + 6, S2); step(c + 7, S3);
            step(c + 8, S0); step(c + 9, S1); step(c + 10, S2); step(c + 11, S3); step(c + 12, S0); step(c + 13, S1); step(c + 14, S2); step(c + 15, S3);
        }
    }
#undef ITEM
}
DI void sample_delta(const Ctx& C, int vs) {
    const int  pair = C.wave >> 1, half = C.wave & 1, lane = C.lane, tt = half * 64 + lane;
    LAS float* qs = (LAS float*)(C.lds + pair * 9216); LAS float* ksm = qs + 1024; LAS float* red = ksm + 1024;
    const bf16* PROJ = WSP(bf16, WS_PROJ); const float* AB = WSP(float, WS_AB); bf16* O = WSP(bf16, WS_O);
    for (int base = vs * 4; base < 256; base += (C.G - NSCAN) * 4) {
        const int idx = base + pair, seq = idx >> 3, h = idx & 7, R0 = MP + seq * 8;
        float yq[8], yk[8], yv[8];
#pragma unroll
        for (int part = 0; part < 3; ++part) { const int col = part * 1024 + h * 128 + tt; float xp[11], cw[4];
#pragma unroll
            for (int r = 0; r < 3; ++r) xp[r] = C.state_conv[(size_t)(seq * 3 + r) * CONVD + col];
#pragma unroll
            for (int t = 0; t < 8; ++t) xp[3 + t] = bf2f(PROJ[(size_t)(R0 + t) * NPROJ + col]);
#pragma unroll
            for (int w = 0; w < 4; ++w) cw[w] = C.a_conv[w * CONVD + col];
#pragma unroll
            for (int t = 0; t < 8; ++t) { const float y = silu_f(cw[0] * xp[t] + cw[1] * xp[t + 1] + cw[2] * xp[t + 2] + cw[3] * xp[t + 3]);
                if (part == 0) yq[t] = y; else if (part == 1) yk[t] = y; else yv[t] = y; } }
#pragma unroll
        for (int t = 0; t < 8; ++t) { const float sq = wsum(yq[t] * yq[t]), sk = wsum(yk[t] * yk[t]); if (lane == 0) { red[t * 2 + half] = sq; red[16 + t * 2 + half] = sk; } }
        LDS_BARRIER();
#pragma unroll
        for (int t = 0; t < 8; ++t) { const float nq = rsqrtf(red[t * 2] + red[t * 2 + 1] + 1e-6f) * 0.08838834764831845f, nk = rsqrtf(red[16 + t * 2] + red[16 + t * 2 + 1] + 1e-6f);
            qs[t * 128 + tt] = yq[t] * nq; ksm[t * 128 + tt] = yk[t] * nk; }
        LDS_BARRIER();
        float s[128];
        const float* sp = C.state_delta + (size_t)((seq * 8 + h) * 128) * 128 + tt;
#pragma unroll
        for (int d = 0; d < 128; ++d) { s[d] = sp[(size_t)d * 128]; if ((d & 15) == 15) asm volatile("" ::: "memory"); }
#pragma unroll
        for (int t = 0; t < 8; ++t) {
            const float a = AB[(size_t)(R0 + t) * 16 + h], bb = AB[(size_t)(R0 + t) * 16 + 8 + h];
            const float eg = __expf(-__expf(C.a_log[h]) * softplus_f(a + C.a_dtb[h])), beta = sigmoid_f(bb);
            float dot = 0.f;
#pragma unroll
            for (int d4 = 0; d4 < 32; ++d4) { const f32x4 kk = *(const LAS f32x4*)(ksm + t * 128 + 4 * d4);
#pragma unroll
                for (int e = 0; e < 4; ++e) { s[4 * d4 + e] *= eg; dot += kk[e] * s[4 * d4 + e]; }
                if ((d4 & 7) == 7) asm volatile("" ::: "memory"); }
            const float err = (yv[t] - dot) * beta; float o = 0.f;
#pragma unroll
            for (int d4 = 0; d4 < 32; ++d4) { const f32x4 kk = *(const LAS f32x4*)(ksm + t * 128 + 4 * d4), qq = *(const LAS f32x4*)(qs + t * 128 + 4 * d4);
#pragma unroll
                for (int e = 0; e < 4; ++e) { s[4 * d4 + e] += kk[e] * err; o += qq[e] * s[4 * d4 + e]; }
                if ((d4 & 3) == 3) asm volatile("" ::: "memory"); }
            O[(size_t)(R0 + t) * DM + h * 128 + tt] = (bf16)(pk2(o, 0.f) & 0xffffu);
            asm volatile("" ::: "memory");
        }
        float* so = C.out + O_SDELTA + (size_t)((seq * 8 + h) * 128) * 128 + tt;
#pragma unroll
        for (int d = 0; d < 128; ++d) { so[(size_t)d * 128] = s[d]; if ((d & 15) == 15) asm volatile("" ::: "memory"); }
        LDS_BARRIER();
    }
}
DI void onorm_phase(const Ctx& C) {
    const int gw = C.vcu * NWAVES + C.wave, NGW = C.G * NWAVES, sub = C.lane & 15;
    const bf16* O = WSP(bf16, WS_O); const bf16* PROJ = WSP(bf16, WS_PROJ); bf16* OG = WSP(bf16, WS_OG);
    const f32x4 n0 = *(const GAS f32x4*)(C.a_norm + 8 * sub), n1 = *(const GAS f32x4*)(C.a_norm + 8 * sub + 4);
    constexpr int NIT = MT * 8 / 4;
    for (int it0 = gw; it0 < NIT; it0 += 4 * NGW) {
        v4u ou[4], zu[4]; int rw[4], cl[4];
#pragma unroll
        for (int q = 0; q < 4; ++q) { const int it = (it0 + q * NGW < NIT) ? it0 + q * NGW : it0; const int grp = it * 4 + (C.lane >> 4); rw[q] = grp >> 3; cl[q] = (grp & 7) * 128 + 8 * sub;
            ou[q] = *(const GAS v4u*)(O + (size_t)rw[q] * DM + cl[q]); zu[q] = *(const GAS v4u*)(PROJ + (size_t)rw[q] * NPROJ + 3072 + cl[q]); }
#pragma unroll
        for (int q = 0; q < 4; ++q) { if (it0 + q * NGW < NIT) {
            const f32x4 o0 = {bflo(ou[q].x), bfhi(ou[q].x), bflo(ou[q].y), bfhi(ou[q].y)}, o1 = {bflo(ou[q].z), bfhi(ou[q].z), bflo(ou[q].w), bfhi(ou[q].w)}; const v4u z = zu[q];
            float ss = (o0[0] * o0[0] + o0[1] * o0[1]) + (o0[2] * o0[2] + o0[3] * o0[3]) + (o1[0] * o1[0] + o1[1] * o1[1]) + (o1[2] * o1[2] + o1[3] * o1[3]);
            ss = rowsum16(ss);
            const float r = rsqrtf(ss * (1.f / 128.f) + 1e-6f);
            float v[8] = {o0[0] * r * n0[0] * silu_f(bflo(z.x)), o0[1] * r * n0[1] * silu_f(bfhi(z.x)), o0[2] * r * n0[2] * silu_f(bflo(z.y)), o0[3] * r * n0[3] * silu_f(bfhi(z.y)),
                          o1[0] * r * n1[0] * silu_f(bflo(z.z)), o1[1] * r * n1[1] * silu_f(bfhi(z.z)), o1[2] * r * n1[2] * silu_f(bflo(z.w)), o1[3] * r * n1[3] * silu_f(bfhi(z.w))};
            *(GAS bf16x8*)(OG + (size_t)rw[q] * DM + cl[q]) = pack8(v); } }
    }
}
template <bool RES_BF16> DI void ln_phase(const Ctx& C, const void* resA_, const void* resB_, const bf16* mix, const float* g, const float* bb, float* outf, bf16* outb) {
    const int gw = C.vcu * NWAVES + C.wave, NGW = C.G * NWAVES, lane = C.lane;
    f32x4 gv[4], bv[4];
#pragma unroll
    for (int j = 0; j < 4; ++j) { gv[j] = *(const GAS f32x4*)(g + 4 * lane + 256 * j); bv[j] = *(const GAS f32x4*)(bb + 4 * lane + 256 * j); }
    for (int row0 = gw; row0 < MT; row0 += 2 * NGW) {
        v2u ru[2][4], mu[2][4]; f32x4 rf[2][4];
#pragma unroll
        for (int q = 0; q < 2; ++q) { const int row = (row0 + q * NGW < MT) ? row0 + q * NGW : row0; const bf16* mr = mix + (size_t)row * DM;
#pragma unroll
            for (int j = 0; j < 4; ++j) { mu[q][j] = *(const GAS v2u*)(mr + 4 * lane + 256 * j);
                if (RES_BF16) { const bf16* rr = (row < MP ? (const bf16*)resA_ + (size_t)row * DM : (const bf16*)resB_ + (size_t)(row - MP) * DM); ru[q][j] = *(const GAS v2u*)(rr + 4 * lane + 256 * j); }
                else { const float* rr = (row < MP ? (const float*)resA_ + (size_t)row * DM : (const float*)resB_ + (size_t)(row - MP) * DM); rf[q][j] = *(const GAS f32x4*)(rr + 4 * lane + 256 * j); } } }
#pragma unroll
        for (int q = 0; q < 2; ++q) { const int row = row0 + q * NGW; if (row < MT) {
            f32x4 v[4]; float s = 0.f;
#pragma unroll
            for (int j = 0; j < 4; ++j) { f32x4 a;
                if (RES_BF16) a = (f32x4){bflo(ru[q][j].x), bfhi(ru[q][j].x), bflo(ru[q][j].y), bfhi(ru[q][j].y)}; else a = rf[q][j];
                const f32x4 m = {bflo(mu[q][j].x), bfhi(mu[q][j].x), bflo(mu[q][j].y), bfhi(mu[q][j].y)}; v[j] = a * ALPHA + m; s += (v[j][0] + v[j][1]) + (v[j][2] + v[j][3]); }
            const float mean = wsum(s) * (1.f / DM); float s2 = 0.f;
#pragma unroll
            for (int j = 0; j < 4; ++j) { v[j] = v[j] - mean; s2 += (v[j][0] * v[j][0] + v[j][1] * v[j][1]) + (v[j][2] * v[j][2] + v[j][3] * v[j][3]); }
            const float rstd = rsqrtf(wsum(s2) * (1.f / DM) + 1e-5f);
#pragma unroll
            for (int j = 0; j < 4; ++j) { const f32x4 y = v[j] * rstd * gv[j] + bv[j];
                if (outf) *(GAS f32x4*)(outf + (size_t)row * DM + 4 * lane + 256 * j) = y;
                if (outb) { v2u o; o.x = pk2(y[0], y[1]); o.y = pk2(y[2], y[3]); *(GAS v2u*)(outb + (size_t)row * DM + 4 * lane + 256 * j) = o; } } } }
    }
}
constexpr float SM_SCALE = 0.125f, SM_C2 = 0.125f * 1.4426950408889634f;
DI float exp2_f(float x) { return __builtin_amdgcn_exp2f(x); }
DI float xor16_f(float v) { return __int_as_float(__builtin_amdgcn_ds_swizzle(__float_as_int(v), 0x401F)); }
DI float half_add(float v) { const auto rr = __builtin_amdgcn_permlane32_swap(__float_as_uint(v), __float_as_uint(v), false, false); return __uint_as_float(rr[0]) + __uint_as_float(rr[1]); }
DI float half_max(float v) { const auto rr = __builtin_amdgcn_permlane32_swap(__float_as_uint(v), __float_as_uint(v), false, false); return fmaxf(__uint_as_float(rr[0]), __uint_as_float(rr[1])); }

template <bool CAUSAL, bool FIXREF, class KF, class VF>
DI void moba_tile(const KF& kfrag, const VF& vfrag, const bf16x8 (&qf)[2][2], int kt_max, int q0, int lane, float (&m_out)[2], float (&l_out)[2], f32x4 (&ot)[4][2], float kmax = 0.f, int ntl = 2  ) {
    const int il = lane & 15, g4 = lane >> 4;
    f32x4 st[16][2];
    const float NEG = -__builtin_inff();
    float nref[2] = {0.f, 0.f};
    if (FIXREF) {
#pragma unroll
        for (int nt = 0; nt < 2; ++nt) { float q2 = 0.f;
#pragma unroll
            for (int ks = 0; ks < 2; ++ks) { const v4u qu = __builtin_bit_cast(v4u, qf[nt][ks]); const unsigned w_[4] = {qu.x, qu.y, qu.z, qu.w};
#pragma unroll
                for (int e = 0; e < 4; ++e) { const float a = bflo(w_[e]), b = bfhi(w_[e]); q2 += a * a + b * b; } }
            q2 += xor16_f(q2); q2 = half_add(q2);
            nref[nt] = -fminf(sqrtf(q2) * kmax, 40.f); m_out[nt] = -nref[nt] * 0.6931471805599453f; } }
    bf16x8 kc0 = kfrag(0, 0), kc1 = kfrag(0, 1);
#pragma unroll
    for (int mt = 0; mt < 16; ++mt) {
        bf16x8 kn0 = kc0, kn1 = kc1;
        if (mt + 1 < 16) { if (mt + 1 < kt_max) { kn0 = kfrag(mt + 1, 0); kn1 = kfrag(mt + 1, 1); } }
        if (mt < kt_max) {
            const bf16x8 k0 = kc0, k1 = kc1;
#pragma unroll
            for (int nt = 0; nt < 2; ++nt) { f32x4 acc = {nref[nt], nref[nt], nref[nt], nref[nt]}; if (nt < ntl) { acc = mfma16(k0, qf[nt][0], acc); acc = mfma16(k1, qf[nt][1], acc); }
                if (CAUSAL) {
#pragma unroll
                    for (int r = 0; r < 4; ++r) if (16 * mt + 4 * g4 + r > q0 + 16 * nt + il) acc[r] = NEG; }
                st[mt][nt] = acc; }
        } else { st[mt][0] = (f32x4){NEG, NEG, NEG, NEG}; st[mt][1] = st[mt][0]; }
        kc0 = kn0; kc1 = kn1;
        asm volatile("" ::: "memory");
    }
    if (FIXREF) {
#pragma unroll
        for (int nt = 0; nt < 2; ++nt)
#pragma unroll
            for (int mt = 0; mt < 16; ++mt)
#pragma unroll
                for (int r = 0; r < 4; ++r) st[mt][nt][r] = exp2_f(st[mt][nt][r]);
    } else {
#pragma unroll
    for (int nt = 0; nt < 2; ++nt) { float m = NEG; if (nt >= ntl) { m_out[nt] = 0.f; continue; }
#pragma unroll
        for (int mt = 0; mt < 16; ++mt) m = fmaxf(m, fmaxf(fmaxf(st[mt][nt][0], st[mt][nt][1]), fmaxf(st[mt][nt][2], st[mt][nt][3])));
        m = fmaxf(m, xor16_f(m)); m = half_max(m);
#pragma unroll
        for (int mt = 0; mt < 16; ++mt)
#pragma unroll
            for (int r = 0; r < 4; ++r) st[mt][nt][r] = exp2_f(st[mt][nt][r] - m);
        m_out[nt] = m * 0.6931471805599453f; }
    }
    f32x4 ls0 = {0.f, 0.f, 0.f, 0.f}, ls1 = ls0; const bf16x8 ones = __builtin_bit_cast(bf16x8, (v4u){0x3f803f80u, 0x3f803f80u, 0x3f803f80u, 0x3f803f80u});
#pragma unroll
    for (int mt = 0; mt < 4; ++mt) { ot[mt][0] = (f32x4){0.f, 0.f, 0.f, 0.f}; ot[mt][1] = ot[mt][0]; }
    bf16x8 vc0 = vfrag(0, 0), vc1 = vfrag(1, 0);
#pragma unroll
    for (int ks = 0; ks < 8; ++ks) {
        bf16x8 vn0 = vc0, vn1 = vc1;
        if (ks + 1 < 8) { if (2 * (ks + 1) < kt_max) { vn0 = vfrag(0, ks + 1); vn1 = vfrag(1, ks + 1); } }
        if (2 * ks < kt_max) {
            const bf16x8 p0 = pack44(st[2 * ks][0], st[2 * ks + 1][0]), p1 = pack44(st[2 * ks][1], st[2 * ks + 1][1]);
            const bf16x8 v2 = vfrag(2, ks), v3 = vfrag(3, ks);
            ot[0][0] = mfma16(vc0, p0, ot[0][0]); ot[1][0] = mfma16(vc1, p0, ot[1][0]); ls0 = mfma16(ones, p0, ls0); ot[2][0] = mfma16(v2, p0, ot[2][0]); ot[3][0] = mfma16(v3, p0, ot[3][0]);
            if (ntl > 1) { ot[0][1] = mfma16(vc0, p1, ot[0][1]); ot[1][1] = mfma16(vc1, p1, ot[1][1]); ls1 = mfma16(ones, p1, ls1); ot[2][1] = mfma16(v2, p1, ot[2][1]); ot[3][1] = mfma16(v3, p1, ot[3][1]); }
        }
        vc0 = vn0; vc1 = vn1;
        asm volatile("" ::: "memory");
    }
    l_out[0] = ls0[0]; l_out[1] = ls1[0];
}
struct LdsK { const LAS unsigned char* p; int lane; DI bf16x8 operator()(int mt, int ks) const { return *(const LAS bf16x8*)(p + ((mt * 2 + ks) * 64 + lane) * 16); } };
struct LdsV { const LAS unsigned char* p; int lane; DI bf16x8 operator()(int mt, int ks) const { return *(const LAS bf16x8*)(p + ((mt * 8 + ks) * 64 + lane) * 16); } };
DI void stage_kv(int tid, const bf16* Kblk  , const bf16* Vt  , LAS unsigned char* Kl, LAS unsigned char* Vl, LAS float* kmx  ) {
    float k2max = 0.f;
#pragma unroll
    for (int q = 0; q < 4; ++q) { const int ch = tid + q * NTHR, key = ch >> 3, ci = ch & 7;
        const v4u v = *(const GAS v4u*)(Kblk + (size_t)key * 256 + 8 * ci);
        { const unsigned w_[4] = {v.x, v.y, v.z, v.w}; float s2 = 0.f;
#pragma unroll
          for (int e = 0; e < 4; ++e) { const float a = bflo(w_[e]), b = bfhi(w_[e]); s2 += a * a + b * b; }
          s2 += __shfl_xor(s2, 1); s2 += __shfl_xor(s2, 2); s2 += __shfl_xor(s2, 4); k2max = fmaxf(k2max, s2); }
        *(LAS v4u*)(Kl + ((((key >> 4) * 2 + (ci >> 2)) * 64) + (ci & 3) * 16 + (key & 15)) * 16) = v; }
#pragma unroll
    for (int q = 0; q < 4; ++q) { const int ch = tid + q * NTHR, d = ch >> 5, c32 = ch & 31;
        const v4u v = *(const GAS v4u*)(Vt + (size_t)d * 256 + 8 * c32);
        *(LAS v4u*)(Vl + ((((d >> 4) * 8 + (c32 >> 2)) * 64) + (c32 & 3) * 16 + (d & 15)) * 16) = v; }
#pragma unroll
    for (int o = 8; o < 64; o <<= 1) k2max = fmaxf(k2max, __shfl_xor(k2max, o));
    if ((tid & 63) == 0) kmx[tid >> 6] = k2max;
}
DI float read_kmax(const LAS float* kmx) { float m = 0.f;
#pragma unroll
    for (int w = 0; w < 8; ++w) m = fmaxf(m, kmx[w]);
    return sqrtf(m); }

DI void attn_p11(const Ctx& C) {
    float* PM = WSP(float, WS_PMEANS); const float* pk = C.out + O_PK;
    LAS float* red = (LAS float*)C.lds;
    for (int it = C.vcu; it < 64; it += C.G) {
        const float* base = pk + (size_t)(it * 256 + C.wave * 32) * 256 + 4 * C.lane; f32x4 a = {0.f, 0.f, 0.f, 0.f};
#pragma unroll 8
        for (int r = 0; r < 32; ++r) a += *(const GAS f32x4*)(base + (size_t)r * 256);
        *(LAS f32x4*)(red + C.wave * 256 + 4 * C.lane) = a;
        LDS_WAIT(); __syncthreads();
        if (C.tid < 256) { float s = 0.f;
#pragma unroll
            for (int w = 0; w < 8; ++w) s += red[w * 256 + C.tid];
            PM[it * 256 + C.tid] = s * (1.f / 256.f); }
        __syncthreads();
    }
    LAS unsigned short* img = (LAS unsigned short*)(C.lds + 16384);
    const bf16* VB = WSP(bf16, WS_VB); bf16* VTP = WSP(bf16, WS_VTP);
    for (int it = C.vcu; it < 256; it += C.G) { const int n = it & 31, g = (it >> 5) & 3, b = it >> 7;
#pragma unroll
        for (int q = 0; q < 4; ++q) { const int ch = C.tid + q * NTHR, key = ch >> 3, ci = ch & 7;
            const v4u v = *(const GAS v4u*)(VB + (size_t)(b * SEQ + n * 256 + key) * 256 + g * 64 + 8 * ci);
            LAS unsigned* dst = (LAS unsigned*)(img + key * 68 + 8 * ci); dst[0] = v.x; dst[1] = v.y; dst[2] = v.z; dst[3] = v.w; }
        LDS_WAIT(); __syncthreads();
#pragma unroll
        for (int q = 0; q < 4; ++q) { const int task = C.tid + q * NTHR, d = task >> 5, ks = (task >> 2) & 7, g4 = task & 3; unsigned short e8[8];
#pragma unroll
            for (int e = 0; e < 8; ++e) e8[e] = img[(32 * ks + 16 * (e >> 2) + 4 * g4 + (e & 3)) * 68 + d];
            v4u o; o.x = e8[0] | ((unsigned)e8[1] << 16); o.y = e8[2] | ((unsigned)e8[3] << 16); o.z = e8[4] | ((unsigned)e8[5] << 16); o.w = e8[6] | ((unsigned)e8[7] << 16);
            *(GAS v4u*)(VTP + ((size_t)((b * 4 + g) * 32 + n) * 64 + d) * 256 + 32 * ks + 8 * g4) = o; }
        __syncthreads();
    }
}
#define TOP3_INS(v_, i_) do { const float tv_ = (v_); const int ti_ = (i_); const bool g0_ = tv_ > v0, g1_ = tv_ > v1, g2_ = tv_ > v2; \
    const float nv2_ = g1_ ? v1 : (g2_ ? tv_ : v2); const int ni2_ = g1_ ? i1 : (g2_ ? ti_ : i2); \
    const float nv1_ = g0_ ? v0 : (g1_ ? tv_ : v1); const int ni1_ = g0_ ? i0 : (g1_ ? ti_ : i1); \
    v0 = g0_ ? tv_ : v0; i0 = g0_ ? ti_ : i0; v1 = nv1_; i1 = ni1_; v2 = nv2_; i2 = ni2_; } while (0)
DI void attn_p12(const Ctx& C) {
    const float* PM = WSP(float, WS_PMEANS); const bf16* Q = WSP(bf16, WS_Q); unsigned* LIST = WSP(unsigned, WS_LIST);
    LAS float* mn = (LAS float*)C.lds;
    const int lane = C.lane;
    for (int it = C.vcu; it < 512; it += C.G) {
        const int tr = it & 63, g = (it >> 6) & 3, b = it >> 8, own = tr >> 1;
        { float mv[4];
#pragma unroll
          for (int q = 0; q < 4; ++q) { const int i = C.tid + q * NTHR; mv[q] = PM[(size_t)(b * 32 + (i >> 6)) * 256 + g * 64 + (i & 63)]; }
#pragma unroll
          for (int q = 0; q < 4; ++q) mn[C.tid + q * NTHR] = mv[q]; }
        LDS_WAIT(); __syncthreads();
        const int h4 = C.wave & 3, t = tr * 128 + (C.wave >> 2) * 64 + lane;
        if (own > 0) {
            float q[64];
            const bf16* qp = Q + (size_t)(b * SEQ + t) * DM + (4 * g + h4) * 64;
#pragma unroll
            for (int c8 = 0; c8 < 8; ++c8) { const v4u v = *(const GAS v4u*)(qp + 8 * c8);
                q[8 * c8] = bflo(v.x); q[8 * c8 + 1] = bfhi(v.x); q[8 * c8 + 2] = bflo(v.y); q[8 * c8 + 3] = bfhi(v.y); q[8 * c8 + 4] = bflo(v.z); q[8 * c8 + 5] = bfhi(v.z); q[8 * c8 + 6] = bflo(v.w); q[8 * c8 + 7] = bfhi(v.w); }
            float v0 = -__builtin_inff(), v1 = v0, v2 = v0; int i0 = -1, i1 = -1, i2 = -1;
#pragma unroll 1
            for (int n = 0; n < own; ++n) { float s = 0.f;
#pragma unroll
                for (int d4 = 0; d4 < 16; ++d4) { const f32x4 m = *(const LAS f32x4*)(mn + n * 64 + 4 * d4); s += (q[4 * d4] * m[0] + q[4 * d4 + 1] * m[1]) + (q[4 * d4 + 2] * m[2] + q[4 * d4 + 3] * m[3]); }
                TOP3_INS(s, n); }
            unsigned long long mymask = 0ull;
#pragma unroll 1
            for (int n = 0; n < own; ++n) { const bool s_ = (i0 == n) || (i1 == n) || (i2 == n); const unsigned long long mask = __ballot(s_); if (lane == n) mymask = mask; }
            unsigned mybase = 0u;
            if (lane < own && mymask) mybase = __hip_atomic_fetch_add(C.ctl + CW_PCNT + ((b * 4 + g) * 32 + lane) * 4 + h4, (unsigned)__builtin_popcountll(mymask), __ATOMIC_RELAXED, __HIP_MEMORY_SCOPE_AGENT);
#pragma unroll
            for (int j = 0; j < 3; ++j) { const int n = (j == 0) ? i0 : (j == 1) ? i1 : i2; const int nn = n < 0 ? 0 : n;
                const unsigned basep = __shfl(mybase, nn); const unsigned mlo = __shfl((unsigned)mymask, nn), mhi = __shfl((unsigned)(mymask >> 32), nn);
                const unsigned long long mask = ((unsigned long long)mhi << 32) | mlo;
                if (n >= 0) LIST[(size_t)(((b * 4 + g) * 32 + n) * 4 + h4) * 8192 + basep + __builtin_popcountll(mask & ((1ull << lane) - 1ull))] = (unsigned)t | ((unsigned)j << 13); }
        }
        __syncthreads();
    }
    const float* CM = WSP(float, WS_CMEANS); unsigned* SL = WSP(unsigned, WS_SLIST);
    for (int it = C.vcu; it < 128; it += C.G) { const int g = it & 3, seq = it >> 2, q32 = C.tid >> 4, sub = C.tid & 15, tq = q32 >> 2, h4 = q32 & 3;
        float q[64]; const bf16* qp = Q + (size_t)(MP + seq * 8 + tq) * DM + (4 * g + h4) * 64;
#pragma unroll
        for (int c8 = 0; c8 < 8; ++c8) { const v4u v = *(const GAS v4u*)(qp + 8 * c8);
            q[8 * c8] = bflo(v.x); q[8 * c8 + 1] = bfhi(v.x); q[8 * c8 + 2] = bflo(v.y); q[8 * c8 + 3] = bfhi(v.y); q[8 * c8 + 4] = bflo(v.z); q[8 * c8 + 5] = bfhi(v.z); q[8 * c8 + 6] = bflo(v.w); q[8 * c8 + 7] = bfhi(v.w); }
        float v0 = -__builtin_inff(), v1 = v0, v2 = v0; int i0 = -1, i1 = -1, i2 = -1;
#pragma unroll 1
        for (int j = 0; j < 4; ++j) { const int n = 4 * sub + j; const float* mp = CM + (size_t)(seq * 64 + n) * 256 + g * 64; float s = 0.f;
#pragma unroll
            for (int d4 = 0; d4 < 16; ++d4) { const f32x4 m = *(const GAS f32x4*)(mp + 4 * d4); s += (q[4 * d4] * m[0] + q[4 * d4 + 1] * m[1]) + (q[4 * d4 + 2] * m[2] + q[4 * d4 + 3] * m[3]); }
            TOP3_INS(s, n); }
#pragma unroll
        for (int o = 1; o < 16; o <<= 1) { const float a0 = __shfl_xor(v0, o), a1 = __shfl_xor(v1, o), a2 = __shfl_xor(v2, o); const int j0 = __shfl_xor(i0, o), j1 = __shfl_xor(i1, o), j2 = __shfl_xor(i2, o);
            TOP3_INS(a0, j0); TOP3_INS(a1, j1); TOP3_INS(a2, j2); }
        if (sub == 0) {
#pragma unroll
            for (int s = 0; s < 3; ++s) { const int lid = (seq * 4 + g) * 64 + (s == 0 ? i0 : s == 1 ? i1 : i2); const unsigned pos = __hip_atomic_fetch_add(C.ctl + CW_SCNT + lid, 1u, __ATOMIC_RELAXED, __HIP_MEMORY_SCOPE_AGENT);
                SL[(size_t)lid * 32 + pos] = (unsigned)q32 | ((unsigned)s << 5); } }
        __syncthreads();
        if (C.tid < 64) { const int lid = (seq * 4 + g) * 64 + C.tid; if (__hip_atomic_load(C.ctl + CW_SCNT + lid, __ATOMIC_RELAXED, __HIP_MEMORY_SCOPE_AGENT) != 0u) { const unsigned p = __hip_atomic_fetch_add(C.ctl + CW_SCNT + 8192, 1u, __ATOMIC_RELAXED, __HIP_MEMORY_SCOPE_AGENT); WSP(unsigned, WS_GLB + 131072)[p] = (unsigned)lid; } }
    }
}
struct GlobK { const float* r0; const float* r1; int g, lane;
    DI bf16x8 operator()(int mt, int ks) const { const int key = 16 * mt + (lane & 15); const float* p = (key < 128 ? r0 + (size_t)key * 256 : r1 + (size_t)(key - 128) * 256) + 32 * ks + 8 * (lane >> 4);
        return pack44(*(const GAS f32x4*)p, *(const GAS f32x4*)(p + 4)); } };
struct GlobV { const float* r0; const float* r1; int lane;
    DI bf16x8 operator()(int mt, int ks) const { float v[8];
#pragma unroll
        for (int e = 0; e < 8; ++e) { const int key = 32 * ks + 16 * (e >> 2) + 4 * (lane >> 4) + (e & 3); v[e] = (key < 128 ? r0 + (size_t)key * 256 : r1 + (size_t)(key - 128) * 256)[16 * mt + (lane & 15)]; }
        return pack8(v); } };
#if defined(PROBE_DLY)
#define P13_T(n) do { if ((n) == PROBE_DLY && (int)blockIdx.x == PROBE_BLK) p13_t0_ = __builtin_amdgcn_s_memrealtime(); } while (0)
#define P13_TE(n) do { if ((n) == PROBE_DLY && (int)blockIdx.x == PROBE_BLK) *dacc += __builtin_amdgcn_s_memrealtime() - p13_t0_; } while (0)
#else
#define P13_T(n) do { } while (0)
#define P13_TE(n) do { } while (0)
#endif
DI void attn_p13_sample(const Ctx& C, int wi, int nw) {
    const int tid_f = C.wave * 64 + lane_id();
    const unsigned* SL = WSP(unsigned, WS_SLIST); float* SP = WSP(float, WS_SPART); const bf16* Q = WSP(bf16, WS_Q);
    LAS int* seq = (LAS int*)(C.lds + 131072); int nit = 0;
    if (tid_f == 0) { const int tot = (int)__hip_atomic_load(C.ctl + CW_SCNT + 8192, __ATOMIC_RELAXED, __HIP_MEMORY_SCOPE_AGENT); int n = 0; for (int k = wi; k < tot && n < 120; k += nw) seq[1 + n++] = (int)WSP(unsigned, WS_GLB + 131072)[k]; seq[0] = n; }
    LDS_BARRIER();
    nit = seq[0];
    if (nit == 0) return;
    if (C.wave >= 1) {
        struct LSet { f32x4 kv[5][2], vv[3][4]; };
        LSet A, B;
        auto issue = [&](int idx, LSet& s) {
            const int it = seq[1 + (idx < nit ? idx : nit - 1)];
            int tid_l = tid_f; asm volatile("" : "+v"(tid_l)); const int lt = tid_l - 64;
            const int n = it & 63, g = (it >> 6) & 3, sq = it >> 8;
            const int pg0 = C.page_table[sq * 128 + 2 * n], pg1 = C.page_table[sq * 128 + 2 * n + 1];
            const float* k0 = C.cache_k + (size_t)pg0 * 32768 + g * 64; const float* k1 = C.cache_k + (size_t)pg1 * 32768 + g * 64;
            const float* v0 = C.cache_v + (size_t)pg0 * 32768 + g * 64; const float* v1 = C.cache_v + (size_t)pg1 * 32768 + g * 64;
#pragma unroll
            for (int q = 0; q < 5; ++q) { const int u0 = lt + q * 448, u = u0 < 2048 ? u0 : 2047; const int key = u >> 3, d8 = u & 7; const float* p = (key < 128 ? k0 + (size_t)key * 256 : k1 + (size_t)(key - 128) * 256) + 8 * d8;
                s.kv[q][0] = __builtin_nontemporal_load((const GAS f32x4*)p); s.kv[q][1] = __builtin_nontemporal_load((const GAS f32x4*)(p + 4)); }
#pragma unroll
            for (int q = 0; q < 3; ++q) { const int u0 = lt + q * 448, u = u0 < 1024 ? u0 : 1023; const int kq = u >> 4, d4 = u & 15;
#pragma unroll
                for (int j = 0; j < 4; ++j) { const int key = 4 * kq + j; s.vv[q][j] = __builtin_nontemporal_load((const GAS f32x4*)((key < 128 ? v0 + (size_t)key * 256 : v1 + (size_t)(key - 128) * 256) + 4 * d4)); } }
        };
        auto commit = [&](int buf, const LSet& s) {
            int tid_l = tid_f; asm volatile("" : "+v"(tid_l)); const int lt = tid_l - 64;
            LAS unsigned char* Kl = C.lds + buf * 65536; LAS unsigned char* Vl = Kl + 32768;
#pragma unroll
            for (int q = 0; q < 5; ++q) { const int u0 = lt + q * 448, u = u0 < 2048 ? u0 : 2047; const int key = u >> 3, d8 = u & 7;
                *(LAS bf16x8*)(Kl + ((((key >> 4) * 2 + (d8 >> 2)) * 64) + (d8 & 3) * 16 + (key & 15)) * 16) = pack44(s.kv[q][0], s.kv[q][1]); }
#pragma unroll
            for (int q = 0; q < 3; ++q) { const int u0 = lt + q * 448, u = u0 < 1024 ? u0 : 1023; const int kq = u >> 4, d4 = u & 15, key0 = 4 * kq, ks8 = key0 >> 5, kp = key0 & 31, hi = kp >> 4, gq = (kp >> 2) & 3;
#pragma unroll
                for (int e = 0; e < 4; ++e) { const int d = 4 * d4 + e; v2u o; o.x = pk2(s.vv[q][0][e], s.vv[q][1][e]); o.y = pk2(s.vv[q][2][e], s.vv[q][3][e]);
                    *(LAS v2u*)(Vl + ((((d >> 4) * 8 + ks8) * 64) + 16 * gq + (d & 15)) * 16 + 8 * hi) = o; } }
        };
        issue(0, A); issue(1, B); commit(0, A); issue(2, A);
        LDS_BARRIER();
#pragma unroll 1
        for (int i = 0; i < nit; i += 2) {
            commit(1, B); issue(i + 3, B); LDS_BARRIER();
            if (i + 1 < nit) { commit(0, A); issue(i + 4, A); LDS_BARRIER(); }
        }
    } else {
        LDS_BARRIER();
        int lane0 = tid_f & 63; asm volatile("" : "+v"(lane0));
        auto ld_e = [&](int i, unsigned (&e)[2]) { const int it = seq[1 + (i < nit ? i : nit - 1)];
#pragma unroll
            for (int nt = 0; nt < 2; ++nt) e[nt] = SL[(size_t)it * 32 + nt * 16 + (lane0 & 15)]; };
        auto ld_q = [&](int i, const unsigned (&e)[2], bf16x8 (&qf)[2][2]) { const int it = seq[1 + (i < nit ? i : nit - 1)], g = (it >> 6) & 3, sq = it >> 8;
#pragma unroll
            for (int nt = 0; nt < 2; ++nt) { const int q32 = e[nt] & 31; const bf16* qp = Q + (size_t)(MP + sq * 8 + (q32 >> 2)) * DM + (4 * g + (q32 & 3)) * 64 + 8 * (lane0 >> 4);
                qf[nt][0] = *(const GAS bf16x8*)qp; qf[nt][1] = *(const GAS bf16x8*)(qp + 32); } };
        unsigned eC[2], eN[2]; bf16x8 qfC[2][2];
        ld_e(0, eC); ld_q(0, eC, qfC); ld_e(1, eN);
#pragma unroll 1
        for (int i = 0; i < nit; ++i) {
            const int it = seq[1 + i], bi = i & 1;
            int tid_l = tid_f; asm volatile("" : "+v"(tid_l)); const int lane = tid_l & 63, il = lane & 15, g4 = lane >> 4;
            const int cnt = (int)__hip_atomic_load(C.ctl + CW_SCNT + it, __ATOMIC_RELAXED, __HIP_MEMORY_SCOPE_AGENT);
            const int g = (it >> 6) & 3, seqi = it >> 8;
            bf16x8 qfN[2][2]; ld_q(i + 1, eN, qfN);
            unsigned eNN[2]; ld_e(i + 2, eNN);
            float m[2], l[2]; f32x4 ot[4][2];
            moba_tile<false, false>(LdsK{C.lds + bi * 65536, lane}, LdsV{C.lds + bi * 65536 + 32768, lane}, qfC, 16, 0, lane, m, l, ot, 0.f, cnt > 16 ? 2 : 1);
#pragma unroll
            for (int nt = 0; nt < 2; ++nt) if (nt * 16 + il < cnt) { const int q32 = eC[nt] & 31, sl = (eC[nt] >> 5) & 3; const size_t rec = ((size_t)(seqi * 8 + (q32 >> 2)) * 16 + 4 * g + (q32 & 3)) * 3 + sl;
#pragma unroll
                for (int mt = 0; mt < 4; ++mt) *(GAS f32x4*)(SP + rec * 68 + 16 * mt + 4 * g4) = ot[mt][nt];
                if (g4 == 0) { SP[rec * 68 + 64] = m[nt]; SP[rec * 68 + 65] = l[nt]; } }
            eC[0] = eN[0]; eC[1] = eN[1]; eN[0] = eNN[0]; eN[1] = eNN[1];
#pragma unroll
            for (int nt = 0; nt < 2; ++nt) { qfC[nt][0] = qfN[nt][0]; qfC[nt][1] = qfN[nt][1]; }
            LDS_BARRIER();
        }
    }
}
DI void attn_p13_prompt(const Ctx& C, int wi, int nw) {
    int lane = C.lane, il = lane & 15, g4 = lane >> 4;
    LAS unsigned char* Kl = C.lds; LAS unsigned char* Vl = C.lds + 32768; LAS int* start = (LAS int*)(C.lds + 65536);
    LAS int* wtot = (LAS int*)(C.lds + 65536 + 4352);
    { const unsigned c0 = __hip_atomic_load(C.ctl + CW_PCNT + 2 * C.tid, __ATOMIC_RELAXED, __HIP_MEMORY_SCOPE_AGENT), c1 = __hip_atomic_load(C.ctl + CW_PCNT + 2 * C.tid + 1, __ATOMIC_RELAXED, __HIP_MEMORY_SCOPE_AGENT);
      const int t0 = (int)(c0 + 255) >> 8, t1 = (int)(c1 + 255) >> 8; int s = t0 + t1, inc = s;
#pragma unroll
      for (int o = 1; o < 64; o <<= 1) { const int v = __shfl_up(inc, o); if (lane >= o) inc += v; }
      if (lane == 63) wtot[C.wave] = inc;
      LDS_WAIT(); __syncthreads();
      int wb = 0;
#pragma unroll
      for (int w = 0; w < 8; ++w) if (w < C.wave) wb += wtot[w];
      const int ex = wb + inc - s; start[2 * C.tid] = ex; start[2 * C.tid + 1] = ex + t0; if (C.tid == NTHR - 1) start[1024] = ex + s;
      LDS_WAIT(); __syncthreads(); }
    const int T = start[1024], per = (T + nw - 1) / nw, i_lo = wi * per, i_hi = (i_lo + per < T) ? i_lo + per : T;
    const bf16* Q = WSP(bf16, WS_Q); const bf16* KB = WSP(bf16, WS_KB); const bf16* VTP = WSP(bf16, WS_VTP); const unsigned* LIST = WSP(unsigned, WS_LIST);
    bf16* OP = WSP(bf16, WS_OPART); float* ML = WSP(float, WS_ML);
    int cur_blk = -1; float kmax = 0.f; LAS float* kmx = (LAS float*)(C.lds + 65536 + 4352 + 64);
    auto find = [&](int item, int& lid, int& tile) { int lo = 0, hi = 1024; while (hi - lo > 1) { const int mid = (lo + hi) >> 1; if (start[mid] <= item) lo = mid; else hi = mid; } lid = lo; tile = item - start[lo]; };
    auto ld_entries = [&](int lid, int tile, int lane_, unsigned (&e)[2]) {
#pragma unroll
        for (int nt = 0; nt < 2; ++nt) { const int pi = tile * 256 + (lane_ >> 6) * 0 + ((C.wave * 32 + nt * 16 + (lane_ & 15)) & 255); e[nt] = LIST[(size_t)lid * 8192 + ((tile * 256 + C.wave * 32 + nt * 16 + (lane_ & 15)) & 8191)]; (void)pi; } };
    auto ld_q = [&](int lid, const unsigned (&e)[2], int lane_, bf16x8 (&qf)[2][2]) { const int h = 4 * ((lid >> 7) & 3) + (lid & 3), b = lid >> 9;
#pragma unroll
        for (int nt = 0; nt < 2; ++nt) { const bf16* qp = Q + (size_t)(b * SEQ + (e[nt] & 8191)) * DM + h * 64 + 8 * (lane_ >> 4); qf[nt][0] = *(const GAS bf16x8*)qp; qf[nt][1] = *(const GAS bf16x8*)(qp + 32); } };
    int lidC = 0, tileC = 0, lidN = 0, tileN = 0, cur_lid = 0; unsigned eC[2], eN[2]; bf16x8 qfC[2][2];
    if (i_lo < i_hi) { find(i_lo, lidC, tileC); cur_lid = lidC; ld_entries(lidC, tileC, lane, eC); ld_q(lidC, eC, lane, qfC); find(i_lo + 1 < i_hi ? i_lo + 1 : i_lo, lidN, tileN); ld_entries(lidN, tileN, lane, eN); }
#pragma unroll 1
    for (int item = i_lo; item < i_hi; ++item) {
        int tid_l = C.tid; asm volatile("" : "+v"(tid_l)); lane = tid_l & 63; il = lane & 15; g4 = lane >> 4;
        const int lid = lidC, tile = tileC, h4 = lid & 3, n = (lid >> 2) & 31, g = (lid >> 7) & 3, b = lid >> 9, blkid = lid >> 2;
        const int cnt = (int)__hip_atomic_load(C.ctl + CW_PCNT + lid, __ATOMIC_RELAXED, __HIP_MEMORY_SCOPE_AGENT);
        bf16x8 qfN[2][2]; ld_q(lidN, eN, lane, qfN);
        int lidNN, tileNN; unsigned eNN[2]; { const int tgt = item + 2 < i_hi ? item + 2 : i_hi - 1; while (cur_lid < 1023 && start[cur_lid + 1] <= tgt) ++cur_lid; lidNN = cur_lid; tileNN = tgt - start[cur_lid]; } ld_entries(lidNN, tileNN, lane, eNN);
        if (blkid != cur_blk) { LDS_BARRIER(); stage_kv(tid_l, KB + (size_t)(b * SEQ + n * 256) * 256 + g * 64, VTP + (size_t)blkid * 64 * 256, Kl, Vl, kmx); cur_blk = blkid; LDS_BARRIER(); kmax = read_kmax(kmx); }
        const int h = 4 * g + h4;
        if (tile * 256 + C.wave * 32 < cnt) {
            float m[2], l[2]; f32x4 ot[4][2];
            moba_tile<false, true>(LdsK{Kl, lane}, LdsV{Vl, lane}, qfC, 16, 0, lane, m, l, ot, kmax);
#pragma unroll
            for (int nt = 0; nt < 2; ++nt) if (tile * 256 + C.wave * 32 + nt * 16 + il < cnt) { const size_t rec = ((size_t)(b * SEQ + (int)(eC[nt] & 8191u)) * 16 + h) * 3 + ((eC[nt] >> 13) & 3u);
#pragma unroll
                for (int mt = 0; mt < 4; ++mt) { v2u o; o.x = pk2(ot[mt][nt][0], ot[mt][nt][1]); o.y = pk2(ot[mt][nt][2], ot[mt][nt][3]); *(GAS v2u*)(OP + rec * 64 + 16 * mt + 4 * g4) = o; }
                if (g4 == 0) *(GAS f32x2*)(ML + rec * 2) = (f32x2){m[nt], l[nt]}; }
        }
        lidC = lidN; tileC = tileN; eC[0] = eN[0]; eC[1] = eN[1]; lidN = lidNN; tileN = tileNN; eN[0] = eNN[0]; eN[1] = eNN[1];
#pragma unroll
        for (int nt = 0; nt < 2; ++nt) { qfC[nt][0] = qfN[nt][0]; qfC[nt][1] = qfN[nt][1]; }
    }
    __syncthreads();
}
DI void attn_p13(const Ctx& C, unsigned long long* dacc) {
    unsigned long long p13_t0_ = 0ull; (void)p13_t0_; (void)dacc;
    { Ctx C1 = C; C1.lane = lane_id(); C1.tid = C1.wave * 64 + C1.lane; P13_T(6); attn_p13_prompt(C1, C.vcu, C.G); P13_TE(6); }
    { Ctx C2 = C; C2.lane = lane_id(); C2.tid = C2.wave * 64 + C2.lane; P13_T(7); attn_p13_sample(C2, C.vcu, C.G); P13_TE(7); }
}
DI void attn_p14(const Ctx& C) {
    int lane = C.lane, il = lane & 15, g4 = lane >> 4;
    LAS unsigned char* Kl = C.lds; LAS unsigned char* Vl = C.lds + 32768;
    const bf16* Q = WSP(bf16, WS_Q); const bf16* KB = WSP(bf16, WS_KB); const bf16* VB = WSP(bf16, WS_VB); const bf16* VTP = WSP(bf16, WS_VTP);
    const bf16* OP = WSP(bf16, WS_OPART); const float* ML = WSP(float, WS_ML); bf16* ATT = WSP(bf16, WS_OG);
#pragma unroll 1
    for (int it = C.vcu; it < 256; it += C.G) { const int n = it & 31, g = (it >> 5) & 3, b = it >> 7;
        LDS_BARRIER(); stage_kv(C.tid, KB + (size_t)(b * SEQ + n * 256) * 256 + g * 64, VTP + (size_t)it * 64 * 256, Kl, Vl, (LAS float*)(C.lds + 65536)); LDS_BARRIER();
        const float kmax = read_kmax((const LAS float*)(C.lds + 65536));
        const int nsl = n < 3 ? n : 3;
        const int qg = (C.wave < 4) ? C.wave : 11 - C.wave, q0 = qg * 32;
        bf16x8 qf[2][2];
        { const int il0 = C.lane & 15, g40 = C.lane >> 4;
#pragma unroll
          for (int nt = 0; nt < 2; ++nt) { const bf16* qp = Q + (size_t)(b * SEQ + n * 256 + q0 + nt * 16 + il0) * DM + (4 * g) * 64 + 8 * g40; qf[nt][0] = *(const GAS bf16x8*)qp; qf[nt][1] = *(const GAS bf16x8*)(qp + 32); } }
#pragma unroll 1
        for (int h4 = 0; h4 < 4; ++h4) { { int tid_l = C.tid; asm volatile("" : "+v"(tid_l)); lane = tid_l & 63; il = lane & 15; g4 = lane >> 4; }
            const int h = 4 * g + h4;
            bf16x8 qfN[2][2]; { const int hn = 4 * g + (h4 < 3 ? h4 + 1 : 3);
#pragma unroll
                for (int nt = 0; nt < 2; ++nt) { const bf16* qp = Q + (size_t)(b * SEQ + n * 256 + q0 + nt * 16 + il) * DM + hn * 64 + 8 * g4; qfN[nt][0] = *(const GAS bf16x8*)qp; qfN[nt][1] = *(const GAS bf16x8*)(qp + 32); } }
            float m[2], l[2]; f32x4 ot[4][2];
            moba_tile<true, true>(LdsK{Kl, lane}, LdsV{Vl, lane}, qf, 2 * qg + 2, q0, lane, m, l, ot, kmax);
            f32x2 mlv[2][3]; v2u opv[2][3][4];
#pragma unroll
            for (int nt = 0; nt < 2; ++nt) { const size_t rec = ((size_t)(b * SEQ + n * 256 + q0 + nt * 16 + il) * 16 + h) * 3;
#pragma unroll
                for (int s = 0; s < 3; ++s) { const size_t rs = rec + (s < nsl ? s : 0); mlv[nt][s] = *(const GAS f32x2*)(ML + rs * 2);
#pragma unroll
                    for (int mt = 0; mt < 4; ++mt) opv[nt][s][mt] = *(const GAS v2u*)(OP + rs * 64 + 16 * mt + 4 * g4); } }
#pragma unroll
            for (int nt = 0; nt < 2; ++nt) { const int row = b * SEQ + n * 256 + q0 + nt * 16 + il;
                float M = m[nt];
#pragma unroll
                for (int s = 0; s < 3; ++s) if (s < nsl) M = fmaxf(M, mlv[nt][s][0]);
                const float LOG2E = 1.4426950408889634f; const float w0 = exp2_f((m[nt] - M) * LOG2E); float L = l[nt] * w0, ws[3];
#pragma unroll
                for (int s = 0; s < 3; ++s) { ws[s] = (s < nsl) ? exp2_f((mlv[nt][s][0] - M) * LOG2E) : 0.f; L += (s < nsl) ? mlv[nt][s][1] * ws[s] : 0.f; }
                const float inv = 1.f / L;
#pragma unroll
                for (int mt = 0; mt < 4; ++mt) { f32x4 o = ot[mt][nt] * w0;
#pragma unroll
                    for (int s = 0; s < 3; ++s) if (s < nsl) { const v2u pv = opv[nt][s][mt]; o += (f32x4){bflo(pv.x), bfhi(pv.x), bflo(pv.y), bfhi(pv.y)} * ws[s]; }
                    o = o * inv; v2u w; w.x = pk2(o[0], o[1]); w.y = pk2(o[2], o[3]); *(GAS v2u*)(ATT + (size_t)row * DM + h * 64 + 16 * mt + 4 * g4) = w; } }
#pragma unroll
            for (int nt = 0; nt < 2; ++nt) { qf[nt][0] = qfN[nt][0]; qf[nt][1] = qfN[nt][1]; }
        }
    }
    const float* SP = WSP(float, WS_SPART);
    for (int idx = (C.vcu * NTHR + C.tid) >> 4; idx < 32 * 8 * 16; idx += (C.G * NTHR) >> 4) { const int sub = C.tid & 15, h = idx & 15, t = (idx >> 4) & 7, seq = idx >> 7, row = MP + seq * 8 + t, g = h >> 2;
        const v2u qv = *(const GAS v2u*)(Q + (size_t)row * DM + h * 64 + 4 * sub); const float q0 = bflo(qv.x), q1 = bfhi(qv.x), q2 = bflo(qv.y), q3 = bfhi(qv.y);
        const size_t rec = ((size_t)(seq * 8 + t) * 16 + h) * 3;
        float M = -__builtin_inff(), sc[8];
#pragma unroll
        for (int t2 = 0; t2 < 8; ++t2) { const v2u kv = *(const GAS v2u*)(KB + (size_t)(MP + seq * 8 + t2) * 256 + g * 64 + 4 * sub);
            float s = (q0 * bflo(kv.x) + q1 * bfhi(kv.x)) + (q2 * bflo(kv.y) + q3 * bfhi(kv.y));
            s += __shfl_xor(s, 1); s += __shfl_xor(s, 2); s += __shfl_xor(s, 4); s += __shfl_xor(s, 8);
            s = (t2 <= t) ? s * 0.6931471805599453f : -__builtin_inff(); sc[t2] = s; M = fmaxf(M, s); }
        float ms[3], ls[3];
#pragma unroll
        for (int s = 0; s < 3; ++s) { ms[s] = SP[(rec + s) * 68 + 64]; ls[s] = SP[(rec + s) * 68 + 65]; M = fmaxf(M, ms[s]); }
        f32x4 o = {0.f, 0.f, 0.f, 0.f}; float L = 0.f;
#pragma unroll
        for (int s = 0; s < 3; ++s) { const float w = __expf(ms[s] - M); L += ls[s] * w; o += *(const GAS f32x4*)(SP + (rec + s) * 68 + 4 * sub) * w; }
#pragma unroll
        for (int t2 = 0; t2 < 8; ++t2) { const float p = __expf(sc[t2] - M); L += p; const v2u vv = *(const GAS v2u*)(VB + (size_t)(MP + seq * 8 + t2) * 256 + g * 64 + 4 * sub);
            o += (f32x4){bflo(vv.x), bfhi(vv.x), bflo(vv.y), bfhi(vv.y)} * p; }
        const float inv = 1.f / L; v2u w; w.x = pk2(o[0] * inv, o[1] * inv); w.y = pk2(o[2] * inv, o[3] * inv);
        *(GAS v2u*)(ATT + (size_t)row * DM + h * 64 + 4 * sub) = w;
    }
}
template <class EPI, int MTI = 4, int NTJ = 4, int PER = 4> DI void sgemm_phase(const Ctx& C, const bf16* A  , const bf16* Bt  , int K, int ntn, const EPI& epi, int wk0 = 0, int nwk = 0) {
    const int wi = (nwk ? C.rr - wk0 : C.vcu), nw = (nwk ? nwk : C.G);
    if (wi < 0 || wi >= nw) return;
    LAS float* red = (LAS float*)C.lds;
    constexpr int per = PER;
    constexpr int RT = 16 * MTI, CT = 16 * NTJ;
#pragma unroll 1
    for (int tile = wi; tile < (256 / RT) * ntn; tile += nw) {
        int tid_l = C.tid; asm volatile("" : "+v"(tid_l)); const int lane = tid_l & 63, il = lane & 15, g4 = lane >> 4;
        const int m0 = (tile / ntn) * RT, nt = tile % ntn;
        f32x4 acc[MTI][NTJ];
#pragma unroll
        for (int i = 0; i < MTI; ++i)
#pragma unroll
            for (int j = 0; j < NTJ; ++j) acc[i][j] = (f32x4){0.f, 0.f, 0.f, 0.f};
        const bf16* ap = A + (size_t)(m0 + il) * K + (size_t)C.wave * per * 32 + 8 * g4;
        const bf16* bp[NTJ];
#pragma unroll
        for (int j = 0; j < NTJ; ++j) bp[j] = Bt + (size_t)(epi.brow(nt, j) + il) * K + (size_t)C.wave * per * 32 + 8 * g4;
        bf16x8 af[PER][MTI], bfr[PER][NTJ];
#pragma unroll
        for (int s = 0; s < PER; ++s) {
#pragma unroll
            for (int i = 0; i < MTI; ++i) af[s][i] = *(const GAS bf16x8*)(ap + (size_t)(16 * i) * K + 32 * s);
#pragma unroll
            for (int j = 0; j < NTJ; ++j) bfr[s][j] = *(const GAS bf16x8*)(bp[j] + 32 * s); }
#pragma unroll
        for (int s = 0; s < PER; ++s)
#pragma unroll
            for (int i = 0; i < MTI; ++i)
#pragma unroll
                for (int j = 0; j < NTJ; ++j) acc[i][j] = mfma16(af[s][i], bfr[s][j], acc[i][j]);
        LAS float* my = red + C.wave * (RT * CT);
#pragma unroll
        for (int i = 0; i < MTI; ++i)
#pragma unroll
            for (int j = 0; j < NTJ; ++j)
#pragma unroll
                for (int r = 0; r < 4; ++r) my[(16 * i + 4 * g4 + r) * CT + 16 * j + il] = acc[i][j][r];
        LDS_BARRIER();
        if (tid_l < RT * CT / 8) { const int row = tid_l / (CT / 8), c8 = tid_l % (CT / 8); f32x4 s0 = {0.f, 0.f, 0.f, 0.f}, s1 = s0;
#pragma unroll
          for (int w = 0; w < 8; ++w) { s0 += *(const LAS f32x4*)(red + w * (RT * CT) + row * CT + 8 * c8); s1 += *(const LAS f32x4*)(red + w * (RT * CT) + row * CT + 8 * c8 + 4); }
          *(LAS f32x4*)(red + row * CT + 8 * c8) = s0; *(LAS f32x4*)(red + row * CT + 8 * c8 + 4) = s1; }
        LDS_BARRIER();
        epi.store(red, m0, nt, tid_l);
        LDS_BARRIER();
    }
}
struct SEpiBf16 { bf16* O; int ldc;
    DI int brow(int nt, int j) const { return nt * 64 + 16 * j; }
    DI void store(const LAS float* t, int m0, int nt, int tid) const { const int row = tid >> 3, c8 = tid & 7; const f32x4 a = *(const LAS f32x4*)(t + row * 64 + 8 * c8), b = *(const LAS f32x4*)(t + row * 64 + 8 * c8 + 4);
        *(GAS bf16x8*)(O + (size_t)(MP + m0 + row) * ldc + nt * 64 + 8 * c8) = pack44(a, b); } };
struct SEpiF32 { float* O; int ldc;
    DI int brow(int nt, int j) const { return nt * 64 + 16 * j; }
    DI void store(const LAS float* t, int m0, int nt, int tid) const { const int row = tid >> 3, c8 = tid & 7; float* o = O + (size_t)(MP + m0 + row) * ldc + nt * 64 + 8 * c8;
        *(GAS f32x4*)o = *(const LAS f32x4*)(t + row * 64 + 8 * c8); *(GAS f32x4*)(o + 4) = *(const LAS f32x4*)(t + row * 64 + 8 * c8 + 4); } };
struct SEpiSwiglu { bf16* O;
    DI int brow(int nt, int j) const { const int hc = 32 * nt; return (hc >> 7) * 256 + (hc & 127) + (j >> 1) * 128 + (j & 1) * 16; }
    DI void store(const LAS float* t, int m0, int nt, int tid) const { const int row = tid >> 3, c8 = tid & 7; if (c8 < 4) { float v[8];
#pragma unroll
            for (int e = 0; e < 8; ++e) v[e] = silu_f(t[row * 64 + 8 * c8 + e]) * t[row * 64 + 32 + 8 * c8 + e];
            *(GAS bf16x8*)(O + (size_t)(MP + m0 + row) * FF + 32 * nt + 8 * c8) = pack8(v); } } };
struct SEpiQkv { bf16 *Q, *KB, *VB; float* out; const f32x2* tab;
    DI int brow(int nt, int j) const { return nt * 64 + 16 * j; }
    DI void store(const LAS float* t, int m0, int nt, int tid) const { const int row = tid >> 3, c8 = tid & 7, srow = m0 + row, grow = MP + srow;
        const f32x4 a = *(const LAS f32x4*)(t + row * 64 + 8 * c8), b = *(const LAS f32x4*)(t + row * 64 + 8 * c8 + 4);
        if (nt < 20) { const int pi = 8192 + (srow & 7); const f32x4 t0 = *(const GAS f32x4*)(tab + pi * 32 + 4 * c8), t1 = *(const GAS f32x4*)(tab + pi * 32 + 4 * c8 + 2);
            const float cs[4] = {t0[0], t0[2], t1[0], t1[2]}, sn[4] = {t0[1], t0[3], t1[1], t1[3]}; float o1[4], o2[4];
#pragma unroll
            for (int e = 0; e < 4; ++e) { o1[e] = a[e] * cs[e] - b[e] * sn[e]; o2[e] = b[e] * cs[e] + a[e] * sn[e]; }
            v2u w1, w2; w1.x = pk2(o1[0], o1[1]); w1.y = pk2(o1[2], o1[3]); w2.x = pk2(o2[0], o2[1]); w2.y = pk2(o2[2], o2[3]);
            if (nt < 16) { bf16* p = Q + (size_t)grow * DM + nt * 64 + 4 * c8; v2u s1, s2; s1.x = pk2(o1[0] * QSCALE, o1[1] * QSCALE); s1.y = pk2(o1[2] * QSCALE, o1[3] * QSCALE); s2.x = pk2(o2[0] * QSCALE, o2[1] * QSCALE); s2.y = pk2(o2[2] * QSCALE, o2[3] * QSCALE);
                *(GAS v2u*)p = s1; *(GAS v2u*)(p + 32) = s2; }
            else { bf16* p = KB + (size_t)grow * 256 + (nt - 16) * 64 + 4 * c8; *(GAS v2u*)p = w1; *(GAS v2u*)(p + 32) = w2;
                float* f = out + O_SK + (size_t)srow * 256 + (nt - 16) * 64 + 4 * c8; *(GAS f32x4*)f = (f32x4){o1[0], o1[1], o1[2], o1[3]}; *(GAS f32x4*)(f + 32) = (f32x4){o2[0], o2[1], o2[2], o2[3]}; }
        } else { const int col = (nt - 20) * 64 + 8 * c8; *(GAS bf16x8*)(VB + (size_t)grow * 256 + col) = pack44(a, b);
            float* f = out + O_SV + (size_t)srow * 256 + col; *(GAS f32x4*)f = a; *(GAS f32x4*)(f + 4) = b; } } };
struct SEpiF32s { bf16* O; int ldc;
    DI int brow(int nt, int j) const { return nt * 32 + 16 * j; }
    DI void store(const LAS float* t, int m0, int nt, int tid) const { if (tid < 128) { const int row = tid >> 2, c8 = tid & 3;
        *(GAS bf16x8*)(O + (size_t)(MP + m0 + row) * ldc + nt * 32 + 8 * c8) = pack44(*(const LAS f32x4*)(t + row * 32 + 8 * c8), *(const LAS f32x4*)(t + row * 32 + 8 * c8 + 4)); } } };
constexpr int NPHASE = 20;
struct Args { const void* in[22]; float* out; unsigned char* ws; int ph_lo, ph_hi, li, pad; };
__global__ void __launch_bounds__(NTHR, 2) yoco_fwd(Args args) {
    extern __shared__ __attribute__((aligned(16))) unsigned char lds_raw[];
    Ctx C;
    C.lds = (LAS unsigned char*)lds_raw;
    C.wave = __builtin_amdgcn_readfirstlane((int)threadIdx.x >> 6); C.lane = lane_id(); C.tid = C.wave * 64 + C.lane;
#define REFRESH() do { C.lane = lane_id(); C.tid = C.wave * 64 + C.lane; } while (0)
    C.G = gridDim.x; { const int bx = blockIdx.x; C.vcu = (C.G % 8 == 0) ? (bx % 8) * (C.G / 8) + bx / 8 : bx; C.rr = bx; }
    C.x_prompt = (const float*)args.in[0]; C.x_sample = (const float*)args.in[1]; C.state_conv = (const float*)args.in[2]; C.state_delta = (const float*)args.in[3];
    C.cache_k = (const float*)args.in[4]; C.cache_v = (const float*)args.in[5]; C.page_table = (const int*)args.in[6]; C.ln_g = (const float*)args.in[7]; C.ln_b = (const float*)args.in[8];
    C.a_w_in = (const float*)args.in[9]; C.a_conv = (const float*)args.in[10]; C.a_log = (const float*)args.in[11]; C.a_dtb = (const float*)args.in[12]; C.a_norm = (const float*)args.in[13];
    C.a_w_out = (const float*)args.in[14]; C.kv_w_k = (const float*)args.in[15]; C.kv_w_v = (const float*)args.in[16]; C.b_w_q = (const float*)args.in[17]; C.b_w_o = (const float*)args.in[18];
    C.w_gate = (const float*)args.in[19]; C.w_up = (const float*)args.in[20]; C.w_down = (const float*)args.in[21];
    C.out = args.out; C.ws = args.ws; C.ctl = (gu32*)(args.ws + WS_CTL);
    volatile LAS unsigned* MISC = (volatile LAS unsigned*)(C.lds + MISC_OFF);
    if (C.tid < 64) MISC[C.tid] = 0u;
    __syncthreads();
    const int lo = args.ph_lo, hi = args.ph_hi;
#if defined(PROBE_DLY)
    unsigned long long dly_t0_ = 0ull, dly_span_ = 0ull;
#define DLY_BEGIN(n) do { if ((n) == PROBE_DLY && (int)blockIdx.x == PROBE_BLK) dly_t0_ = __builtin_amdgcn_s_memrealtime(); } while (0)
#define DLY_END(n) do { if ((n) == PROBE_DLY && (int)blockIdx.x == PROBE_BLK) dly_span_ += __builtin_amdgcn_s_memrealtime() - dly_t0_; } while (0)
#define DLY_ACC (&dly_span_)
#else
#define DLY_ACC ((unsigned long long*)nullptr)
#define DLY_BEGIN(n) do { } while (0)
#define DLY_END(n) do { } while (0)
#endif
    XcdBarrier bar; bar.bar = (unsigned*)(C.ctl + 32768) + args.li * 4096; bar.x = 0; bar.st = nullptr;
    if (hi - lo > 1) { bar = xcd_barrier_post((unsigned*)(C.ctl + 32768) + args.li * 4096, MISC + 8, C.tid);
        if (C.tid == 0) __hip_atomic_store(C.ctl + 30208 + blockIdx.x, xb_xcc_id() + 1u, __ATOMIC_RELAXED, __HIP_MEMORY_SCOPE_AGENT); }
#define IN(k) (lo <= (k) && (k) < hi)
#define PLACE_IDS() do { if (IN(0) && IN(1) && C.G == 256) { REFRESH(); unsigned less_ = 0u; if (C.tid < 256) { const unsigned xm = __hip_atomic_load(C.ctl + 30208 + blockIdx.x, __ATOMIC_RELAXED, __HIP_MEMORY_SCOPE_AGENT), xt = __hip_atomic_load(C.ctl + 30208 + C.tid, __ATOMIC_RELAXED, __HIP_MEMORY_SCOPE_AGENT); \
            less_ = ((xt << 16) | (unsigned)C.tid) < ((xm << 16) | (unsigned)blockIdx.x) ? 1u : 0u; } \
        const unsigned pc_ = (unsigned)__builtin_popcountll(__ballot(less_ != 0u)); if (C.lane == 0) MISC[16 + C.wave] = pc_; __syncthreads(); \
        unsigned vid_ = 0u; for (int w_ = 0; w_ < 8; ++w_) vid_ += MISC[16 + w_]; vid_ = (unsigned)__builtin_amdgcn_readfirstlane((int)vid_); __syncthreads(); \
        C.vcu = (int)vid_; C.rr = (int)((vid_ % 32u) * 8u + vid_ / 32u); } } while (0)
#if defined(PROBE_TS)
    unsigned long long* ts_ = (unsigned long long*)(C.ws + WS_GLB + 65536);
#define STAMP(k) do { if (blockIdx.x == 0 && C.tid == 0) ts_[k] = __builtin_amdgcn_s_memrealtime(); } while (0)
#define SEAM(k) do { if (IN(k) && IN((k) + 1)) { REFRESH(); xcd_barrier(bar, C.tid); STAMP((k) + 1); } } while (0)
    STAMP(0);
#else
#if defined(PROBE_DLY)
#define SEAM(k) do { if (IN(k) && IN((k) + 1)) { REFRESH(); const bool m_ = (PROBE_DLY == 300 || PROBE_DLY == 301 + (k)) && (int)blockIdx.x == PROBE_BLK; unsigned long long t0_ = 0ull; if (m_) t0_ = __builtin_amdgcn_s_memrealtime(); xcd_barrier(bar, C.tid); if (m_) dly_span_ += __builtin_amdgcn_s_memrealtime() - t0_; } } while (0)
#else
#define SEAM(k) do { if (IN(k) && IN((k) + 1)) { REFRESH(); xcd_barrier(bar, C.tid); } } while (0)
#endif
#endif
    if (IN(0)) { REFRESH(); DLY_BEGIN(100 + 0); DLY_BEGIN(31); p0_weights(C, 0, 6784, C.vcu * NWAVES + C.wave, C.G * NWAVES); DLY_END(31);
#if defined(CMEANS_IN_P0)
        p0_cmeans(C, C.vcu * NWAVES + C.wave, C.G * NWAVES);
#endif
        __syncthreads(); DLY_BEGIN(32); p0_x(C); DLY_END(32); __syncthreads(); }
    DLY_END(100 + 0);
    SEAM(0);
    PLACE_IDS();
    if (IN(1)) { REFRESH(); DLY_BEGIN(100 + 1); { SEpiBf16 se{WSP(bf16, WS_PROJ), NPROJ}; sgemm_phase(C, WSP(bf16, WS_XB) + (size_t)MP * DM, WSP(bf16, WS_WIN), DM, NPROJ / 64, se); }
        pg8::Gemm g{WSP(bf16, WS_XB), WSP(bf16, WS_WIN), MP, NPROJ, DM}; pg8::StaticOrder S; S.init(MP, NPROJ, C.G, C.rr);
        pg8::EpiBf16<0> E{WSP(bf16, WS_PROJ), NPROJ, nullptr, 0, 0, 1.f};
        pg8::gemm_phase<pg8::EpiBf16<0>, pg8::StaticOrder, true, true>(C.lds, g, S, E, C.tid); }
    DLY_END(100 + 1);
    SEAM(1);
    if (IN(2)) { REFRESH(); DLY_BEGIN(100 + 2); conv_state_out(C); prep_phase(C, DLY_ACC); }
    DLY_END(100 + 2);
    SEAM(2);
    if (IN(3)) { REFRESH(); DLY_BEGIN(100 + 3);
#if defined(PROBE_XCC)
        volatile LAS int* role_ = (volatile LAS int*)(C.lds + MISC_OFF + 64);
        if (C.tid == 0) { const unsigned x = xb_xcc_id(); const unsigned t = __hip_atomic_fetch_add(C.ctl + 24576 + 64 * x, 1u, __ATOMIC_RELAXED, __HIP_MEMORY_SCOPE_AGENT); role_[0] = (int)(t < 16u ? (x * 16u + t) : (128u + x * 16u + (t - 16u))); }
        __syncthreads();
        const int vbx = role_[0];
#else
        const int vbx = C.rr;
#endif
        if (vbx < NSCAN) { DLY_BEGIN(1); scan_phase(C, vbx, DLY_ACC); DLY_END(1);
        } else { DLY_BEGIN(2); sample_delta(C, vbx - NSCAN); DLY_END(2); DLY_BEGIN(3);
            p0_cmeans(C, (vbx - NSCAN) * NWAVES + C.wave, (C.G - NSCAN) * NWAVES);
            DLY_END(3);
            LDS_BARRIER(); p0_weights(C, 6784, 12288, (vbx - NSCAN) * NWAVES + C.wave, (C.G - NSCAN) * NWAVES); p0_rope(C, (vbx - NSCAN) * NTHR + C.tid, (C.G - NSCAN) * NTHR);
        } }
    DLY_END(100 + 3);
    SEAM(3);
    if (IN(4)) { REFRESH(); DLY_BEGIN(100 + 4); onorm_phase(C); }
    DLY_END(100 + 4);
    SEAM(4);
    if (IN(5)) { REFRESH(); DLY_BEGIN(100 + 5); { SEpiF32s se{WSP(bf16, WS_MIX), DM}; sgemm_phase<SEpiF32s, 2, 2>(C, WSP(bf16, WS_OG) + (size_t)MP * DM, WSP(bf16, WS_WOUT), DM, DM / 32, se); }
        pg8::Gemm g{WSP(bf16, WS_OG), WSP(bf16, WS_WOUT), MP, DM, DM}; pg8::StaticOrder S; S.init(MP, DM, C.G, C.rr);
        pg8::EpiBf16<0> E{WSP(bf16, WS_MIX), DM, nullptr, 0, 0, 1.f}; pg8::gemm_phase<pg8::EpiBf16<0>, pg8::StaticOrder, true, true>(C.lds, g, S, E, C.tid); }
    DLY_END(100 + 5);
    SEAM(5);
    if (IN(6)) { REFRESH(); DLY_BEGIN(100 + 6); ln_phase<true>(C, WSP(bf16, WS_XB), WSP(bf16, WS_XB) + (size_t)MP * DM, WSP(bf16, WS_MIX), C.ln_g, C.ln_b, nullptr, WSP(bf16, WS_HB)); }
    DLY_END(100 + 6);
    SEAM(6);
    if (IN(7)) { REFRESH(); DLY_BEGIN(100 + 7);         pg8::Gemm g{WSP(bf16, WS_HB), WSP(bf16, WS_WGU0), MP, NGU, DM}; pg8::StaticOrder S; S.init(MP, NGU, C.G, C.rr);
        EpiSwiglu E{WSP(bf16, WS_FF)}; pg8::gemm_phase<EpiSwiglu, pg8::StaticOrder, true, true>(C.lds, g, S, E, C.tid);
        { REFRESH(); SEpiSwiglu se{WSP(bf16, WS_FF)}; sgemm_phase(C, WSP(bf16, WS_HB) + (size_t)MP * DM, WSP(bf16, WS_WGU0), DM, FF / 32, se, 128, 128); } }
    DLY_END(100 + 7);
    SEAM(7);
    if (IN(8)) { REFRESH(); DLY_BEGIN(100 + 8); { SEpiF32s se{WSP(bf16, WS_MIX), DM}; sgemm_phase<SEpiF32s, 2, 2, 11>(C, WSP(bf16, WS_FF) + (size_t)MP * FF, WSP(bf16, WS_WD0), FF, DM / 32, se); }
        pg8::Gemm g{WSP(bf16, WS_FF), WSP(bf16, WS_WD0), MP, DM, FF}; pg8::StaticOrder S; S.init(MP, DM, C.G, C.rr);
        pg8::EpiBf16<0> E{WSP(bf16, WS_MIX), DM, nullptr, 0, 0, 1.f}; pg8::gemm_phase<pg8::EpiBf16<0>, pg8::StaticOrder, true, true>(C.lds, g, S, E, C.tid); }
    DLY_END(100 + 8);
    SEAM(8);
    if (IN(9)) { REFRESH(); DLY_BEGIN(100 + 9); ln_phase<true>(C, WSP(bf16, WS_HB), WSP(bf16, WS_HB) + (size_t)MP * DM, WSP(bf16, WS_MIX), C.ln_g + DM, C.ln_b + DM, nullptr, WSP(bf16, WS_X1B)); }
    DLY_END(100 + 9);
    SEAM(9);
    if (IN(10)) { REFRESH(); DLY_BEGIN(100 + 10);         pg8::Gemm g{WSP(bf16, WS_X1B), WSP(bf16, WS_WQKV), MP, NQKV, DM}; pg8::StaticOrder S; S.init(MP, NQKV, C.G, C.rr);
        EpiQkvRope E{WSP(bf16, WS_Q), WSP(bf16, WS_KB), WSP(bf16, WS_VB), C.out, WSP(f32x2, WS_ROPE)}; pg8::gemm_phase<EpiQkvRope, pg8::StaticOrder, true, true>(C.lds, g, S, E, C.tid);
        { REFRESH(); SEpiQkv se{WSP(bf16, WS_Q), WSP(bf16, WS_KB), WSP(bf16, WS_VB), C.out, WSP(f32x2, WS_ROPE)}; sgemm_phase(C, WSP(bf16, WS_X1B) + (size_t)MP * DM, WSP(bf16, WS_WQKV), DM, NQKV / 64, se, 128, 128); } }
    DLY_END(100 + 10);
    SEAM(10);
    if (IN(11)) { REFRESH(); DLY_BEGIN(100 + 11); attn_p11(C); }
    DLY_END(100 + 11);
    SEAM(11);
    if (IN(12)) { REFRESH(); DLY_BEGIN(100 + 12); attn_p12(C); }
    DLY_END(100 + 12);
    SEAM(12);
    if (IN(13)) { REFRESH(); DLY_BEGIN(100 + 13); attn_p13(C, DLY_ACC); }
    DLY_END(100 + 13);
    SEAM(13);
    if (IN(14)) { REFRESH(); DLY_BEGIN(100 + 14); attn_p14(C); }
    DLY_END(100 + 14);
    SEAM(14);
    if (IN(15)) { REFRESH(); DLY_BEGIN(100 + 15); { SEpiF32s se{WSP(bf16, WS_MIX), DM}; sgemm_phase<SEpiF32s, 2, 2>(C, WSP(bf16, WS_OG) + (size_t)MP * DM, WSP(bf16, WS_WO), DM, DM / 32, se); }
        pg8::Gemm g{WSP(bf16, WS_OG), WSP(bf16, WS_WO), MP, DM, DM}; pg8::StaticOrder S; S.init(MP, DM, C.G, C.rr);
        pg8::EpiBf16<0> E{WSP(bf16, WS_MIX), DM, nullptr, 0, 0, 1.f}; pg8::gemm_phase<pg8::EpiBf16<0>, pg8::StaticOrder, true, true>(C.lds, g, S, E, C.tid); }
    DLY_END(100 + 15);
    SEAM(15);
    if (IN(16)) { REFRESH(); DLY_BEGIN(100 + 16); ln_phase<true>(C, WSP(bf16, WS_X1B), WSP(bf16, WS_X1B) + (size_t)MP * DM, WSP(bf16, WS_MIX), C.ln_g + 2 * DM, C.ln_b + 2 * DM, nullptr, WSP(bf16, WS_HB)); }
    DLY_END(100 + 16);
    SEAM(16);
    if (IN(17)) { REFRESH(); DLY_BEGIN(100 + 17);         pg8::Gemm g{WSP(bf16, WS_HB), WSP(bf16, WS_WGU1), MP, NGU, DM}; pg8::StaticOrder S; S.init(MP, NGU, C.G, C.rr);
        EpiSwiglu E{WSP(bf16, WS_FF)}; pg8::gemm_phase<EpiSwiglu, pg8::StaticOrder, true, true>(C.lds, g, S, E, C.tid);
        { REFRESH(); SEpiSwiglu se{WSP(bf16, WS_FF)}; sgemm_phase(C, WSP(bf16, WS_HB) + (size_t)MP * DM, WSP(bf16, WS_WGU1), DM, FF / 32, se, 128, 128); } }
    DLY_END(100 + 17);
    SEAM(17);
    if (IN(18)) { REFRESH(); DLY_BEGIN(100 + 18); { SEpiF32s se{WSP(bf16, WS_MIX), DM}; sgemm_phase<SEpiF32s, 2, 2, 11>(C, WSP(bf16, WS_FF) + (size_t)MP * FF, WSP(bf16, WS_WD1), FF, DM / 32, se); }
        pg8::Gemm g{WSP(bf16, WS_FF), WSP(bf16, WS_WD1), MP, DM, FF}; pg8::StaticOrder S; S.init(MP, DM, C.G, C.rr);
        pg8::EpiBf16<0> E{WSP(bf16, WS_MIX), DM, nullptr, 0, 0, 1.f}; pg8::gemm_phase<pg8::EpiBf16<0>, pg8::StaticOrder, true, true>(C.lds, g, S, E, C.tid); }
    DLY_END(100 + 18);
    SEAM(18);
    if (IN(19)) { REFRESH(); DLY_BEGIN(100 + 19); ln_phase<true>(C, WSP(bf16, WS_HB), WSP(bf16, WS_HB) + (size_t)MP * DM, WSP(bf16, WS_MIX), C.ln_g + 3 * DM, C.ln_b + 3 * DM, C.out + O_Y, nullptr); }
    DLY_END(100 + 19);

#if defined(PROBE_XBAR)
    for (int xb_ = 0; xb_ < 20; ++xb_) { REFRESH(); xcd_barrier(bar, C.tid); }
#endif
#if defined(PROBE_DLY)
    if ((int)blockIdx.x == PROBE_BLK) { const unsigned long long t0 = __builtin_amdgcn_s_memrealtime(); while (__builtin_amdgcn_s_memrealtime() - t0 < dly_span_) __builtin_amdgcn_s_sleep(8); }
#endif
#if defined(PROBE_TS)
    REFRESH(); xcd_barrier(bar, C.tid); STAMP(20);
    if (blockIdx.x == 0) { __syncthreads();
        const size_t offs[10] = {O_Y, O_Y + (size_t)MP * DM, O_PCONV, O_PDELTA, O_PK, O_PV, O_SCONV, O_SDELTA, O_SK, O_SV};
        const int pa[10] = {0, 2, 14, 4, 6, 8, 10, 12, 15, 16};
        for (int o = 0; o < 10; ++o) { const bool single = (o == 2 || o == 8 || o == 9);
            unsigned long long d0 = (__hip_atomic_load(ts_ + pa[o] + 1, __ATOMIC_RELAXED, __HIP_MEMORY_SCOPE_AGENT) - __hip_atomic_load(ts_ + pa[o], __ATOMIC_RELAXED, __HIP_MEMORY_SCOPE_AGENT)) / 100ull;
            unsigned long long d1 = single ? 0ull : (__hip_atomic_load(ts_ + pa[o] + 2, __ATOMIC_RELAXED, __HIP_MEMORY_SCOPE_AGENT) - __hip_atomic_load(ts_ + pa[o] + 1, __ATOMIC_RELAXED, __HIP_MEMORY_SCOPE_AGENT)) / 100ull;
            if (d0 > 315ull) d0 = 315ull; if (d1 > 315ull) d1 = 315ull;
            const int N = single ? (int)d0 : (int)(d0 * 316ull + d1);
            for (int i = C.tid; i < N; i += NTHR) C.out[offs[o] + i] = __uint_as_float(0xAAAAAAAAu); } }
#endif
#undef IN
#undef SEAM
}

#ifndef MK_SPLIT
#define MK_SPLIT 0
#endif
extern "C" void kernel_launch(void* const* d_in, const int* in_sizes, int n_in, void* d_out, int out_size, void* d_ws, size_t ws_size, hipStream_t stream) {
    static int grid = 0;
    if (grid == 0) {
        if (n_in != 22 || ws_size < WS_END) { fprintf(stderr, "kernel_launch: unexpected sizes n_in %d out %d ws %zu\n", n_in, out_size, ws_size); grid = -1; return; }
        int dev = 0, cus = 0;
        if (hipGetDevice(&dev) != hipSuccess || hipDeviceGetAttribute(&cus, hipDeviceAttributeMultiprocessorCount, dev) != hipSuccess) { grid = -1; return; }
        if (hipFuncSetAttribute((const void*)yoco_fwd, hipFuncAttributeMaxDynamicSharedMemorySize, LDS_BYTES) != hipSuccess) { fprintf(stderr, "kernel_launch: hipFuncSetAttribute failed\n"); grid = -1; return; }
        int per_cu = 0;
        if (hipOccupancyMaxActiveBlocksPerMultiprocessor(&per_cu, (const void*)yoco_fwd, NTHR, LDS_BYTES) != hipSuccess || per_cu < 1) { fprintf(stderr, "kernel_launch: occupancy query says %d\n", per_cu); }
        (void)hipGetLastError();
        grid = cus;
    }
    if (grid < 0) return;
    (void)hipMemsetAsync((char*)d_ws + WS_CTL, 0, CTL_ZERO_BYTES, stream);
    Args a{};
    for (int i = 0; i < 22; ++i) a.in[i] = d_in[i];
    a.out = (float*)d_out; a.ws = (unsigned char*)d_ws;
#if MK_SPLIT
#ifndef MK_REPEAT
#define MK_REPEAT 0u
#endif
    for (int p = 0; p < NPHASE; ++p) { a.ph_lo = p; a.ph_hi = p + 1; a.li = p; const int reps = ((MK_REPEAT >> p) & 1u) ? 2 : 1;
        for (int r = 0; r < reps; ++r) hipLaunchKernelGGL(yoco_fwd, dim3(grid), dim3(NTHR), LDS_BYTES, stream, a); }
#else
    a.ph_lo = 0; a.ph_hi = NPHASE; a.li = 0; hipLaunchKernelGGL(yoco_fwd, dim3(grid), dim3(NTHR), LDS_BYTES, stream, a);
#endif
}
```
